# Optimizing an MI355X kernel written in HIP

```python
import math
import jax, jax.numpy as jnp
from jax import lax
import numpy as np

D_MODEL = 1024
BATCH = 8
SEQ = 4096
DEPTH = 4

N_MIXERS = 3
D_PLE = 256
CONV_K = 4
CHUNK = 64
LN_EPS = 1e-5
DN_HEADS = 8
DN_DK = 128
DN_DV = 128
DN_QK = DN_HEADS * DN_DK
DN_V = DN_HEADS * DN_DV
DN_WIDTHS = (DN_QK, DN_QK, DN_V, DN_V, DN_HEADS, DN_HEADS)
DN_COLS = sum(DN_WIDTHS)
RW_HEAD = 64
RW_HEADS = D_MODEL // RW_HEAD
RW_W = RW_HEADS * RW_HEAD
RW_DECAY_LORA = 64
RW_A_LORA = 64
RW_GN_EPS = 64e-5
RW_WIDTHS = (RW_W, RW_DECAY_LORA, RW_W, RW_W, RW_A_LORA, RW_W)
RW_COLS = sum(RW_WIDTHS)
ML_HEADS = 8
ML_DQK = 64
ML_DV = 128
ML_QK = ML_HEADS * ML_DQK
ML_V = ML_HEADS * ML_DV
ML_WIDTHS = (ML_QK, ML_QK, ML_V, ML_V, ML_V, ML_HEADS, ML_HEADS)
ML_COLS = sum(ML_WIDTHS)
N_DN = (DEPTH + 2) // 3
N_RW = (DEPTH + 1) // 3
N_ML = DEPTH // 3
DEEPNORM_ALPHA = (2.0 * DEPTH) ** 0.25
DEEPNORM_BETA = (8.0 * DEPTH) ** -0.25

kernel_name = "hybrid_deltanet_rwkv7_mlstm_deepnorm"


def split_cols(h, widths):
    return jnp.split(h, [int(c) for c in np.cumsum(widths)[:-1]], axis=-1)


def layer_norm(x, g, b):
    xf = x.astype(jnp.float32)
    mu = jnp.mean(xf, -1, keepdims=True)
    var = jnp.mean(jnp.square(xf - mu), -1, keepdims=True)
    return ((xf - mu) * lax.rsqrt(var + LN_EPS) * g + b).astype(x.dtype)


def rms_norm(x, g, eps=1e-6):
    xf = x.astype(jnp.float32)
    return xf * lax.rsqrt(jnp.mean(xf * xf, -1, keepdims=True) + eps) * g


def l2_normalize(x, eps=1e-6):
    xf = x.astype(jnp.float32)
    return xf * lax.rsqrt(jnp.sum(xf * xf, -1, keepdims=True) + eps)


def group_norm(h, w, b, eps):
    mu = jnp.mean(h, -1, keepdims=True)
    var = jnp.mean(jnp.square(h - mu), -1, keepdims=True)
    out = ((h - mu) * lax.rsqrt(var + eps)).reshape(h.shape[0], h.shape[1], -1) * w
    return out if b is None else out + b


def causal_conv(x, w):
    K, S = w.shape[0], x.shape[1]
    xp = jnp.pad(x, ((0, 0), (K - 1, 0), (0, 0)))
    return sum(w[j] * xp[:, j:j + S] for j in range(K))


def token_shift(x):
    return jnp.pad(x, ((0, 0), (1, 0), (0, 0)))[:, :-1]


def gated_delta_rule_chunked(q, k, v, beta, g):
    B_, H, S, dk = q.shape
    dv = v.shape[-1]
    n, c = S // CHUNK, CHUNK
    q = q * dk ** -0.5
    to_chunks = lambda t: t.reshape(B_, H, n, c, *t.shape[3:])
    q, k, v, beta, g = map(to_chunks, (q, k, v, beta, g))
    G = jnp.cumsum(g, axis=-1)
    causal = jnp.tril(jnp.ones((c, c), dtype=bool))
    strict = jnp.tril(jnp.ones((c, c), dtype=bool), -1)
    diff = G[..., :, None] - G[..., None, :]
    decay_mat = jnp.where(causal, jnp.exp(jnp.where(causal, diff, 0.0)), 0.0)
    k_beta = k * beta[..., None]
    A = jnp.where(strict, jnp.einsum("bhnid,bhnjd->bhnij", k_beta, k) * decay_mat, 0.0)
    eye = jnp.eye(c, dtype=A.dtype)
    T = lax.linalg.triangular_solve(A + eye, jnp.broadcast_to(eye, A.shape),
                                    left_side=True, lower=True, unit_diagonal=True)
    u = jnp.einsum("bhnij,bhnjd->bhnid", T, v * beta[..., None])
    w = jnp.einsum("bhnij,bhnjd->bhnid", T, k_beta * jnp.exp(G)[..., None])
    qk = jnp.einsum("bhnid,bhnjd->bhnij", q, k) * decay_mat
    q_dec = q * jnp.exp(G)[..., None]
    k_dec = k * jnp.exp(G[..., -1:] - G)[..., None]
    g_last = jnp.exp(G[..., -1])

    def step(state, xs):
        qk_c, qd_c, kd_c, u_c, w_c, gl_c = xs
        v_new = u_c - jnp.einsum("bhid,bhde->bhie", w_c, state)
        o = jnp.einsum("bhid,bhde->bhie", qd_c, state) + jnp.einsum("bhij,bhje->bhie", qk_c, v_new)
        state = state * gl_c[..., None, None] + jnp.einsum("bhid,bhie->bhde", kd_c, v_new)
        return state, o

    xs = tuple(jnp.moveaxis(t, 2, 0) for t in (qk, q_dec, k_dec, u, w, g_last))
    state0 = jnp.zeros((B_, H, dk, dv), jnp.float32)
    _, o = lax.scan(step, state0, xs)
    return jnp.moveaxis(o, 0, 2).reshape(B_, H, S, dv)


def gated_deltanet_mixer(x, w_in, conv_w, a_log, dt_bias, norm_w, w_out):
    B_, S, _ = x.shape
    h = x @ w_in
    qkv, z, b_pre, a_pre = split_cols(h, (2 * DN_QK + DN_V, DN_V, DN_HEADS, DN_HEADS))
    qkv = jax.nn.silu(causal_conv(qkv, conv_w))
    q, k, v = split_cols(qkv, (DN_QK, DN_QK, DN_V))
    heads = lambda t, d: t.reshape(B_, S, DN_HEADS, d).transpose(0, 2, 1, 3)
    q = l2_normalize(heads(q, DN_DK))
    k = l2_normalize(heads(k, DN_DK))
    v = heads(v, DN_DV).astype(jnp.float32)
    beta = jax.nn.sigmoid(b_pre.astype(jnp.float32)).transpose(0, 2, 1)
    g = -(jnp.exp(a_log.astype(jnp.float32))
          * jax.nn.softplus(a_pre.astype(jnp.float32) + dt_bias)).transpose(0, 2, 1)
    o = gated_delta_rule_chunked(q, k, v, beta, g)
    o = rms_norm(o, norm_w).transpose(0, 2, 1, 3).reshape(B_, S, DN_V)
    y = (o * jax.nn.silu(z.astype(jnp.float32))).astype(x.dtype)
    return y @ w_out


def rwkv7_mixer(x, w_in, mu, w0, w_lora_up, a0, a_lora_up, k_k, k_a, r_k, gn_w, gn_b, w_out):
    B_, S, D = x.shape
    mu_cols = jnp.repeat(mu, np.array(RW_WIDTHS), axis=0, total_repeat_length=RW_COLS).T
    h = x @ w_in + (token_shift(x) - x) @ (mu_cols * w_in)
    r, w_lo, k, v, a_lo, z = split_cols(h, RW_WIDTHS)
    w_log = -jax.nn.softplus(-(w0 + jnp.tanh(w_lo) @ w_lora_up)) - 0.5
    a = jax.nn.sigmoid(a0 + a_lo @ a_lora_up)
    heads = lambda t: t.astype(jnp.float32).reshape(B_, S, RW_HEADS, RW_HEAD)
    r, k, v, a, w_log = map(heads, (r, k, v, a, w_log))
    kk = l2_normalize(k * k_k.reshape(RW_HEADS, RW_HEAD))
    k = k * (1.0 + (a - 1.0) * k_a.reshape(RW_HEADS, RW_HEAD))
    decay = jnp.exp(-jnp.exp(w_log))

    def step(state, xs):
        r_t, d_t, k_t, v_t, kk_t, a_t = xs
        sa = jnp.einsum("bhvk,bhk->bhv", state, -kk_t)
        state = (state * d_t[:, :, None, :] + sa[..., :, None] * (kk_t * a_t)[..., None, :]
                 + v_t[..., :, None] * k_t[..., None, :])
        return state, jnp.einsum("bhvk,bhk->bhv", state, r_t)

    xs = tuple(jnp.moveaxis(t, 1, 0) for t in (r, decay, k, v, kk, a))
    state0 = jnp.zeros((B_, RW_HEADS, RW_HEAD, RW_HEAD), jnp.float32)
    _, y = lax.scan(step, state0, xs)
    y = group_norm(jnp.moveaxis(y, 0, 1), gn_w, gn_b, RW_GN_EPS)
    bonus = jnp.sum(r * k * r_k, -1, keepdims=True) * v
    y = (y + bonus.reshape(B_, S, RW_W)) * jax.nn.silu(z.astype(jnp.float32))
    return y.astype(x.dtype) @ w_out


def mlstm_chunked(q, k, v, i_log, f_log):
    B_, H, S, dk = q.shape
    dv = v.shape[-1]
    n, c = S // CHUNK, CHUNK
    k = k * dk ** -0.5
    to_chunks = lambda t: t.reshape(B_, H, n, c, *t.shape[3:])
    q, k, v, i_log, f_log = map(to_chunks, (q, k, v, i_log, f_log))
    b = jnp.cumsum(f_log, axis=-1)
    causal = jnp.tril(jnp.ones((c, c), dtype=bool))
    d_log = jnp.where(causal, b[..., :, None] - b[..., None, :] + i_log[..., None, :], -jnp.inf)
    m_intra = jnp.max(d_log, axis=-1)
    qk = jnp.einsum("bhnid,bhnjd->bhnij", q, k)
    key_log = b[..., -1:] - b + i_log

    def step(carry, xs):
        C, nrm, m = carry
        qk_c, d_c, mi_c, b_c, kl_c, q_c, k_c, v_c = xs
        m_state = m[..., None] + b_c
        m_t = jnp.maximum(m_state, mi_c)
        inter = jnp.exp(m_state - m_t)
        w_qk = jnp.exp(d_c - m_t[..., None]) * qk_c
        num = (inter[..., None] * jnp.einsum("bhid,bhde->bhie", q_c, C)
               + jnp.einsum("bhij,bhje->bhie", w_qk, v_c))
        den = inter * jnp.einsum("bhid,bhd->bhi", q_c, nrm) + jnp.sum(w_qk, -1)
        h = num / jnp.maximum(jnp.abs(den), jnp.exp(-m_t))[..., None]
        m_new = m_t[..., -1]
        carry_scale = jnp.exp(m + b_c[..., -1] - m_new)
        k_w = k_c * jnp.exp(kl_c - m_new[..., None])[..., None]
        C = C * carry_scale[..., None, None] + jnp.einsum("bhid,bhie->bhde", k_w, v_c)
        nrm = nrm * carry_scale[..., None] + jnp.sum(k_w, axis=-2)
        return (C, nrm, m_new), h

    xs = tuple(jnp.moveaxis(t, 2, 0) for t in (qk, d_log, m_intra, b, key_log, q, k, v))
    carry0 = (jnp.zeros((B_, H, dk, dv), jnp.float32), jnp.zeros((B_, H, dk), jnp.float32),
              jnp.full((B_, H), -jnp.inf, jnp.float32))
    _, h = lax.scan(step, carry0, xs)
    return jnp.moveaxis(h, 0, 2).reshape(B_, H, S, dv)


def mlstm_mixer(x, w_in, conv_w, i_bias, f_bias, gn_w, w_out):
    B_, S, _ = x.shape
    h = x @ w_in
    qk, v, o, z, i_pre, f_pre = split_cols(h, (2 * ML_QK, ML_V, ML_V, ML_V, ML_HEADS, ML_HEADS))
    qk = jax.nn.silu(causal_conv(qk, conv_w))
    q, k = split_cols(qk, (ML_QK, ML_QK))
    heads = lambda t, d: t.astype(jnp.float32).reshape(B_, S, ML_HEADS, d).transpose(0, 2, 1, 3)
    q, k, v = heads(q, ML_DQK), heads(k, ML_DQK), heads(v, ML_DV)
    i_log = (i_pre.astype(jnp.float32) + i_bias).transpose(0, 2, 1)
    f_log = jax.nn.log_sigmoid(f_pre.astype(jnp.float32) + f_bias).transpose(0, 2, 1)
    h_tilde = mlstm_chunked(q, k, v, i_log, f_log).transpose(0, 2, 1, 3)
    og = jax.nn.sigmoid(o.astype(jnp.float32)).reshape(B_, S, ML_HEADS, ML_DV)
    hh = group_norm(og * h_tilde, gn_w, None, 1e-6)
    y = hh * jax.nn.silu(z.astype(jnp.float32))
    return y.astype(x.dtype) @ w_out


def setup_inputs(seed: int = 0) -> dict:
    key = jax.random.key(seed)
    ks = iter(jax.random.split(key, 40))
    nk = lambda: next(ks)
    nrm = lambda shape, s: jax.random.normal(nk(), shape, jnp.float32) * s
    uni = lambda shape, lo, hi: jax.random.uniform(nk(), shape, jnp.float32, lo, hi)
    D = D_MODEL

    def col_scale(widths, scales):
        return jnp.asarray(np.concatenate([np.full(wd, sc, np.float32) for wd, sc in zip(widths, scales)]))

    x = nrm((BATCH, SEQ, D), 1.0)
    p = nrm((DEPTH, BATCH, SEQ, D_PLE), 1.0)
    ln_g = 1.0 + nrm((DEPTH, D), 0.02)
    ln_b = nrm((DEPTH, D), 0.02)
    ple_w_proj = nrm((DEPTH, D_PLE, D), D_PLE ** -0.5)
    ple_norm_w = 1.0 + nrm((DEPTH, D), 0.02)
    ple_w_gate = nrm((DEPTH, D, D), D ** -0.5)

    s_in = D ** -0.5
    dn_w_in = nrm((N_DN, D, DN_COLS), 1.0) * col_scale(DN_WIDTHS, (s_in,) * 5 + (0.1 * s_in,))
    dn_conv_w = nrm((N_DN, CONV_K, 2 * DN_QK + DN_V), CONV_K ** -0.5)
    dn_a_log = jnp.log(uni((N_DN, DN_HEADS), 1.0, 16.0))
    dt = jnp.exp(uni((N_DN, DN_HEADS), math.log(1e-3), math.log(1e-1)))
    dn_dt_bias = dt + jnp.log(-jnp.expm1(-dt))
    dn_norm_w = 1.0 + nrm((N_DN, DN_DV), 0.02)
    dn_w_out = nrm((N_DN, DN_V, D), DN_V ** -0.5 * DEEPNORM_BETA)

    rw_w_in = nrm((N_RW, D, RW_COLS), s_in)
    rw_mu = uni((N_RW, len(RW_WIDTHS), D), 0.0, 1.0)
    rw_w0 = uni((N_RW, RW_W), -5.0, -1.0)
    rw_w_lora_up = nrm((N_RW, RW_DECAY_LORA, RW_W), 0.1 * RW_DECAY_LORA ** -0.5)
    rw_a0 = nrm((N_RW, RW_W), 0.1)
    rw_a_lora_up = nrm((N_RW, RW_A_LORA, RW_W), 0.1 * RW_A_LORA ** -0.5)
    rw_k_k = 0.85 + nrm((N_RW, RW_W), 0.05)
    rw_k_a = 1.0 + nrm((N_RW, RW_W), 0.05)
    rw_r_k = nrm((N_RW, RW_HEADS, RW_HEAD), 0.2)
    rw_gn_w = 1.0 + nrm((N_RW, RW_W), 0.02)
    rw_gn_b = nrm((N_RW, RW_W), 0.02)
    rw_w_out = nrm((N_RW, RW_W, D), RW_W ** -0.5 * DEEPNORM_BETA)

    ml_w_in = nrm((N_ML, D, ML_COLS), 1.0) * col_scale(ML_WIDTHS, (s_in,) * 5 + (0.1 * s_in,) * 2)
    ml_conv_w = nrm((N_ML, CONV_K, 2 * ML_QK), CONV_K ** -0.5)
    ml_i_bias = nrm((N_ML, ML_HEADS), 0.1)
    ml_f_bias = uni((N_ML, ML_HEADS), 3.0, 6.0)
    ml_gn_w = 1.0 + nrm((N_ML, ML_V), 0.02)
    ml_w_out = nrm((N_ML, ML_V, D), ML_V ** -0.5 * DEEPNORM_BETA)

    return {"x": x, "p": p, "ln_g": ln_g, "ln_b": ln_b, "ple_w_proj": ple_w_proj,
            "ple_norm_w": ple_norm_w, "ple_w_gate": ple_w_gate,
            "dn_w_in": dn_w_in, "dn_conv_w": dn_conv_w, "dn_a_log": dn_a_log, "dn_dt_bias": dn_dt_bias,
            "dn_norm_w": dn_norm_w, "dn_w_out": dn_w_out,
            "rw_w_in": rw_w_in, "rw_mu": rw_mu, "rw_w0": rw_w0, "rw_w_lora_up": rw_w_lora_up,
            "rw_a0": rw_a0, "rw_a_lora_up": rw_a_lora_up, "rw_k_k": rw_k_k, "rw_k_a": rw_k_a,
            "rw_r_k": rw_r_k, "rw_gn_w": rw_gn_w, "rw_gn_b": rw_gn_b, "rw_w_out": rw_w_out,
            "ml_w_in": ml_w_in, "ml_conv_w": ml_conv_w, "ml_i_bias": ml_i_bias, "ml_f_bias": ml_f_bias,
            "ml_gn_w": ml_gn_w, "ml_w_out": ml_w_out}


def reference(x, p, ln_g, ln_b, ple_w_proj, ple_norm_w, ple_w_gate,
              dn_w_in, dn_conv_w, dn_a_log, dn_dt_bias, dn_norm_w, dn_w_out,
              rw_w_in, rw_mu, rw_w0, rw_w_lora_up, rw_a0, rw_a_lora_up, rw_k_k, rw_k_a,
              rw_r_k, rw_gn_w, rw_gn_b, rw_w_out,
              ml_w_in, ml_conv_w, ml_i_bias, ml_f_bias, ml_gn_w, ml_w_out):
    for i in range(DEPTH):
        kind, j = i % N_MIXERS, i // N_MIXERS
        if kind == 0:
            y = gated_deltanet_mixer(x, dn_w_in[j], dn_conv_w[j], dn_a_log[j], dn_dt_bias[j],
                                     dn_norm_w[j], dn_w_out[j])
        elif kind == 1:
            y = rwkv7_mixer(x, rw_w_in[j], rw_mu[j], rw_w0[j], rw_w_lora_up[j], rw_a0[j], rw_a_lora_up[j],
                            rw_k_k[j], rw_k_a[j], rw_r_k[j], rw_gn_w[j], rw_gn_b[j], rw_w_out[j])
        else:
            y = mlstm_mixer(x, ml_w_in[j], ml_conv_w[j], ml_i_bias[j], ml_f_bias[j], ml_gn_w[j], ml_w_out[j])
        x = layer_norm(DEEPNORM_ALPHA * x + y, ln_g[i], ln_b[i])
        gate = jax.nn.sigmoid((x @ ple_w_gate[i]).astype(jnp.float32))
        x = (x.astype(jnp.float32) + gate * rms_norm(p[i] @ ple_w_proj[i], ple_norm_w[i])).astype(x.dtype)
    return x
```

```cpp
#include <hip/hip_runtime.h>
#include <hip/hip_cooperative_groups.h>
#include <cstdio>
#include <cstddef>
namespace cg = cooperative_groups;

#ifndef PHMASK
#define PHMASK 0xFFFF
#endif
#ifndef SOLVE_N
#define SOLVE_N 64
#endif
#define HAS(b) ((PHMASK >> (b)) & 1)
#ifndef MULTI_LAUNCH
#define MULTI_LAUNCH 0
#endif

#define LAS __attribute__((address_space(3)))
typedef unsigned short bf16_t;
typedef short bf16x8 __attribute__((ext_vector_type(8)));
typedef float f32x4 __attribute__((ext_vector_type(4)));
typedef unsigned u32x4 __attribute__((ext_vector_type(4)));
typedef unsigned u32x2 __attribute__((ext_vector_type(2)));

constexpr int MTOK = 32768, DM = 1024, SEQ = 4096, NB = 8, NLAYER = 4, DPLE = 256;
constexpr int NH = 4352;
constexpr float ALPHA = 1.681792830507429f;
constexpr int NTHR = 512;
constexpr int LDS_BYTES = 131072 + 16;

constexpr size_t MiB = 1048576;
constexpr size_t WS_X = 0;
constexpr size_t WS_H = 128 * MiB;
constexpr size_t WS_W = 400 * MiB;
constexpr size_t W_IN_BYTES = (size_t)NH * 1024 * 2;
constexpr size_t WS_W_DN0 = WS_W;
constexpr size_t WS_W_DN1 = WS_W_DN0 + W_IN_BYTES;
constexpr size_t WS_W_RW = WS_W_DN1 + W_IN_BYTES;
constexpr size_t WS_W_ML = WS_W_RW + 2 * W_IN_BYTES;
constexpr size_t WS_W_OUT = WS_W_ML + W_IN_BYTES;
constexpr size_t WS_W_GATE = WS_W_OUT + 4 * 2 * MiB;
constexpr size_t WS_W_PROJ = WS_W_GATE + 4 * 2 * MiB;
constexpr size_t WS_P = WS_W_PROJ + 2 * MiB;
constexpr size_t WS_BONUS = WS_P + 16 * MiB;
constexpr size_t WS_BAR = WS_BONUS + 2 * MiB;
constexpr size_t WS_END = WS_BAR + 65536;

struct Args { const float* in[31]; float* out; unsigned char* ws; int ph_lo, ph_hi; };
#define AS4 __attribute__((address_space(4)))
typedef const AS4 unsigned char* kargp_t;
struct KA { kargp_t p;
    __device__ __forceinline__ const float* in(int i) const { return *(const float* const AS4*)(p + 8 * i); }
    __device__ __forceinline__ float* out() const { return *(float* const AS4*)(p + 248); }
    __device__ __forceinline__ unsigned char* ws() const { return *(unsigned char* const AS4*)(p + 256); }
};
static_assert(offsetof(Args, out) == 248 && offsetof(Args, ws) == 256, "kernarg layout");

__device__ __forceinline__ int ltid() { int t = (int)threadIdx.x; asm volatile("" : "+v"(t)); return t; }
__device__ __forceinline__ int lbid() { int t = (int)blockIdx.x; asm volatile("" : "+s"(t)); return t; }
__device__ __forceinline__ float bf2f(bf16_t b) { return __uint_as_float(((unsigned)b) << 16); }
__device__ __forceinline__ float bflo(unsigned u) { return __uint_as_float(u << 16); }
__device__ __forceinline__ float bfhi(unsigned u) { return __uint_as_float(u & 0xffff0000u); }
typedef float f32x2_ __attribute__((ext_vector_type(2)));
typedef __bf16 bf16x2_ __attribute__((ext_vector_type(2)));
__device__ __forceinline__ unsigned pk_bf16(float lo, float hi) { const f32x2_ v = {lo, hi}; return __builtin_bit_cast(unsigned, __builtin_convertvector(v, bf16x2_)); }
__device__ __forceinline__ float sigmoidf_(float x) { return __builtin_amdgcn_rcpf(1.0f + __expf(-x)); }
__device__ __forceinline__ float siluf_(float x) { return x * __builtin_amdgcn_rcpf(1.0f + __expf(-x)); }
__device__ __forceinline__ float softplusf_(float x) { return x > 20.f ? x : log1pf(__expf(x)); }
template <int CTRL> __device__ __forceinline__ float dppf(float x) { return __builtin_bit_cast(float, __builtin_amdgcn_mov_dpp(__builtin_bit_cast(int, x), CTRL, 0xf, 0xf, true)); }
__device__ __forceinline__ float row16_sum(float v) { v += dppf<0xB1>(v); v += dppf<0x4E>(v); v += dppf<0x124>(v); v += dppf<0x128>(v); return v; }
__device__ __forceinline__ float row8_sum(float v) { v += dppf<0xB1>(v); v += dppf<0x4E>(v); v += dppf<0x141>(v); return v; }
__device__ __forceinline__ float quad_sum(float v) { v += dppf<0xB1>(v); v += dppf<0x4E>(v); return v; }
__device__ __forceinline__ float wave_sum(float v) { v = row16_sum(v); v += __shfl_xor(v, 16, 64); v += __shfl_xor(v, 32, 64); return v; }
template <int CTRL, int RM> __device__ __forceinline__ float dpp_old(float oldv, float x) { return __builtin_bit_cast(float, __builtin_amdgcn_update_dpp(__builtin_bit_cast(int, oldv), __builtin_bit_cast(int, x), CTRL, RM, 0xf, false)); }
__device__ __forceinline__ float wave_scan_add(float v) {
    v += dpp_old<0x111, 0xf>(0.f, v); v += dpp_old<0x112, 0xf>(0.f, v); v += dpp_old<0x114, 0xf>(0.f, v); v += dpp_old<0x118, 0xf>(0.f, v);
    v += dpp_old<0x142, 0xa>(0.f, v); v += dpp_old<0x143, 0xc>(0.f, v); return v; }
__device__ __forceinline__ float wave_scan_max(float v) {
    const float ninf = -__builtin_inff();
    v = fmaxf(v, dpp_old<0x111, 0xf>(ninf, v)); v = fmaxf(v, dpp_old<0x112, 0xf>(ninf, v)); v = fmaxf(v, dpp_old<0x114, 0xf>(ninf, v)); v = fmaxf(v, dpp_old<0x118, 0xf>(ninf, v));
    v = fmaxf(v, dpp_old<0x142, 0xa>(ninf, v)); v = fmaxf(v, dpp_old<0x143, 0xc>(ninf, v)); return v; }
__device__ __forceinline__ void unpack8(const u32x4 r, float (&f)[8]) {
    f[0] = bflo(r.x); f[1] = bfhi(r.x); f[2] = bflo(r.y); f[3] = bfhi(r.y); f[4] = bflo(r.z); f[5] = bfhi(r.z); f[6] = bflo(r.w); f[7] = bfhi(r.w);
}

__device__ __forceinline__ bf16x8 ldfrag(const bf16_t* base, int ld, int r0, int k0, int lane) { return *(const bf16x8*)(base + (r0 + (lane & 15)) * ld + k0 + (lane >> 4) * 8); }
#define MFMA16(a, b, c) __builtin_amdgcn_mfma_f32_16x16x32_bf16(a, b, c, 0, 0, 0)
__device__ __forceinline__ bf16_t f2bf1(float x) { return (bf16_t)(pk_bf16(x, x) & 0xffffu); }

namespace pg8 {
constexpr int BM = 256, BK = 64, HALF = 128, HTB = HALF * BK * 2, STAGE_BYTES = 8 * HTB, NXCD = 8, WGM = 8;
__host__ __device__ __forceinline__ int lds_byte(int r, int c) { const int st = (r >> 4) * 2 + (c >> 5), rr = r & 15, cc = c & 31, ob = rr * 64 + cc * 2; return st * 1024 + (ob ^ (((ob >> 9) & 1) << 5)); }
__host__ __device__ __forceinline__ void stage_rc(int b, int& R, int& C) { const int st = b / 1024, sb = b % 1024, swz = sb ^ (((sb >> 9) & 1) << 5); R = (st >> 1) * 16 + swz / 64; C = (st & 1) * 32 + (swz % 64) / 2; }
__host__ __device__ __forceinline__ int perm32(int rho) { const int n = rho >> 4, i = rho & 15; return 8 * (i >> 2) + 4 * n + (i & 3); }
struct Unit { int pm, pn; };
struct Gemm { const bf16_t* A; const bf16_t* Bt; int M, N, K; };
struct StaticOrder {
    int nM, nN, nwg, G, c;
    __device__ void init(int M, int N, int G_, int c_) { nM = M / BM; nN = N / BM; nwg = nM * nN; G = G_; c = c_; }
    __device__ bool next(int i, Unit& u) const {
        const long L = (long)i * G + c; if (L >= nwg) return false;
        int wgid = (int)L; { const int q = nwg / NXCD, r = nwg % NXCD, xcd = wgid % NXCD, off = wgid / NXCD; wgid = (xcd < r ? xcd * (q + 1) : r * (q + 1) + (xcd - r) * q) + off; }
        const int nig = WGM * nN, gid = wgid / nig, fm = gid * WGM, gsz = (nM - fm) < WGM ? (nM - fm) : WGM;
        u.pm = fm + ((wgid % nig) % gsz); u.pn = (wgid % nig) / gsz; return true;
    }
};
struct EpiBf16 {
    static constexpr bool PERM = true;
    bf16_t* O; int ldc; int act;
    __device__ __forceinline__ void operator()(const f32x4 (&acc)[2][2][4][2], const Unit& u, int wr, int wc, int fr, int fq) const {
        const int row0 = u.pm * BM + wr * 64 + fr; const int col0 = u.pn * BM + wc * 32 + 8 * fq;
#pragma unroll
        for (int ai = 0; ai < 2; ++ai)
#pragma unroll
            for (int m = 0; m < 4; ++m) { bf16_t* rowp = O + (size_t)(row0 + ai * HALF + m * 16) * ldc + col0;
#pragma unroll
                for (int bj = 0; bj < 2; ++bj) { f32x4 v0 = acc[ai][bj][m][0], v1 = acc[ai][bj][m][1];
                    if (act) {
#pragma unroll
                        for (int j = 0; j < 4; ++j) { v0[j] = sigmoidf_(v0[j]); v1[j] = sigmoidf_(v1[j]); } }
                    u32x4 w; w.x = pk_bf16(v0[0], v0[1]); w.y = pk_bf16(v0[2], v0[3]); w.z = pk_bf16(v1[0], v1[1]); w.w = pk_bf16(v1[2], v1[3]);
                    *(u32x4*)(rowp + bj * HALF) = w; } }
    }
};
struct EpiF32 {
    static constexpr bool PERM = false;
    float* C; int ldc; const float* R; float rscale;
    __device__ __forceinline__ void operator()(const f32x4 (&acc)[2][2][4][2], const Unit& u, int wr, int wc, int fr, int fq) const {
        const int row0 = u.pm * BM + wr * 64 + fr, col0 = u.pn * BM + wc * 32 + 4 * fq;
#pragma unroll
        for (int ai = 0; ai < 2; ++ai)
#pragma unroll
            for (int m = 0; m < 4; ++m) { const size_t ro = (size_t)(row0 + ai * HALF + m * 16) * ldc + col0;
#pragma unroll
                for (int bj = 0; bj < 2; ++bj)
#pragma unroll
                    for (int n = 0; n < 2; ++n) { f32x4 v = acc[ai][bj][m][n];
                        if (R) { const f32x4 r = *(const f32x4*)(R + ro + bj * HALF + n * 16); v = v + r * rscale; }
                        *(f32x4*)(C + ro + bj * HALF + n * 16) = v; } }
    }
};

template <class Epi>
__device__ __forceinline__ void gemm_phase(LAS unsigned char* lds, const Gemm g, const StaticOrder& S, const Epi& E) {
    const int tid = ltid(), wid = __builtin_amdgcn_readfirstlane(tid >> 6), lane = tid & 63, wr = wid >> 2, wc = wid & 3, fr = lane & 15, fq = lane >> 4;
    const int K = g.K, nt = K / BK;
    unsigned voffA[2], voffB[2];
#pragma unroll
    for (int i = 0; i < 2; ++i) { int R, C; stage_rc(tid * 16 + i * 8192, R, C); const int Rb = Epi::PERM ? ((R & ~31) + perm32(R & 31)) : R;
        voffA[i] = (unsigned)(R * K + C) * 2u; voffB[i] = (unsigned)(Rb * K + C) * 2u; }
    const size_t kstep = (size_t)(BK * 2);
    const size_t hstep = (size_t)HALF * K * 2;
    const size_t tstep = 2 * hstep;
    const unsigned ldsw = (unsigned)wid * 1024u;
    const int aoff = lds_byte(wr * 64 + fr, fq * 8), boff = lds_byte(wc * 32 + fr, fq * 8);
#define PG8_SA(b, h) (((b) * 2 + (h)) * HTB)
#define PG8_SB(b, h) ((4 + (b) * 2 + (h)) * HTB)
#define PG8_STAGE(bufoff, gbase, voff) do { _Pragma("unroll") for (int _i = 0; _i < 2; ++_i) \
        __builtin_amdgcn_global_load_lds((const unsigned*)((const char*)(gbase) + (voff)[_i]), (LAS unsigned*)(lds + (bufoff) + ldsw + _i * 8192), 16, 0, 0); } while (0)
#define PG8_LDA(dst, b, h) do { _Pragma("unroll") for (int m = 0; m < 4; ++m) _Pragma("unroll") for (int k = 0; k < 2; ++k) dst[m][k] = *(const LAS bf16x8*)(lds + PG8_SA(b, h) + aoff + m * 2048 + k * 1024); } while (0)
#define PG8_LDB(dst, b, h) do { _Pragma("unroll") for (int n = 0; n < 2; ++n) _Pragma("unroll") for (int k = 0; k < 2; ++k) dst[n][k] = *(const LAS bf16x8*)(lds + PG8_SB(b, h) + boff + n * 2048 + k * 1024); } while (0)
#define PG8_MMA(ai, bj, At, Bt) do { __builtin_amdgcn_s_setprio(1); _Pragma("unroll") for (int m = 0; m < 4; ++m) _Pragma("unroll") for (int n = 0; n < 2; ++n) _Pragma("unroll") for (int k = 0; k < 2; ++k) \
        acc[ai][bj][m][n] = __builtin_amdgcn_mfma_f32_16x16x32_bf16(Bt[n][k], At[m][k], acc[ai][bj][m][n], 0, 0, 0); __builtin_amdgcn_s_setprio(0); } while (0)
#define PG8_WAIT_V(n) asm volatile("s_waitcnt vmcnt(" #n ")" ::: "memory")
#define PG8_WAIT_L(n) asm volatile("s_waitcnt lgkmcnt(" #n ")" ::: "memory")
#define PG8_BAR __builtin_amdgcn_s_barrier()
#define PG8_SCHED __builtin_amdgcn_sched_barrier(0)
    Unit cur, nxt; int ui = 0;
    if (!S.next(0, cur)) return;
    f32x4 acc[2][2][4][2];
#pragma unroll
    for (int a = 0; a < 2; ++a)
#pragma unroll
        for (int b = 0; b < 2; ++b)
#pragma unroll
            for (int m = 0; m < 4; ++m)
#pragma unroll
                for (int n = 0; n < 2; ++n) acc[a][b][m][n] = (f32x4){0.f, 0.f, 0.f, 0.f};
    bf16x8 At[4][2], B0[2][2], B1[2][2];
    const char* cA = (const char*)g.A + (size_t)cur.pm * tstep; const char* cB = (const char*)g.Bt + (size_t)cur.pn * tstep;
    PG8_STAGE(PG8_SB(0, 0), cB, voffB); PG8_STAGE(PG8_SA(0, 0), cA, voffA); PG8_STAGE(PG8_SB(0, 1), cB + hstep, voffB); PG8_STAGE(PG8_SA(0, 1), cA + hstep, voffA);
    if (wr == 1) PG8_BAR;
    PG8_WAIT_V(4); PG8_BAR;
    PG8_STAGE(PG8_SB(1, 0), cB + kstep, voffB); PG8_STAGE(PG8_SA(1, 0), cA + kstep, voffA); PG8_STAGE(PG8_SB(1, 1), cB + hstep + kstep, voffB);
    PG8_WAIT_V(6); PG8_BAR;
    for (;;) {
        const bool has_next = S.next(ui + 1, nxt);
        const char* nA = has_next ? (const char*)g.A + (size_t)nxt.pm * tstep : cA; const char* nB = has_next ? (const char*)g.Bt + (size_t)nxt.pn * tstep : cB;
        for (int t = 0; t < nt; t += 2) {
            const bool last = (t == nt - 2);
            const char* a1 = cA + (size_t)(t + 1) * kstep;
            const char* a2 = last ? nA : cA + (size_t)(t + 2) * kstep; const char* b2 = last ? nB : cB + (size_t)(t + 2) * kstep;
            const char* a3 = a2 + kstep; const char* b3 = b2 + kstep;
            PG8_LDB(B0, 0, 0); PG8_SCHED; PG8_LDA(At, 0, 0); PG8_STAGE(PG8_SA(1, 1), a1 + hstep, voffA);
            PG8_WAIT_L(8); PG8_BAR; PG8_WAIT_L(0); PG8_MMA(0, 0, At, B0); PG8_BAR; PG8_SCHED;
            PG8_LDB(B1, 0, 1); PG8_STAGE(PG8_SB(0, 0), b2, voffB);
            PG8_BAR; PG8_WAIT_L(0); PG8_MMA(0, 1, At, B1); PG8_BAR;
            PG8_LDA(At, 0, 1); PG8_STAGE(PG8_SA(0, 0), a2, voffA);
            PG8_BAR; PG8_WAIT_L(0); PG8_MMA(1, 0, At, B0); PG8_BAR; PG8_SCHED;
            PG8_STAGE(PG8_SB(0, 1), b2 + hstep, voffB);
            PG8_WAIT_V(6); PG8_BAR; PG8_MMA(1, 1, At, B1); PG8_BAR;
            PG8_LDB(B0, 1, 0); PG8_SCHED; PG8_LDA(At, 1, 0); PG8_STAGE(PG8_SA(0, 1), a2 + hstep, voffA);
            PG8_WAIT_L(8); PG8_BAR; PG8_WAIT_L(0); PG8_MMA(0, 0, At, B0); PG8_BAR; PG8_SCHED;
            PG8_LDB(B1, 1, 1); PG8_STAGE(PG8_SB(1, 0), b3, voffB);
            PG8_BAR; PG8_WAIT_L(0); PG8_MMA(0, 1, At, B1); PG8_BAR;
            PG8_LDA(At, 1, 1); PG8_STAGE(PG8_SA(1, 0), a3, voffA);
            PG8_BAR; PG8_WAIT_L(0); PG8_MMA(1, 0, At, B0); PG8_BAR; PG8_SCHED;
            PG8_STAGE(PG8_SB(1, 1), b3 + hstep, voffB);
            PG8_WAIT_V(6); PG8_BAR; PG8_MMA(1, 1, At, B1); PG8_BAR;
        }
        E(acc, cur, wr, wc, fr, fq);
        if (!has_next) break;
#pragma unroll
        for (int a = 0; a < 2; ++a)
#pragma unroll
            for (int b = 0; b < 2; ++b)
#pragma unroll
                for (int m = 0; m < 4; ++m)
#pragma unroll
                    for (int n = 0; n < 2; ++n) acc[a][b][m][n] = (f32x4){0.f, 0.f, 0.f, 0.f};
        cur = nxt; cA = nA; cB = nB; ++ui;
    }
    PG8_WAIT_V(0);
    if (wr == 0) PG8_BAR;
    PG8_BAR;
#undef PG8_SA
#undef PG8_SB
#undef PG8_STAGE
#undef PG8_LDA
#undef PG8_LDB
#undef PG8_MMA
#undef PG8_WAIT_V
#undef PG8_WAIT_L
#undef PG8_BAR
#undef PG8_SCHED
}
}

struct Seg { int in_idx, src_off, ldsrc, scol0, len, K, dst_off, ldk, koff, n0, mumode, mu_off; };
#define OFFW(x) ((int)((x) - WS_W))
__constant__ Seg g_segs[] = {
    {7, 0, 4112, 0, 4112, 1024, OFFW(WS_W_DN0), 1024, 0, 0, 0, 0}, {7, 0, 0, 0, 240, 1024, OFFW(WS_W_DN0), 1024, 0, 4112, 3, 0},
    {7, 1024 * 4112, 4112, 0, 4112, 1024, OFFW(WS_W_DN1), 1024, 0, 0, 0, 0}, {7, 0, 0, 0, 240, 1024, OFFW(WS_W_DN1), 1024, 0, 4112, 3, 0},
    {25, 0, 4112, 0, 4112, 1024, OFFW(WS_W_ML), 1024, 0, 0, 0, 0}, {25, 0, 0, 0, 240, 1024, OFFW(WS_W_ML), 1024, 0, 4112, 3, 0},
    {13, 0, 4224, 0, 1024, 1024, OFFW(WS_W_RW), 2048, 0, 0, 1, 0 * 1024}, {13, 0, 4224, 0, 1024, 1024, OFFW(WS_W_RW), 2048, 1024, 0, 2, 0 * 1024},
    {13, 0, 4224, 1088, 1024, 1024, OFFW(WS_W_RW), 2048, 0, 1024, 1, 2 * 1024}, {13, 0, 4224, 1088, 1024, 1024, OFFW(WS_W_RW), 2048, 1024, 1024, 2, 2 * 1024},
    {13, 0, 4224, 2112, 1024, 1024, OFFW(WS_W_RW), 2048, 0, 2048, 1, 3 * 1024}, {13, 0, 4224, 2112, 1024, 1024, OFFW(WS_W_RW), 2048, 1024, 2048, 2, 3 * 1024},
    {13, 0, 4224, 3200, 1024, 1024, OFFW(WS_W_RW), 2048, 0, 3072, 1, 5 * 1024}, {13, 0, 4224, 3200, 1024, 1024, OFFW(WS_W_RW), 2048, 1024, 3072, 2, 5 * 1024},
    {13, 0, 4224, 1024, 64, 1024, OFFW(WS_W_RW), 2048, 0, 4096, 1, 1 * 1024}, {13, 0, 4224, 1024, 64, 1024, OFFW(WS_W_RW), 2048, 1024, 4096, 2, 1 * 1024},
    {13, 0, 4224, 3136, 64, 1024, OFFW(WS_W_RW), 2048, 0, 4160, 1, 4 * 1024}, {13, 0, 4224, 3136, 64, 1024, OFFW(WS_W_RW), 2048, 1024, 4160, 2, 4 * 1024},
    {13, 0, 0, 0, 128, 2048, OFFW(WS_W_RW), 2048, 0, 4224, 3, 0},
    {12, 0, 1024, 0, 1024, 1024, OFFW(WS_W_OUT + 0 * 2 * MiB), 1024, 0, 0, 0, 0}, {24, 0, 1024, 0, 1024, 1024, OFFW(WS_W_OUT + 1 * 2 * MiB), 1024, 0, 0, 0, 0},
    {30, 0, 1024, 0, 1024, 1024, OFFW(WS_W_OUT + 2 * 2 * MiB), 1024, 0, 0, 0, 0}, {12, 1024 * 1024, 1024, 0, 1024, 1024, OFFW(WS_W_OUT + 3 * 2 * MiB), 1024, 0, 0, 0, 0},
    {6, 0 * 1024 * 1024, 1024, 0, 1024, 1024, OFFW(WS_W_GATE + 0 * 2 * MiB), 1024, 0, 0, 0, 0}, {6, 1 * 1024 * 1024, 1024, 0, 1024, 1024, OFFW(WS_W_GATE + 1 * 2 * MiB), 1024, 0, 0, 0, 0},
    {6, 2 * 1024 * 1024, 1024, 0, 1024, 1024, OFFW(WS_W_GATE + 2 * 2 * MiB), 1024, 0, 0, 0, 0}, {6, 3 * 1024 * 1024, 1024, 0, 1024, 1024, OFFW(WS_W_GATE + 3 * 2 * MiB), 1024, 0, 0, 0, 0},
    {4, 0 * 256 * 1024, 1024, 0, 1024, 256, OFFW(WS_W_PROJ + 0 * (MiB / 2)), 256, 0, 0, 0, 0}, {4, 1 * 256 * 1024, 1024, 0, 1024, 256, OFFW(WS_W_PROJ + 1 * (MiB / 2)), 256, 0, 0, 0, 0},
    {4, 2 * 256 * 1024, 1024, 0, 1024, 256, OFFW(WS_W_PROJ + 2 * (MiB / 2)), 256, 0, 0, 0, 0}, {4, 3 * 256 * 1024, 1024, 0, 1024, 256, OFFW(WS_W_PROJ + 3 * (MiB / 2)), 256, 0, 0, 0, 0},
};
constexpr int N_SEGS = 6 + 13 + 4 + 4 + 4;

__device__ __forceinline__ void phase_prep(const KA a, unsigned char* lds_) {
    const size_t gtid = (size_t)lbid() * NTHR + ltid(), gsz = (size_t)gridDim.x * NTHR;
    { const float* x = a.in(0); bf16_t* xb = (bf16_t*)(a.ws() + WS_X);
      const size_t n8 = (size_t)MTOK * DM / 8;
      for (size_t i = gtid; i < n8; i += 4 * gsz) {
          f32x4 v0[4], v1[4];
#pragma unroll
          for (int q = 0; q < 4; ++q) { const size_t ii = i + q * gsz; if (ii < n8) { v0[q] = *(const f32x4*)(x + ii * 8); v1[q] = *(const f32x4*)(x + ii * 8 + 4); } }
#pragma unroll
          for (int q = 0; q < 4; ++q) { const size_t ii = i + q * gsz; if (ii < n8) {
              u32x4 w; w.x = pk_bf16(v0[q][0], v0[q][1]); w.y = pk_bf16(v0[q][2], v0[q][3]); w.z = pk_bf16(v1[q][0], v1[q][1]); w.w = pk_bf16(v1[q][2], v1[q][3]); *(u32x4*)(xb + ii * 8) = w; } } } }
    bf16_t* tl = (bf16_t*)lds_;
    const int tid = ltid(), G = (int)gridDim.x;
    const int lk = tid >> 3, ln8 = (tid & 7) * 8;
#define PREP_NT(SG) ((((SG).len + 63) >> 6) * ((SG).K >> 6))
    int cs = 0, ct = lbid(), cnt = PREP_NT(g_segs[0]);
    while (cs < N_SEGS && ct >= cnt) { ct -= cnt; ++cs; if (cs < N_SEGS) cnt = PREP_NT(g_segs[cs]); }
    f32x4 r0 = {0.f, 0.f, 0.f, 0.f}, r1 = r0; float rsc = 1.f;
#define PREP_LOAD(S_, T_) do { const Seg q = g_segs[S_]; const int ntn = (q.len + 63) >> 6, tn = (T_) % ntn, tk = (T_) / ntn; const int k = tk * 64 + lk, n = tn * 64 + ln8; \
        r0 = (f32x4){0.f, 0.f, 0.f, 0.f}; r1 = r0; rsc = 1.f; \
        if (q.mumode != 3 && n < q.len) { const float* sp = a.in(q.in_idx) + q.src_off + (size_t)k * q.ldsrc + q.scol0 + n; r0 = *(const f32x4*)sp; r1 = *(const f32x4*)(sp + 4); \
            if (q.mumode == 1) rsc = 1.0f - a.in(14)[q.mu_off + k]; else if (q.mumode == 2) rsc = a.in(14)[q.mu_off + k]; } } while (0)
    if (cs < N_SEGS) PREP_LOAD(cs, ct);
    int buf = 0;
    while (cs < N_SEGS) {
        int ns = cs, nt = ct + G, nnt = cnt;
        while (ns < N_SEGS && nt >= nnt) { nt -= nnt; ++ns; if (ns < N_SEGS) nnt = PREP_NT(g_segs[ns]); }
        bf16_t* tb = tl + buf * (64 * 72);
        { const f32x4 v0 = r0 * rsc, v1 = r1 * rsc;
          tb[(ln8 + 0) * 72 + lk] = f2bf1(v0[0]); tb[(ln8 + 1) * 72 + lk] = f2bf1(v0[1]); tb[(ln8 + 2) * 72 + lk] = f2bf1(v0[2]); tb[(ln8 + 3) * 72 + lk] = f2bf1(v0[3]);
          tb[(ln8 + 4) * 72 + lk] = f2bf1(v1[0]); tb[(ln8 + 5) * 72 + lk] = f2bf1(v1[1]); tb[(ln8 + 6) * 72 + lk] = f2bf1(v1[2]); tb[(ln8 + 7) * 72 + lk] = f2bf1(v1[3]); }
        const Seg cq = g_segs[cs]; const int cntn = (cq.len + 63) >> 6, ctn = ct % cntn, ctk = ct / cntn;
        if (ns < N_SEGS) PREP_LOAD(ns, nt);
        __syncthreads();
        { const int n = ctn * 64 + (tid >> 3), kp = (tid & 7) * 8;
          if (n < cq.len) *(u32x4*)((bf16_t*)(a.ws() + WS_W + (size_t)cq.dst_off) + (size_t)(cq.n0 + n) * cq.ldk + cq.koff + ctk * 64 + kp) = *(const u32x4*)(tb + (tid >> 3) * 72 + kp); }
        buf ^= 1; cs = ns; ct = nt; cnt = nnt;
    }
#undef PREP_LOAD
#undef PREP_NT
}

template <int NC, int TC, int FN  >
__device__ __forceinline__ void cols_load(const bf16_t* __restrict__ h, size_t row0, int col0, float* dst, int dstride, int vt) {
    constexpr int NV = NC / 8, NITEM = NV * TC;
    for (int it = vt; it < NITEM; it += NTHR) {
        const int vc = it % NV, t = it / NV, c = vc * 8;
        const u32x4 r = *(const u32x4*)(h + (row0 + t) * NH + col0 + c);
        float f[8]; unpack8(r, f);
        float* d = dst + (size_t)t * dstride + c;
#pragma unroll
        for (int e = 0; e < 8; ++e) d[e] = FN == 1 ? tanhf(f[e]) : f[e];
    }
}
__device__ __forceinline__ int vtid(int shift) { return (int)((ltid() + NTHR - shift) & (NTHR - 1)); }

__device__ __forceinline__ void phase_dn_post(const KA a, int j) {
    const bf16_t* h = (const bf16_t*)(a.ws() + WS_H);
    const bf16_t* O = (const bf16_t*)(a.ws() + WS_X + 64 * MiB);
    bf16_t* Y = (bf16_t*)(a.ws() + WS_X);
#define DNO(R) (O + ((size_t)((((R) >> 12) * 8 + (lane >> 3)) * 64 + (((R) & 4095) >> 6)) * 8192 + ((R) & 63) * 128 + (lane & 7) * 16))
    const int lane = ltid() & 63, wid = ltid() >> 6;
    const float* nw = a.in(11) + j * 128 + (lane & 7) * 16;
    float w[16];
#pragma unroll
    for (int e = 0; e < 16; ++e) w[e] = nw[e];
    const int stride = (int)gridDim.x * 8;
    int row = lbid() * 8 + wid;
    u32x4 no0, no1, nz0, nz1;
    if (row < MTOK) { no0 = *(const u32x4*)DNO(row); no1 = *(const u32x4*)(DNO(row) + 8);
        nz0 = *(const u32x4*)(h + (size_t)row * NH + 3072 + lane * 16); nz1 = *(const u32x4*)(h + (size_t)row * NH + 3072 + lane * 16 + 8); }
    for (; row < MTOK; row += stride) {
        float o[16], z[16];
        unpack8(no0, *(float(*)[8])&o[0]); unpack8(no1, *(float(*)[8])&o[8]); unpack8(nz0, *(float(*)[8])&z[0]); unpack8(nz1, *(float(*)[8])&z[8]);
        const int nr = row + stride;
        if (nr < MTOK) { no0 = *(const u32x4*)DNO(nr); no1 = *(const u32x4*)(DNO(nr) + 8);
            nz0 = *(const u32x4*)(h + (size_t)nr * NH + 3072 + lane * 16); nz1 = *(const u32x4*)(h + (size_t)nr * NH + 3072 + lane * 16 + 8); }
        float ss = 0.f;
#pragma unroll
        for (int e = 0; e < 16; ++e) ss += o[e] * o[e];
        ss = row8_sum(ss);
        const float sc = rsqrtf(ss * (1.0f / 128.0f) + 1e-6f);
        float y[16];
#pragma unroll
        for (int e = 0; e < 16; ++e) y[e] = o[e] * sc * w[e] * siluf_(z[e]);
        u32x4 w0, w1; w0.x = pk_bf16(y[0], y[1]); w0.y = pk_bf16(y[2], y[3]); w0.z = pk_bf16(y[4], y[5]); w0.w = pk_bf16(y[6], y[7]);
        w1.x = pk_bf16(y[8], y[9]); w1.y = pk_bf16(y[10], y[11]); w1.z = pk_bf16(y[12], y[13]); w1.w = pk_bf16(y[14], y[15]);
        *(u32x4*)(Y + (size_t)row * DM + lane * 16) = w0; *(u32x4*)(Y + (size_t)row * DM + lane * 16 + 8) = w1;
    }
#undef DNO
}

__device__ __forceinline__ float tanh_fast(float x) { const float e = __expf(2.0f * x); return 1.0f - 2.0f * __builtin_amdgcn_rcpf(e + 1.0f); }
__device__ __forceinline__ int xcd_unit(int u) { return ((u & 7) << 5) | ((u >> 3) & 31); }
__device__ __forceinline__ void phase_rw_scan3(const KA a, unsigned char* shm_) {
    const bf16_t* h = (const bf16_t*)(a.ws() + WS_H);
    bf16_t* O = (bf16_t*)(a.ws() + WS_X);
    float* bonus = (float*)(a.ws() + WS_BONUS);
    float* osb = (float*)(shm_ + 90112);
    bf16_t* WL = (bf16_t*)(shm_ + 98304); bf16_t* AL = (bf16_t*)(shm_ + 102912); bf16_t* WUPT = (bf16_t*)(shm_ + 107520); bf16_t* AUPT = (bf16_t*)(shm_ + 116736);
    const int tid0 = ltid();
    for (int unit = lbid(); unit < NB * 16 * 2; unit += gridDim.x) {
        const int un_ = (gridDim.x == 256) ? xcd_unit(unit) : unit; const int b = un_ >> 5, hd = (un_ >> 1) & 15, half = un_ & 1;
        const int tid = tid0, wid = tid >> 6, lane = tid & 63, quad = lane >> 4, l15 = lane & 15;
        const bool producer = wid >= 4;
        const int ptid = tid & 255, pw = ptid >> 6;
        __syncthreads();
        for (int i = tid; i < 4096; i += NTHR) { const int jj = i >> 6, c = i & 63;
            WUPT[c * 72 + jj] = f2bf1(a.in(16)[jj * 1024 + hd * 64 + c]); AUPT[c * 72 + jj] = f2bf1(a.in(18)[jj * 1024 + hd * 64 + c]); }
        const int cm = pw * 16 + l15;
        const float w0c = a.in(15)[hd * 64 + cm], a0c = a.in(17)[hd * 64 + cm], kkc = a.in(19)[hd * 64 + cm], kac = a.in(20)[hd * 64 + cm];
        const int rpart = ptid & 7;
        const f32x4 rkA = *(const f32x4*)(a.in(21) + hd * 64 + rpart * 8), rkB = *(const f32x4*)(a.in(21) + hd * 64 + rpart * 8 + 4);
        const int pt = ptid >> 3, pvc = ptid & 7, vt_ = (ptid & 127) >> 2, vvc = ptid & 3;
        const size_t rowb = (size_t)b * SEQ;
        u32x4 p0 = {0u, 0u, 0u, 0u}, p1 = p0, p2 = p0, p3 = p0, p4 = p0;
#define RW3_PREFETCH(CH) do { const size_t rn = rowb + (size_t)(CH) * 32; \
            p0 = *(const u32x4*)(h + (rn + pt) * NH + hd * 64 + pvc * 8); p1 = *(const u32x4*)(h + (rn + pt) * NH + 1024 + hd * 64 + pvc * 8); \
            p2 = *(const u32x4*)(h + (rn + pt) * NH + 4096 + pvc * 8); p3 = *(const u32x4*)(h + (rn + pt) * NH + 4160 + pvc * 8); \
            if (ptid < 128) p4 = *(const u32x4*)(h + (rn + vt_) * NH + 2048 + hd * 64 + half * 32 + vvc * 8); } while (0)
        if (producer) RW3_PREFETCH(0);
        const int crow = (wid & 3) * 8 + (lane >> 3), kq = lane & 7;
        f32x2_ S0 = {0.f, 0.f}, S1 = S0, S2 = S0, S3 = S0;
        for (int c = -1; c < SEQ / 32; ++c) {
            const int cb = c & 1, nb = (c + 1) & 1;
            float* rsC = (float*)(shm_ + cb * 45056); float* dsC = rsC + 2048; float* kpC = rsC + 4096; float* kkC = rsC + 6144; float* kaC = rsC + 8192; float* vsC = rsC + 10240;
            float* rsN = (float*)(shm_ + nb * 45056); float* dsN = rsN + 2048; float* kpN = rsN + 4096; float* kkN = rsN + 6144; float* kaN = rsN + 8192; float* vsN = rsN + 10240;
            float* osC = osb + cb * 1024; float* osP = osb + nb * 1024;
            const bool cact = (c >= 0), pact = (c + 1 < SEQ / 32);
            __syncthreads();
#pragma unroll 1
            for (int seg = 0; seg < 4; ++seg) {
                if (!producer) {
                    if (seg == 0 && c >= 1) {
                        const int t = tid >> 3, c4 = (tid & 7) * 4; const f32x4 v = *(const f32x4*)(osP + t * 32 + c4);
                        u32x2 w; w.x = pk_bf16(v[0], v[1]); w.y = pk_bf16(v[2], v[3]);
                        *(u32x2*)(O + (rowb + (size_t)(c - 1) * 32 + t) * DM + hd * 64 + half * 32 + c4) = w; }
                    if (cact) {
                        float yv[8];
                        f32x4 nkA, nkB, naA, naB, ndA, ndB, npA, npB, nrA, nrB; float nvv;
#define RW3_LD(T) do { const int o_ = (T) * 64 + kq * 8; nkA = *(const f32x4*)(kkC + o_); nkB = *(const f32x4*)(kkC + o_ + 4); naA = *(const f32x4*)(kaC + o_); naB = *(const f32x4*)(kaC + o_ + 4); \
                            ndA = *(const f32x4*)(dsC + o_); ndB = *(const f32x4*)(dsC + o_ + 4); npA = *(const f32x4*)(kpC + o_); npB = *(const f32x4*)(kpC + o_ + 4); \
                            nrA = *(const f32x4*)(rsC + o_); nrB = *(const f32x4*)(rsC + o_ + 4); nvv = vsC[(T) * 32 + crow]; } while (0)
                        RW3_LD(seg * 8);
#pragma unroll
                        for (int tt = 0; tt < 8; ++tt) { const int t = seg * 8 + tt;
                            const f32x4 kkA = nkA, kkB = nkB, kaA = naA, kaB = naB, dA = ndA, dB = ndB, kpA = npA, kpB = npB, rA = nrA, rB = nrB; const float vv = nvv;
                            if (tt < 7) RW3_LD(t + 1);
                            f32x2_ p = S0 * (f32x2_){kkA[0], kkA[1]}; p = S1 * (f32x2_){kkA[2], kkA[3]} + p; p = S2 * (f32x2_){kkB[0], kkB[1]} + p; p = S3 * (f32x2_){kkB[2], kkB[3]} + p;
                            float sa = -(p[0] + p[1]);
                            sa = row8_sum(sa);
                            const f32x2_ sa2 = {sa, sa}, vv2 = {vv, vv};
                            S0 = S0 * (f32x2_){dA[0], dA[1]} + sa2 * (f32x2_){kaA[0], kaA[1]} + vv2 * (f32x2_){kpA[0], kpA[1]};
                            S1 = S1 * (f32x2_){dA[2], dA[3]} + sa2 * (f32x2_){kaA[2], kaA[3]} + vv2 * (f32x2_){kpA[2], kpA[3]};
                            S2 = S2 * (f32x2_){dB[0], dB[1]} + sa2 * (f32x2_){kaB[0], kaB[1]} + vv2 * (f32x2_){kpB[0], kpB[1]};
                            S3 = S3 * (f32x2_){dB[2], dB[3]} + sa2 * (f32x2_){kaB[2], kaB[3]} + vv2 * (f32x2_){kpB[2], kpB[3]};
                            f32x2_ q2 = S0 * (f32x2_){rA[0], rA[1]}; q2 = S1 * (f32x2_){rA[2], rA[3]} + q2; q2 = S2 * (f32x2_){rB[0], rB[1]} + q2; q2 = S3 * (f32x2_){rB[2], rB[3]} + q2;
                            float y = q2[0] + q2[1];
                            y = row8_sum(y);
                            yv[tt] = y;
                        }
#undef RW3_LD
                        if (kq == 0) {
#pragma unroll
                            for (int tt = 0; tt < 8; ++tt) osC[(seg * 8 + tt) * 32 + crow] = yv[tt]; }
                    }
                } else if (pact) {
                    if (seg == 0) {
                        float f[8];
                        unpack8(p0, f); { float* d = rsN + pt * 64 + pvc * 8; *(f32x4*)d = (f32x4){f[0], f[1], f[2], f[3]}; *(f32x4*)(d + 4) = (f32x4){f[4], f[5], f[6], f[7]}; }
                        unpack8(p1, f); { float* d = kpN + pt * 64 + pvc * 8; *(f32x4*)d = (f32x4){f[0], f[1], f[2], f[3]}; *(f32x4*)(d + 4) = (f32x4){f[4], f[5], f[6], f[7]}; }
                        unpack8(p2, f); { u32x4 w; w.x = pk_bf16(tanh_fast(f[0]), tanh_fast(f[1])); w.y = pk_bf16(tanh_fast(f[2]), tanh_fast(f[3]));
                            w.z = pk_bf16(tanh_fast(f[4]), tanh_fast(f[5])); w.w = pk_bf16(tanh_fast(f[6]), tanh_fast(f[7])); *(u32x4*)(WL + pt * 72 + pvc * 8) = w; }
                        *(u32x4*)(AL + pt * 72 + pvc * 8) = p3;
                        if (ptid < 128) { unpack8(p4, f); float* dv = vsN + vt_ * 32 + vvc * 8; *(f32x4*)dv = (f32x4){f[0], f[1], f[2], f[3]}; *(f32x4*)(dv + 4) = (f32x4){f[4], f[5], f[6], f[7]}; }
                        if (c + 2 < SEQ / 32) RW3_PREFETCH(c + 2);
                    } else if (seg == 1) {
#pragma unroll
                        for (int rt = 0; rt < 2; ++rt) {
                            f32x4 aw = {0.f, 0.f, 0.f, 0.f}, aa = {0.f, 0.f, 0.f, 0.f};
                            aw = MFMA16(ldfrag(WL, 72, rt * 16, 0, lane), ldfrag(WUPT, 72, pw * 16, 0, lane), aw); aw = MFMA16(ldfrag(WL, 72, rt * 16, 32, lane), ldfrag(WUPT, 72, pw * 16, 32, lane), aw);
                            aa = MFMA16(ldfrag(AL, 72, rt * 16, 0, lane), ldfrag(AUPT, 72, pw * 16, 0, lane), aa); aa = MFMA16(ldfrag(AL, 72, rt * 16, 32, lane), ldfrag(AUPT, 72, pw * 16, 32, lane), aa);
#pragma unroll
                            for (int jj = 0; jj < 4; ++jj) { const int t = rt * 16 + quad * 4 + jj;
                                const float sw = w0c + aw[jj], sa_ = a0c + aa[jj];
                                const float av = sigmoidf_(sa_);
                                const float kraw = kpN[t * 64 + cm];
                                dsN[t * 64 + cm] = __expf(-0.6065306597f * sigmoidf_(sw));
                                kkN[t * 64 + cm] = kraw * kkc;
                                kpN[t * 64 + cm] = kraw * (1.0f + (av - 1.0f) * kac);
                                kaN[t * 64 + cm] = av; } }
                    } else if (seg == 2) {
                        const int t = ptid >> 3;
                        float* pk_ = kkN + t * 64 + rpart * 8; float* pa_ = kaN + t * 64 + rpart * 8;
                        const f32x4 k0 = *(const f32x4*)pk_, k1 = *(const f32x4*)(pk_ + 4), a0 = *(const f32x4*)pa_, a1 = *(const f32x4*)(pa_ + 4);
                        const f32x4 r0 = *(const f32x4*)(rsN + t * 64 + rpart * 8), r1 = *(const f32x4*)(rsN + t * 64 + rpart * 8 + 4);
                        const f32x4 q0 = *(const f32x4*)(kpN + t * 64 + rpart * 8), q1 = *(const f32x4*)(kpN + t * 64 + rpart * 8 + 4);
                        const float ss = row8_sum(k0[0] * k0[0] + k0[1] * k0[1] + k0[2] * k0[2] + k0[3] * k0[3] + k1[0] * k1[0] + k1[1] * k1[1] + k1[2] * k1[2] + k1[3] * k1[3]);
                        const float inv = rsqrtf(ss + 1e-6f);
                        const f32x4 n0 = k0 * inv, n1 = k1 * inv;
                        *(f32x4*)pk_ = n0; *(f32x4*)(pk_ + 4) = n1; *(f32x4*)pa_ = n0 * a0; *(f32x4*)(pa_ + 4) = n1 * a1;
                        const float bo = row8_sum(r0[0] * q0[0] * rkA[0] + r0[1] * q0[1] * rkA[1] + r0[2] * q0[2] * rkA[2] + r0[3] * q0[3] * rkA[3]
                                                  + r1[0] * q1[0] * rkB[0] + r1[1] * q1[1] * rkB[1] + r1[2] * q1[2] * rkB[2] + r1[3] * q1[3] * rkB[3]);
                        if (half == 0 && rpart == 0) bonus[(rowb + (size_t)(c + 1) * 32 + t) * 16 + hd] = bo;
                    }
                }
                if (seg < 3) __syncthreads();
            }
        }
        __syncthreads();
        if (!producer) {
            const int cl = SEQ / 32 - 1; const float* osL = osb + (cl & 1) * 1024;
            const int t = tid >> 3, c4 = (tid & 7) * 4; const f32x4 v = *(const f32x4*)(osL + t * 32 + c4);
            u32x2 w; w.x = pk_bf16(v[0], v[1]); w.y = pk_bf16(v[2], v[3]);
            *(u32x2*)(O + (rowb + (size_t)cl * 32 + t) * DM + hd * 64 + half * 32 + c4) = w; }
#undef RW3_PREFETCH
    }
}
__device__ __forceinline__ void phase_rw_post(const KA a) {
    const bf16_t* h = (const bf16_t*)(a.ws() + WS_H);
    const bf16_t* O = (const bf16_t*)(a.ws() + WS_X);
    const float* bonus = (const float*)(a.ws() + WS_BONUS);
    bf16_t* Y = (bf16_t*)(a.ws() + WS_X + 64 * MiB);
    const int lane = ltid() & 63, wid = ltid() >> 6;
    float gw[16], gb[16];
#pragma unroll
    for (int e = 0; e < 16; ++e) { gw[e] = a.in(22)[lane * 16 + e]; gb[e] = a.in(23)[lane * 16 + e]; }
    const int stride = (int)gridDim.x * 8;
    int row = lbid() * 8 + wid;
    u32x4 n0[6]; float nbo = 0.f;
#define RWP_LOAD(R) do { n0[0] = *(const u32x4*)(O + (size_t)(R) * DM + lane * 16); n0[1] = *(const u32x4*)(O + (size_t)(R) * DM + lane * 16 + 8); \
        n0[2] = *(const u32x4*)(h + (size_t)(R) * NH + 3072 + lane * 16); n0[3] = *(const u32x4*)(h + (size_t)(R) * NH + 3072 + lane * 16 + 8); \
        n0[4] = *(const u32x4*)(h + (size_t)(R) * NH + 2048 + lane * 16); n0[5] = *(const u32x4*)(h + (size_t)(R) * NH + 2048 + lane * 16 + 8); \
        nbo = bonus[(size_t)(R) * 16 + (lane >> 2)]; } while (0)
    if (row < MTOK) RWP_LOAD(row);
    for (; row < MTOK; row += stride) {
        float o[16], z[16], v[16];
        unpack8(n0[0], *(float(*)[8])&o[0]); unpack8(n0[1], *(float(*)[8])&o[8]); unpack8(n0[2], *(float(*)[8])&z[0]); unpack8(n0[3], *(float(*)[8])&z[8]);
        unpack8(n0[4], *(float(*)[8])&v[0]); unpack8(n0[5], *(float(*)[8])&v[8]);
        const float bo = nbo;
        const int nr = row + stride;
        if (nr < MTOK) RWP_LOAD(nr);
        float s = 0.f;
#pragma unroll
        for (int e = 0; e < 16; ++e) s += o[e];
        s = quad_sum(s);
        const float mu = s * (1.0f / 64.0f);
        float ss = 0.f;
#pragma unroll
        for (int e = 0; e < 16; ++e) { const float d = o[e] - mu; ss += d * d; }
        ss = quad_sum(ss);
        const float sc = rsqrtf(ss * (1.0f / 64.0f) + 64e-5f);
        float y[16];
#pragma unroll
        for (int e = 0; e < 16; ++e) y[e] = ((o[e] - mu) * sc * gw[e] + gb[e] + bo * v[e]) * siluf_(z[e]);
        u32x4 w0, w1; w0.x = pk_bf16(y[0], y[1]); w0.y = pk_bf16(y[2], y[3]); w0.z = pk_bf16(y[4], y[5]); w0.w = pk_bf16(y[6], y[7]);
        w1.x = pk_bf16(y[8], y[9]); w1.y = pk_bf16(y[10], y[11]); w1.z = pk_bf16(y[12], y[13]); w1.w = pk_bf16(y[14], y[15]);
        *(u32x4*)(Y + (size_t)row * DM + lane * 16) = w0; *(u32x4*)(Y + (size_t)row * DM + lane * 16 + 8) = w1;
    }
#undef RWP_LOAD
}

__device__ __forceinline__ bf16_t* dn_seg(bf16_t* h, size_t row0, int hd, int sgi) { const int ar = sgi / 61, r = sgi - ar * 61; return h + (row0 + r) * NH + ar * 1024 + hd * 128; }
__device__ __forceinline__ void phase_dn_prep2(const KA a, int j, unsigned char* shm_) {
    bf16_t* h = (bf16_t*)(a.ws() + WS_H);
    float* E63 = (float*)(a.ws() + WS_BONUS);
    const float* convw = a.in(8) + (size_t)j * 4 * 3072;
    bf16_t* Kraw = (bf16_t*)shm_; bf16_t* KT = (bf16_t*)(shm_ + 17408); bf16_t* VT = (bf16_t*)(shm_ + 35840);
    float* Ap = (float*)(shm_ + 54272); bf16_t* T1 = (bf16_t*)(shm_ + 70656); bf16_t* T2 = (bf16_t*)(shm_ + 79872);
    float* gt = (float*)(shm_ + 89088); float* bet = gt; float* Gs = gt + 64; float* eG = gt + 128; float* rk = gt + 192;
    bf16_t* Vraw = (bf16_t*)(shm_ + 90112); bf16_t* Qraw = (bf16_t*)(shm_ + 107520);
    float* rq = (float*)(shm_ + 124928); float* kds = rq + 64; float* rqp = rq + 128;
    const int tid0 = ltid();
#define DNP_IDX(T) const int tid = (T), wid = tid >> 6, lane = tid & 63, quad = lane >> 4, l15 = lane & 15, cidx = tid & 255, cvc = cidx & 31, ctg = cidx >> 5, cisv = tid >> 8, qc2 = tid & 63, qtg = tid >> 6; (void)quad; (void)l15
    u32x2 praw[11]; unsigned qraw[11]; float pbp = 0.f, pap = 0.f;
#define DNP_PREFETCH(U) do { const int ch_ = (U) & 63, hd_ = ((U) >> 6) & 7, b_ = (U) >> 9; const int t0p = ch_ * 64; const size_t rowp = (size_t)b_ * SEQ + t0p; \
        const int hc = 1024 + cisv * 1024 + hd_ * 128 + cvc * 4; const int hq = hd_ * 128 + qc2 * 2; \
        _Pragma("unroll") for (int i = 0; i < 11; ++i) { const int tl = ctg * 8 - 3 + i; \
            if (t0p + tl >= 0) praw[i] = *(const u32x2*)(h + (size_t)((long)rowp + tl) * NH + hc); else praw[i] = (u32x2){0u, 0u}; } \
        _Pragma("unroll") for (int i = 0; i < 11; ++i) { const int tl = qtg * 8 - 3 + i; \
            if (t0p + tl >= 0) qraw[i] = *(const unsigned*)(h + (size_t)((long)rowp + tl) * NH + hq); else qraw[i] = 0u; } \
        if (wid == 5) { pbp = bf2f(h[(rowp + lane) * NH + 4096 + hd_]); pap = bf2f(h[(rowp + lane) * NH + 4104 + hd_]); } } while (0)
    { DNP_IDX(tid0); const int u0 = lbid(); if (u0 < NB * 8 * 64) DNP_PREFETCH(u0); }
    for (int unit = lbid(); unit < NB * 8 * 64; unit += gridDim.x) {
        int tl_ = tid0; asm volatile("" : "+v"(tl_));
        DNP_IDX(tl_);
        const int ch = unit & 63, hd = (unit >> 6) & 7, b = unit >> 9;
        const int t0 = ch * 64; const size_t row0 = (size_t)b * SEQ + t0;
        bf16_t* Wg = (bf16_t*)(a.ws() + WS_X + (size_t)unit * 16384); bf16_t* Ug = (bf16_t*)(a.ws() + WS_X + 64 * MiB + (size_t)unit * 16384);
        f32x4 pwv[4]; f32x2_ qwv[4];
#pragma unroll
        for (int jw = 0; jw < 4; ++jw) { pwv[jw] = *(const f32x4*)(convw + jw * 3072 + 1024 + cisv * 1024 + hd * 128 + cvc * 4); qwv[jw] = *(const f32x2_*)(convw + jw * 3072 + hd * 128 + qc2 * 2); }
        __syncthreads();
        {
            bf16_t* rm = cisv ? Vraw : Kraw;
            f32x4 x0, x1, x2, x3;
#define DN_X(i) ((f32x4){bflo(praw[i].x), bfhi(praw[i].x), bflo(praw[i].y), bfhi(praw[i].y)})
            x1 = DN_X(0); x2 = DN_X(1); x3 = DN_X(2);
#pragma unroll
            for (int i = 3; i < 11; ++i) {
                x0 = x1; x1 = x2; x2 = x3; x3 = DN_X(i);
                const f32x4 y = pwv[0] * x0 + pwv[1] * x1 + pwv[2] * x2 + pwv[3] * x3;
                u32x2 o; o.x = pk_bf16(siluf_(y[0]), siluf_(y[1])); o.y = pk_bf16(siluf_(y[2]), siluf_(y[3]));
                *(u32x2*)(rm + (ctg * 8 + i - 3) * 136 + cvc * 4) = o;
            }
#undef DN_X
            __builtin_amdgcn_sched_barrier(0);
            f32x2_ q0, q1, q2, q3;
#define DN_Q(i) ((f32x2_){bflo(qraw[i]), bfhi(qraw[i])})
            q1 = DN_Q(0); q2 = DN_Q(1); q3 = DN_Q(2);
#pragma unroll
            for (int i = 3; i < 11; ++i) {
                q0 = q1; q1 = q2; q2 = q3; q3 = DN_Q(i);
                const f32x2_ y = qwv[0] * q0 + qwv[1] * q1 + qwv[2] * q2 + qwv[3] * q3;
                *(unsigned*)(Qraw + (qtg * 8 + i - 3) * 136 + qc2 * 2) = pk_bf16(siluf_(y[0]), siluf_(y[1]));
            }
#undef DN_Q
        }
        if (wid == 5) { const int t = lane;
            float g = -__expf(a.in(9)[j * 8 + hd]) * softplusf_(pap + a.in(10)[j * 8 + hd]);
#pragma unroll
            for (int off = 1; off < 64; off <<= 1) { const float y = __shfl_up(g, off, 64); if (lane >= off) g += y; }
            bet[t] = sigmoidf_(pbp); Gs[t] = g; eG[t] = __expf(g);
            if (lane == 63) E63[unit] = __expf(g); }
        __syncthreads();
        {
            const int row = tid >> 2, part = tid & 3, which = row >> 6, t = row & 63;
            const bf16_t* src = (which ? Kraw : Qraw) + t * 136 + part * 32;
            float ss = 0.f;
#pragma unroll
            for (int q8 = 0; q8 < 4; ++q8) { float f[8]; unpack8(*(const u32x4*)(src + q8 * 8), f);
#pragma unroll
                for (int e = 0; e < 8; ++e) ss += f[e] * f[e]; }
            ss = quad_sum(ss);
            if (part == 0) { const float r = rsqrtf(ss + 1e-6f);
                if (which) { rk[t] = r; kds[t] = r * __expf(Gs[63] - Gs[t]); } else { rqp[t] = r * 0.08838834764831845f; rq[t] = r * 0.08838834764831845f * eG[t]; } } }
        __syncthreads();
        { const int d = tid & 127, jg = tid >> 7;
#pragma unroll
          for (int r = 0; r < 2; ++r) { const bf16_t* src = r ? Vraw : Kraw; bf16_t* dst = r ? VT : KT;
            bf16_t raw[16];
#pragma unroll
            for (int jj = 0; jj < 16; ++jj) raw[jj] = src[(jg * 16 + jj) * 136 + d];
            u32x4 w0, w1; w0.x = raw[0] | ((unsigned)raw[1] << 16); w0.y = raw[2] | ((unsigned)raw[3] << 16); w0.z = raw[4] | ((unsigned)raw[5] << 16); w0.w = raw[6] | ((unsigned)raw[7] << 16);
            w1.x = raw[8] | ((unsigned)raw[9] << 16); w1.y = raw[10] | ((unsigned)raw[11] << 16); w1.z = raw[12] | ((unsigned)raw[13] << 16); w1.w = raw[14] | ((unsigned)raw[15] << 16);
            *(u32x4*)(dst + d * 72 + jg * 16) = w0; *(u32x4*)(dst + d * 72 + jg * 16 + 8) = w1;
            if (r == 0) { float kv[16];
#pragma unroll
                for (int jj = 0; jj < 16; ++jj) kv[jj] = bf2f(raw[jj]) * kds[jg * 16 + jj];
                u32x4 g0, g1; g0.x = pk_bf16(kv[0], kv[1]); g0.y = pk_bf16(kv[2], kv[3]); g0.z = pk_bf16(kv[4], kv[5]); g0.w = pk_bf16(kv[6], kv[7]);
                g1.x = pk_bf16(kv[8], kv[9]); g1.y = pk_bf16(kv[10], kv[11]); g1.z = pk_bf16(kv[12], kv[13]); g1.w = pk_bf16(kv[14], kv[15]);
                bf16_t* kp_ = dn_seg(h, row0, hd, 64 + (d >> 1)) + (d & 1) * 64 + jg * 16;
                *(u32x4*)kp_ = g0; *(u32x4*)(kp_ + 8) = g1; }
            __builtin_amdgcn_sched_barrier(0); } }
        {
            const int t = tid >> 3, c16 = (tid & 7) * 16; const float sc = rq[t];
            float f[8]; u32x4 o0, o1;
            unpack8(*(const u32x4*)(Qraw + t * 136 + c16), f);
            o0.x = pk_bf16(f[0] * sc, f[1] * sc); o0.y = pk_bf16(f[2] * sc, f[3] * sc); o0.z = pk_bf16(f[4] * sc, f[5] * sc); o0.w = pk_bf16(f[6] * sc, f[7] * sc);
            unpack8(*(const u32x4*)(Qraw + t * 136 + c16 + 8), f);
            o1.x = pk_bf16(f[0] * sc, f[1] * sc); o1.y = pk_bf16(f[2] * sc, f[3] * sc); o1.z = pk_bf16(f[4] * sc, f[5] * sc); o1.w = pk_bf16(f[6] * sc, f[7] * sc);
            bf16_t* qp_ = dn_seg(h, row0, hd, t) + c16;
            *(u32x4*)qp_ = o0; *(u32x4*)(qp_ + 8) = o1; }
        __builtin_amdgcn_sched_barrier(0);
        { const int rt = wid >> 1;
#pragma unroll
          for (int c2 = 0; c2 < 2; ++c2) { const int ct = (wid & 1) * 2 + c2;
            f32x4 acc = {0.f, 0.f, 0.f, 0.f}, accp = {0.f, 0.f, 0.f, 0.f};
#pragma unroll
            for (int k0 = 0; k0 < 128; k0 += 32) { const bf16x8 bk = ldfrag(Kraw, 136, ct * 16, k0, lane);
                acc = MFMA16(ldfrag(Kraw, 136, rt * 16, k0, lane), bk, acc); accp = MFMA16(ldfrag(Qraw, 136, rt * 16, k0, lane), bk, accp); }
            const int jc = ct * 16 + l15; const float rkj = rk[jc], Gj = Gs[jc];
#pragma unroll
            for (int jj = 0; jj < 4; ++jj) { const int i = rt * 16 + quad * 4 + jj;
                const float dec = __expf(Gs[i] - Gj);
                const float av = (jc < i) ? bet[i] * rk[i] * rkj * dec * acc[jj] : 0.f;
                Ap[i * 64 + (jc & 7) * 8 + (jc >> 3)] = av;
                const float pv = (jc <= i) ? rqp[i] * rkj * dec * accp[jj] : 0.f;
                dn_seg(h, row0, hd, 128 + (i >> 1))[(i & 1) * 64 + jc] = f2bf1(pv); } } }
        __syncthreads();
        { const int un = unit + (int)gridDim.x; if (un < NB * 8 * 64) DNP_PREFETCH(un); }
        {
            const int c = wid * 8 + (lane >> 3), js = lane & 7;
            float Tl[8];
#pragma unroll
            for (int m = 0; m < 8; ++m) Tl[m] = 0.f;
            if (js == 0) Tl[0] = (c == 0) ? 1.f : 0.f;
#pragma unroll
            for (int i = 1; i < 64; ++i) {
                const f32x4 c0 = *(const f32x4*)(Ap + i * 64 + js * 8);
                f32x4 c1 = {0.f, 0.f, 0.f, 0.f};
                if (i > 32) c1 = *(const f32x4*)(Ap + i * 64 + js * 8 + 4);
                float part = 0.f;
#pragma unroll
                for (int m = 0; m < (i + 7) / 8; ++m) part += (m < 4 ? c0[m & 3] : c1[m & 3]) * Tl[m];
                const float sres = row8_sum(part);
                const float val = ((i == c) ? 1.f : 0.f) - sres;
                if (js == (i & 7)) Tl[i >> 3] = val;
            }
            const float s1 = bet[c], s2 = bet[c] * eG[c] * rk[c];
#pragma unroll
            for (int m = 0; m < 8; ++m) { const int i = js + 8 * m; T1[i * 72 + c] = f2bf1(Tl[m] * s1); T2[i * 72 + c] = f2bf1(Tl[m] * s2); }
        }
        __syncthreads();
        {
            const bf16x8 bv0 = ldfrag(VT, 72, wid * 16, 0, lane), bv1 = ldfrag(VT, 72, wid * 16, 32, lane);
            const bf16x8 bk0 = ldfrag(KT, 72, wid * 16, 0, lane), bk1 = ldfrag(KT, 72, wid * 16, 32, lane);
#pragma unroll
            for (int rt = 0; rt < 4; ++rt) {
                f32x4 au = {0.f, 0.f, 0.f, 0.f}, aw = {0.f, 0.f, 0.f, 0.f};
                au = MFMA16(ldfrag(T1, 72, rt * 16, 0, lane), bv0, au); au = MFMA16(ldfrag(T1, 72, rt * 16, 32, lane), bv1, au);
                aw = MFMA16(ldfrag(T2, 72, rt * 16, 0, lane), bk0, aw); aw = MFMA16(ldfrag(T2, 72, rt * 16, 32, lane), bk1, aw);
#pragma unroll
                for (int jj = 0; jj < 4; ++jj) { const int i = rt * 16 + quad * 4 + jj;
                    Ug[i * 128 + wid * 16 + l15] = f2bf1(au[jj]); Wg[i * 128 + wid * 16 + l15] = f2bf1(aw[jj]); } }
        }
    }
#undef DNP_PREFETCH
#undef DNP_IDX
}
__device__ __forceinline__ void phase_dn_chunk2(const KA a, int j, unsigned char* shm_) {
    bf16_t* h = (bf16_t*)(a.ws() + WS_H);
    const float* E63 = (const float*)(a.ws() + WS_BONUS);
    bf16_t* Qsl = (bf16_t*)shm_; bf16_t* KdT = (bf16_t*)(shm_ + 34816); bf16_t* Wbf = (bf16_t*)(shm_ + 53248);
    bf16_t* ST = (bf16_t*)(shm_ + 70656); bf16_t* Pbf = (bf16_t*)(shm_ + 79360); bf16_t* VnT = (bf16_t*)(shm_ + 88576);
    const int tid = ltid(), wid = tid >> 6, lane = tid & 63, quad = lane >> 4, l15 = lane & 15;
    for (int unit = lbid(); unit < NB * 8 * 4; unit += gridDim.x) {
        const int un_ = (gridDim.x == 256) ? xcd_unit(unit) : unit; const int b = un_ >> 5, hd = (un_ >> 2) & 7, q4 = un_ & 3;
        f32x4 st0 = {0.f, 0.f, 0.f, 0.f}, st1 = {0.f, 0.f, 0.f, 0.f};
        __syncthreads();
        for (int i = tid; i < 32 * 136 / 2; i += NTHR) ((unsigned*)ST)[i] = 0u;
        const int rt = wid >> 1, et = wid & 1;
        const size_t rowb = (size_t)b * SEQ;
        const bf16_t* Wg0 = (const bf16_t*)(a.ws() + WS_X + (size_t)((b * 8 + hd) * 64) * 16384);
        bf16_t* Ug0 = (bf16_t*)(a.ws() + WS_X + 64 * MiB + (size_t)((b * 8 + hd) * 64) * 16384);
        u32x4 pq[2], pk_[2], pp, pw[2]; bf16_t pu[4]; float pe = 0.f;
#define DN2_PREFETCH(CH) do { const size_t r0p = rowb + (size_t)(CH) * 64; const bf16_t* Wgp = Wg0 + (size_t)(CH) * 8192; const bf16_t* Ugp = Ug0 + (size_t)(CH) * 8192; \
            _Pragma("unroll") for (int r = 0; r < 2; ++r) { const int p = tid + NTHR * r; \
                pq[r] = *(const u32x4*)(dn_seg(h, r0p, hd, p >> 4) + (p & 15) * 8); \
                const int d = p >> 3; pk_[r] = *(const u32x4*)(dn_seg(h, r0p, hd, 64 + (d >> 1)) + (d & 1) * 64 + (p & 7) * 8); \
                pw[r] = *(const u32x4*)(Wgp + (p >> 4) * 128 + (p & 15) * 8); } \
            { const int i = tid >> 3; pp = *(const u32x4*)(dn_seg(h, r0p, hd, 128 + (i >> 1)) + (i & 1) * 64 + (tid & 7) * 8); } \
            _Pragma("unroll") for (int jj = 0; jj < 4; ++jj) pu[jj] = Ugp[(rt * 16 + quad * 4 + jj) * 128 + q4 * 32 + et * 16 + l15]; \
            pe = E63[(b * 8 + hd) * 64 + (CH)]; } while (0)
        DN2_PREFETCH(0);
        for (int ch = 0; ch < SEQ / 64; ++ch) {
            __syncthreads();
#pragma unroll
            for (int r = 0; r < 2; ++r) { const int p = tid + NTHR * r;
                *(u32x4*)(Qsl + (p >> 4) * 136 + (p & 15) * 8) = pq[r];
                *(u32x4*)(KdT + (p >> 3) * 72 + (p & 7) * 8) = pk_[r];
                *(u32x4*)(Wbf + (p >> 4) * 136 + (p & 15) * 8) = pw[r]; }
            *(u32x4*)(Pbf + (tid >> 3) * 72 + (tid & 7) * 8) = pp;
            float ureg[4];
#pragma unroll
            for (int jj = 0; jj < 4; ++jj) ureg[jj] = bf2f(pu[jj]);
            const float eg63 = pe;
            if (ch + 1 < SEQ / 64) DN2_PREFETCH(ch + 1);
            __syncthreads();
            f32x4 accv = {0.f, 0.f, 0.f, 0.f}, acco = {0.f, 0.f, 0.f, 0.f};
#pragma unroll
            for (int k0 = 0; k0 < 128; k0 += 32) { const bf16x8 bs = ldfrag(ST, 136, et * 16, k0, lane);
                accv = MFMA16(ldfrag(Wbf, 136, rt * 16, k0, lane), bs, accv);
                acco = MFMA16(ldfrag(Qsl, 136, rt * 16, k0, lane), bs, acco); }
            { u32x2 w; w.x = pk_bf16(ureg[0] - accv[0], ureg[1] - accv[1]); w.y = pk_bf16(ureg[2] - accv[2], ureg[3] - accv[3]);
              *(u32x2*)(VnT + (et * 16 + l15) * 72 + rt * 16 + quad * 4) = w; }
            __syncthreads();
            acco = MFMA16(ldfrag(Pbf, 72, rt * 16, 0, lane), ldfrag(VnT, 72, et * 16, 0, lane), acco);
            acco = MFMA16(ldfrag(Pbf, 72, rt * 16, 32, lane), ldfrag(VnT, 72, et * 16, 32, lane), acco);
#pragma unroll
            for (int jj = 0; jj < 4; ++jj) { const int i = rt * 16 + quad * 4 + jj;
                Ug0[(size_t)ch * 8192 + i * 128 + q4 * 32 + et * 16 + l15] = f2bf1(acco[jj]); }
            { const bf16x8 ak0 = ldfrag(KdT, 72, wid * 16, 0, lane), ak1 = ldfrag(KdT, 72, wid * 16, 32, lane);
              st0 = st0 * eg63; st1 = st1 * eg63;
              st0 = MFMA16(ak0, ldfrag(VnT, 72, 0, 0, lane), st0); st0 = MFMA16(ak1, ldfrag(VnT, 72, 0, 32, lane), st0);
              st1 = MFMA16(ak0, ldfrag(VnT, 72, 16, 0, lane), st1); st1 = MFMA16(ak1, ldfrag(VnT, 72, 16, 32, lane), st1);
              u32x2 w; w.x = pk_bf16(st0[0], st0[1]); w.y = pk_bf16(st0[2], st0[3]);
              *(u32x2*)(ST + (l15) * 136 + wid * 16 + quad * 4) = w;
              w.x = pk_bf16(st1[0], st1[1]); w.y = pk_bf16(st1[2], st1[3]);
              *(u32x2*)(ST + (16 + l15) * 136 + wid * 16 + quad * 4) = w; }
        }
#undef DN2_PREFETCH
    }
}
__device__ __forceinline__ void phase_ml_chunk(const KA a, unsigned char* shm_) {
    const bf16_t* h = (const bf16_t*)(a.ws() + WS_H);
    bf16_t* O = (bf16_t*)(a.ws() + WS_X);
    const float* convw = a.in(26);
    float* qs = (float*)shm_; float* ks = qs + 4096; float* vs = qs + 8192; float* Hout = qs + 10240;
    bf16_t* Qbf = (bf16_t*)(shm_ + 53248); bf16_t* Kbf = Qbf + 64 * 72; bf16_t* KwT = Kbf + 64 * 72; bf16_t* Wbf = KwT + 64 * 72; bf16_t* VT = Wbf + 64 * 72; bf16_t* CT = VT + 48 * 72;
    float* gt = (float*)(shm_ + 103936);
    float* il = gt; float* fl = gt + 64; float* ra = gt + 128; float* cb = gt + 192; float* inter = gt + 256; float* kscale = gt + 320; float* em = gt + 384; float* misc = gt + 448;
    const int tid = ltid(), wid = tid >> 6, lane = tid & 63, quad = lane >> 4, l15 = lane & 15;
    for (int unit = lbid(); unit < NB * 8 * 4; unit += gridDim.x) {
        const int un_ = (gridDim.x == 256) ? xcd_unit(unit) : unit; const int b = un_ >> 5, hd = (un_ >> 2) & 7, q4 = un_ & 3;
        const float ib = a.in(27)[hd], fb = a.in(28)[hd];
        f32x4 st0 = {0.f, 0.f, 0.f, 0.f}, st1 = {0.f, 0.f, 0.f, 0.f};
        float m_prev = -1e30f;
        __syncthreads();
        for (int i = tid; i < 48 * 72 / 2; i += NTHR) ((unsigned*)CT)[i] = 0u;
        for (int i = tid; i < 16 * 72; i += NTHR) VT[32 * 72 + i] = (i < 72) ? (bf16_t)0x3F80 : (bf16_t)0;
        const int cidx = tid & 127, cvc = cidx & 15, ctg = cidx >> 4, cisk = (tid >> 7) & 1;
        const int chc = cisk * 512 + hd * 64 + cvc * 4;
        const int vt_ = (tid & 255) >> 2, vvc = tid & 3, vcol = 1024 + hd * 128 + q4 * 32 + vvc * 8;
        const size_t rowb = (size_t)b * SEQ;
        f32x4 cwv[4];
#pragma unroll
        for (int jw = 0; jw < 4; ++jw) cwv[jw] = *(const f32x4*)(convw + jw * 1024 + chc);
        u32x2 praw[11]; u32x4 pv = {0u, 0u, 0u, 0u}; float pip = 0.f, pfp = 0.f;
#define ML_PREFETCH(CH) do { const int t0p = (CH) * 64; \
            if (tid < 256) { _Pragma("unroll") for (int i = 0; i < 11; ++i) { const int tl = ctg * 8 - 3 + i; \
                if (t0p + tl >= 0) praw[i] = *(const u32x2*)(h + (size_t)((long)(rowb + t0p) + tl) * NH + chc); else praw[i] = (u32x2){0u, 0u}; } } \
            else pv = *(const u32x4*)(h + (rowb + t0p + vt_) * NH + vcol); \
            if (wid == 6) { pip = bf2f(h[(rowb + t0p + lane) * NH + 4096 + hd]); pfp = bf2f(h[(rowb + t0p + lane) * NH + 4104 + hd]); } } while (0)
        ML_PREFETCH(0);
        for (int ch = 0; ch < SEQ / 64; ++ch) {
            const int t0 = ch * 64; const size_t row0 = (size_t)b * SEQ + t0;
            __syncthreads();
            if (tid < 256) {
                float* dst = (cisk ? ks : qs) + cvc * 4; const float sc = cisk ? 0.125f : 1.0f;
                f32x4 x0, x1, x2, x3;
#define ML_X(i) ((f32x4){bflo(praw[i].x), bfhi(praw[i].x), bflo(praw[i].y), bfhi(praw[i].y)})
                x1 = ML_X(0); x2 = ML_X(1); x3 = ML_X(2);
#pragma unroll
                for (int i = 3; i < 11; ++i) {
                    x0 = x1; x1 = x2; x2 = x3; x3 = ML_X(i);
                    const f32x4 y = cwv[0] * x0 + cwv[1] * x1 + cwv[2] * x2 + cwv[3] * x3;
                    *(f32x4*)(dst + (ctg * 8 + i - 3) * 64) = (f32x4){siluf_(y[0]) * sc, siluf_(y[1]) * sc, siluf_(y[2]) * sc, siluf_(y[3]) * sc};
                }
#undef ML_X
            } else { float f[8]; unpack8(pv, f); float* dv = vs + vt_ * 32 + vvc * 8;
                *(f32x4*)dv = (f32x4){f[0], f[1], f[2], f[3]}; *(f32x4*)(dv + 4) = (f32x4){f[4], f[5], f[6], f[7]}; }
            if (wid == 6) { il[lane] = pip + ib; fl[lane] = -softplusf_(-(pfp + fb)); }
            if (ch + 1 < SEQ / 64) ML_PREFETCH(ch + 1);
            __syncthreads();
            {
                const int t = tid >> 3, c8 = (tid & 7) * 8;
                const f32x4 q0 = *(const f32x4*)(qs + t * 64 + c8), q1 = *(const f32x4*)(qs + t * 64 + c8 + 4);
                const f32x4 k0 = *(const f32x4*)(ks + t * 64 + c8), k1 = *(const f32x4*)(ks + t * 64 + c8 + 4);
                u32x4 w; w.x = pk_bf16(q0[0], q0[1]); w.y = pk_bf16(q0[2], q0[3]); w.z = pk_bf16(q1[0], q1[1]); w.w = pk_bf16(q1[2], q1[3]); *(u32x4*)(Qbf + t * 72 + c8) = w;
                w.x = pk_bf16(k0[0], k0[1]); w.y = pk_bf16(k0[2], k0[3]); w.z = pk_bf16(k1[0], k1[1]); w.w = pk_bf16(k1[2], k1[3]); *(u32x4*)(Kbf + t * 72 + c8) = w;
                const int c = tid & 31, jg = tid >> 5;
                u32x2 v2; v2.x = pk_bf16(vs[(jg * 4 + 0) * 32 + c], vs[(jg * 4 + 1) * 32 + c]); v2.y = pk_bf16(vs[(jg * 4 + 2) * 32 + c], vs[(jg * 4 + 3) * 32 + c]);
                *(u32x2*)(VT + c * 72 + jg * 4) = v2;
            }
            if (wid == 7) {
                const float f = fl[lane], iv = il[lane];
                const float bs = wave_scan_add(f);
                const float cbv = iv - bs;
                const float cm = wave_scan_max(cbv);
                const float mi = fmaxf(m_prev + bs, bs + cm);
                const float b63 = __shfl(bs, 63, 64), mnew = __shfl(mi, 63, 64);
                ra[lane] = bs - mi; cb[lane] = cbv; inter[lane] = __expf(m_prev + bs - mi); kscale[lane] = __expf(b63 - mnew + cbv); em[lane] = __expf(-mi);
                if (lane == 0) misc[0] = __expf(m_prev + b63 - mnew);
                m_prev = mnew;
            }
            __syncthreads();
            {
                const int rt = wid >> 1;
#pragma unroll
                for (int c2 = 0; c2 < 2; ++c2) { const int ct = (wid & 1) * 2 + c2;
                    f32x4 acc = {0.f, 0.f, 0.f, 0.f};
                    acc = MFMA16(ldfrag(Qbf, 72, rt * 16, 0, lane), ldfrag(Kbf, 72, ct * 16, 0, lane), acc);
                    acc = MFMA16(ldfrag(Qbf, 72, rt * 16, 32, lane), ldfrag(Kbf, 72, ct * 16, 32, lane), acc);
                    const int jc = ct * 16 + l15; const float cbj = cb[jc];
#pragma unroll
                    for (int jj = 0; jj < 4; ++jj) { const int i = rt * 16 + quad * 4 + jj;
                        const float wv = (jc <= i) ? __expf(ra[i] + cbj) * acc[jj] : 0.f;
                        Wbf[i * 72 + jc] = f2bf1(wv); } }
                const int d = tid & 63, jg = tid >> 6;
                float kv[8];
#pragma unroll
                for (int jj = 0; jj < 8; ++jj) kv[jj] = ks[(jg * 8 + jj) * 64 + d] * kscale[jg * 8 + jj];
                u32x4 w; w.x = pk_bf16(kv[0], kv[1]); w.y = pk_bf16(kv[2], kv[3]); w.z = pk_bf16(kv[4], kv[5]); w.w = pk_bf16(kv[6], kv[7]);
                *(u32x4*)(KwT + d * 72 + jg * 8) = w;
            }
            __syncthreads();
            { const float carry = misc[0];
#pragma unroll
              for (int r = 0; r < 2; ++r) { const int id = wid + 8 * r;
                if (id < 12) { const int rt = id / 3, ct = id - rt * 3;
                    f32x4 acc = {0.f, 0.f, 0.f, 0.f};
                    acc = MFMA16(ldfrag(Qbf, 72, rt * 16, 0, lane), ldfrag(CT, 72, ct * 16, 0, lane), acc);
                    acc = MFMA16(ldfrag(Qbf, 72, rt * 16, 32, lane), ldfrag(CT, 72, ct * 16, 32, lane), acc);
#pragma unroll
                    for (int jj = 0; jj < 4; ++jj) acc[jj] *= inter[rt * 16 + quad * 4 + jj];
                    acc = MFMA16(ldfrag(Wbf, 72, rt * 16, 0, lane), ldfrag(VT, 72, ct * 16, 0, lane), acc);
                    acc = MFMA16(ldfrag(Wbf, 72, rt * 16, 32, lane), ldfrag(VT, 72, ct * 16, 32, lane), acc);
#pragma unroll
                    for (int jj = 0; jj < 4; ++jj) Hout[(rt * 16 + quad * 4 + jj) * 48 + ct * 16 + l15] = acc[jj];
                    f32x4 st = r ? st1 : st0;
                    st = st * carry;
                    st = MFMA16(ldfrag(KwT, 72, rt * 16, 0, lane), ldfrag(VT, 72, ct * 16, 0, lane), st);
                    st = MFMA16(ldfrag(KwT, 72, rt * 16, 32, lane), ldfrag(VT, 72, ct * 16, 32, lane), st);
                    if (r) st1 = st; else st0 = st; } } }
            __syncthreads();
#pragma unroll
            for (int r = 0; r < 2; ++r) { const int id = wid + 8 * r;
                if (id < 12) { const int dt = id / 3, ct = id - dt * 3; const f32x4 st = r ? st1 : st0;
                    u32x2 w; w.x = pk_bf16(st[0], st[1]); w.y = pk_bf16(st[2], st[3]);
                    *(u32x2*)(CT + (ct * 16 + l15) * 72 + dt * 16 + quad * 4) = w; } }
            { const int t = tid >> 3, c4 = (tid & 7) * 4;
              const f32x4 num = *(const f32x4*)(Hout + t * 48 + c4); const float den = Hout[t * 48 + 32];
              const float dd = 1.0f / fmaxf(fabsf(den), em[t]);
              u32x2 w; w.x = pk_bf16(num[0] * dd, num[1] * dd); w.y = pk_bf16(num[2] * dd, num[3] * dd);
              *(u32x2*)(O + (row0 + t) * DM + hd * 128 + q4 * 32 + c4) = w; }
        }
    }
#undef ML_PREFETCH
}
__device__ __forceinline__ void phase_ml_post(const KA a) {
    const bf16_t* h = (const bf16_t*)(a.ws() + WS_H);
    const bf16_t* O = (const bf16_t*)(a.ws() + WS_X);
    bf16_t* Y = (bf16_t*)(a.ws() + WS_X + 64 * MiB);
    const int lane = ltid() & 63, wid = ltid() >> 6;
    float gw[16];
#pragma unroll
    for (int e = 0; e < 16; ++e) gw[e] = a.in(29)[lane * 16 + e];
    const int stride = (int)gridDim.x * 8;
    int row = lbid() * 8 + wid;
    u32x4 n0[6];
#define MLP_LOAD(R) do { n0[0] = *(const u32x4*)(O + (size_t)(R) * DM + lane * 16); n0[1] = *(const u32x4*)(O + (size_t)(R) * DM + lane * 16 + 8); \
        n0[2] = *(const u32x4*)(h + (size_t)(R) * NH + 3072 + lane * 16); n0[3] = *(const u32x4*)(h + (size_t)(R) * NH + 3072 + lane * 16 + 8); \
        n0[4] = *(const u32x4*)(h + (size_t)(R) * NH + 2048 + lane * 16); n0[5] = *(const u32x4*)(h + (size_t)(R) * NH + 2048 + lane * 16 + 8); } while (0)
    if (row < MTOK) MLP_LOAD(row);
    for (; row < MTOK; row += stride) {
        float o[16], z[16], g[16];
        unpack8(n0[0], *(float(*)[8])&o[0]); unpack8(n0[1], *(float(*)[8])&o[8]); unpack8(n0[2], *(float(*)[8])&z[0]); unpack8(n0[3], *(float(*)[8])&z[8]);
        unpack8(n0[4], *(float(*)[8])&g[0]); unpack8(n0[5], *(float(*)[8])&g[8]);
        const int nr = row + stride;
        if (nr < MTOK) MLP_LOAD(nr);
        float s = 0.f;
#pragma unroll
        for (int e = 0; e < 16; ++e) { o[e] *= sigmoidf_(g[e]); s += o[e]; }
        s = row8_sum(s);
        const float mu = s * (1.0f / 128.0f);
        float ss = 0.f;
#pragma unroll
        for (int e = 0; e < 16; ++e) { const float d = o[e] - mu; ss += d * d; }
        ss = row8_sum(ss);
        const float sc = rsqrtf(ss * (1.0f / 128.0f) + 1e-6f);
        float y[16];
#pragma unroll
        for (int e = 0; e < 16; ++e) y[e] = (o[e] - mu) * sc * gw[e] * siluf_(z[e]);
        u32x4 w0, w1; w0.x = pk_bf16(y[0], y[1]); w0.y = pk_bf16(y[2], y[3]); w0.z = pk_bf16(y[4], y[5]); w0.w = pk_bf16(y[6], y[7]);
        w1.x = pk_bf16(y[8], y[9]); w1.y = pk_bf16(y[10], y[11]); w1.z = pk_bf16(y[12], y[13]); w1.w = pk_bf16(y[14], y[15]);
        *(u32x4*)(Y + (size_t)row * DM + lane * 16) = w0; *(u32x4*)(Y + (size_t)row * DM + lane * 16 + 8) = w1;
    }
#undef MLP_LOAD
}

__device__ __forceinline__ void phase_ln(const KA a, int L) {
    const bf16_t* Yb = (const bf16_t*)(a.ws() + WS_H);
    const float* xr = (L == 0) ? a.in(0) : (const float*)a.out();
    bf16_t* xb = (bf16_t*)(a.ws() + WS_X);
    bf16_t* pb = (bf16_t*)(a.ws() + WS_P);
    const float* p = a.in(1) + (size_t)L * MTOK * DPLE;
    const float* lg = a.in(2) + L * DM; const float* lb = a.in(3) + L * DM;
    const int lane = ltid() & 63, wid = ltid() >> 6;
    f32x4 g[4], bb[4];
#pragma unroll
    for (int i = 0; i < 4; ++i) { g[i] = *(const f32x4*)(lg + i * 256 + lane * 4); bb[i] = *(const f32x4*)(lb + i * 256 + lane * 4); }
    const int stride = (int)gridDim.x * 8;
    int row = lbid() * 8 + wid;
    f32x4 nv[4], npv; u32x2 ny[4];
    if (row < MTOK) {
#pragma unroll
        for (int i = 0; i < 4; ++i) { nv[i] = *(const f32x4*)(xr + (size_t)row * DM + i * 256 + lane * 4); ny[i] = *(const u32x2*)(Yb + (size_t)row * DM + i * 256 + lane * 4); }
        npv = *(const f32x4*)(p + (size_t)row * DPLE + lane * 4); }
    for (; row < MTOK; row += stride) {
        f32x4 v[4]; const f32x4 pv = npv; float s = 0.f;
#pragma unroll
        for (int i = 0; i < 4; ++i) { v[i] = nv[i] * ALPHA + (f32x4){bflo(ny[i].x), bfhi(ny[i].x), bflo(ny[i].y), bfhi(ny[i].y)}; s += v[i][0] + v[i][1] + v[i][2] + v[i][3]; }
        const int nr = row + stride;
        if (nr < MTOK) {
#pragma unroll
            for (int i = 0; i < 4; ++i) { nv[i] = *(const f32x4*)(xr + (size_t)nr * DM + i * 256 + lane * 4); ny[i] = *(const u32x2*)(Yb + (size_t)nr * DM + i * 256 + lane * 4); }
            npv = *(const f32x4*)(p + (size_t)nr * DPLE + lane * 4); }
        const float mu = wave_sum(s) * (1.0f / 1024.0f);
        float ss = 0.f;
#pragma unroll
        for (int i = 0; i < 4; ++i) { v[i] = v[i] - mu; ss += v[i][0] * v[i][0] + v[i][1] * v[i][1] + v[i][2] * v[i][2] + v[i][3] * v[i][3]; }
        const float sc = rsqrtf(wave_sum(ss) * (1.0f / 1024.0f) + 1e-5f);
#pragma unroll
        for (int i = 0; i < 4; ++i) { const f32x4 y = v[i] * sc * g[i] + bb[i];
            u32x2 w; w.x = pk_bf16(y[0], y[1]); w.y = pk_bf16(y[2], y[3]); *(u32x2*)(xb + (size_t)row * DM + i * 256 + lane * 4) = w; }
        { u32x2 w; w.x = pk_bf16(pv[0], pv[1]); w.y = pk_bf16(pv[2], pv[3]); *(u32x2*)(pb + (size_t)row * DPLE + lane * 4) = w; }
    }
}
__device__ __forceinline__ void phase_combine(const KA a, int L) {
    const bf16_t* Yb = (const bf16_t*)(a.ws() + WS_H);
    const float* xr = (L == 0) ? a.in(0) : (const float*)a.out();
    const bf16_t* PP = (const bf16_t*)(a.ws() + WS_H + 128 * MiB);
    const bf16_t* G = (const bf16_t*)(a.ws() + WS_H + 192 * MiB);
    bf16_t* xb = (bf16_t*)(a.ws() + WS_X);
    const float* nw = a.in(5) + L * DM; const float* lg = a.in(2) + L * DM; const float* lb = a.in(3) + L * DM;
    const int lane = ltid() & 63, wid = ltid() >> 6;
    const int next_kind = (L + 1 < NLAYER) ? ((L + 1) % 3) : -1;
    const int stride = (int)gridDim.x * 8;
    int row = lbid() * 8 + wid;
    f32x4 ntv[4]; u32x2 npr[4], ngr[4], nyr[4];
    if (row < MTOK) {
#pragma unroll
        for (int i = 0; i < 4; ++i) { const size_t o = (size_t)row * DM + i * 256 + lane * 4; ntv[i] = *(const f32x4*)(xr + o); nyr[i] = *(const u32x2*)(Yb + o); npr[i] = *(const u32x2*)(PP + o); ngr[i] = *(const u32x2*)(G + o); } }
    for (; row < MTOK; row += stride) {
        f32x4 tv[4], pp[4]; u32x2 gr[4]; float s = 0.f, ss = 0.f;
#pragma unroll
        for (int i = 0; i < 4; ++i) { tv[i] = ntv[i] * ALPHA + (f32x4){bflo(nyr[i].x), bfhi(nyr[i].x), bflo(nyr[i].y), bfhi(nyr[i].y)}; gr[i] = ngr[i]; s += tv[i][0] + tv[i][1] + tv[i][2] + tv[i][3];
            pp[i] = (f32x4){bflo(npr[i].x), bfhi(npr[i].x), bflo(npr[i].y), bfhi(npr[i].y)};
            ss += pp[i][0] * pp[i][0] + pp[i][1] * pp[i][1] + pp[i][2] * pp[i][2] + pp[i][3] * pp[i][3]; }
        const int nr = row + stride;
        if (nr < MTOK) {
#pragma unroll
            for (int i = 0; i < 4; ++i) { const size_t o = (size_t)nr * DM + i * 256 + lane * 4; ntv[i] = *(const f32x4*)(xr + o); nyr[i] = *(const u32x2*)(Yb + o); npr[i] = *(const u32x2*)(PP + o); ngr[i] = *(const u32x2*)(G + o); } }
        const float mu = wave_sum(s) * (1.0f / 1024.0f);
        const float psc = rsqrtf(wave_sum(ss) * (1.0f / 1024.0f) + 1e-6f);
        float vs_ = 0.f;
#pragma unroll
        for (int i = 0; i < 4; ++i) { tv[i] = tv[i] - mu; vs_ += tv[i][0] * tv[i][0] + tv[i][1] * tv[i][1] + tv[i][2] * tv[i][2] + tv[i][3] * tv[i][3]; }
        const float lsc = rsqrtf(wave_sum(vs_) * (1.0f / 1024.0f) + 1e-5f);
#pragma unroll
        for (int i = 0; i < 4; ++i) {
            const int c = i * 256 + lane * 4; const size_t o = (size_t)row * DM + c;
            const f32x4 x1 = tv[i] * lsc * *(const f32x4*)(lg + c) + *(const f32x4*)(lb + c);
            const f32x4 gg = {bflo(gr[i].x), bfhi(gr[i].x), bflo(gr[i].y), bfhi(gr[i].y)};
            const f32x4 y = x1 + gg * pp[i] * psc * *(const f32x4*)(nw + c);
            *(f32x4*)(a.out() + o) = y;
            u32x2 w; w.x = pk_bf16(y[0], y[1]); w.y = pk_bf16(y[2], y[3]);
            if (next_kind == 1) {
                *(u32x2*)(xb + (size_t)row * 2048 + c) = w;
                if ((row & (SEQ - 1)) != SEQ - 1) *(u32x2*)(xb + (size_t)(row + 1) * 2048 + 1024 + c) = w;
                if ((row & (SEQ - 1)) == 0) { u32x2 zz; zz.x = 0u; zz.y = 0u; *(u32x2*)(xb + (size_t)row * 2048 + 1024 + c) = zz; }
            } else if (next_kind >= 0) {
                *(u32x2*)(xb + o) = w;
            }
        }
    }
}

#define XB_TMO      128
#define XB_XCNT(j)  (256  + 64 * (j))
#define XB_XSUB(j)  (1280 + 64 * (j))
#define XB_XGEN(j)  (2304 + 64 * (j))
#define XB_TOP      3328
#define XB_TOPGEN   3392
#define XCD_BAR_WORDS 3456
#define XB_SPIN_CAP (1u << 18)
__device__ __forceinline__ unsigned xb_ld(unsigned* p)              { return __hip_atomic_load(p, __ATOMIC_RELAXED, __HIP_MEMORY_SCOPE_AGENT); }
__device__ __forceinline__ unsigned xb_add(unsigned* p, unsigned v) { return __hip_atomic_fetch_add(p, v, __ATOMIC_RELAXED, __HIP_MEMORY_SCOPE_AGENT); }
__device__ __forceinline__ unsigned xb_xcc_id() { return (unsigned)__builtin_amdgcn_s_getreg((3 << 11) | 20) & 0xFu; }
#define XB_SPIN(cond, bar) do { unsigned _sp = 0; while (cond) { __builtin_amdgcn_s_sleep(1); \
    if ((++_sp & 255u) == 0u) { if (xb_ld(&(bar)[XB_TMO])) break; if (_sp > XB_SPIN_CAP) { atomicAdd(&(bar)[XB_TMO], 1u); break; } } } } while (0)
struct XcdBarrier { unsigned* bar; unsigned x; volatile LAS unsigned* st; };
__device__ __forceinline__ void xcd_barrier_complete(unsigned* bar, unsigned x, unsigned& nloc, unsigned& nx) {
    const unsigned G = gridDim.x * gridDim.y * gridDim.z;
    unsigned sum, cnt, mine, sp = 0u;
    for (;;) {
        sum = 0u; cnt = 0u; mine = 0u;
#pragma unroll
        for (unsigned j = 0; j < 16; ++j) { const unsigned c = xb_ld(&bar[XB_XCNT(j)]); sum += c; cnt += (c > 0u) ? 1u : 0u; mine = (j == x) ? c : mine; }
        if (sum == G) break;
        __builtin_amdgcn_s_sleep(1);
        if ((++sp & 255u) == 0u) { if (xb_ld(&bar[XB_TMO])) break; if (sp > XB_SPIN_CAP) { atomicAdd(&bar[XB_TMO], 1u); break; } }
    }
    nloc = mine > 0u ? mine : 1u; nx = cnt > 0u ? cnt : 1u;
}
__device__ __forceinline__ void xcd_barrier(const XcdBarrier& b) {
    asm volatile("s_waitcnt vmcnt(0)" ::: "memory");
    __syncthreads();
    if (threadIdx.x == 0) {
        unsigned* bar = b.bar;
        __builtin_amdgcn_s_waitcnt(0);
        unsigned nloc = b.st[0], nx = b.st[1];
        if (nloc == 0u) { xcd_barrier_complete(bar, b.x, nloc, nx); b.st[0] = nloc; b.st[1] = nx; }
        const unsigned old = xb_add(&bar[XB_XSUB(b.x)], 1u);
        const unsigned gen = old / nloc;
        if (old + 1u == (gen + 1u) * nloc) {
            __builtin_amdgcn_fence(__ATOMIC_RELEASE, "agent");
            asm volatile("s_waitcnt vmcnt(0)" ::: "memory");
            const unsigned og = xb_add(&bar[XB_TOP], 1u);
            const unsigned tg = og / nx;
            if (og + 1u == (tg + 1u) * nx) xb_add(&bar[XB_TOPGEN], 1u);
            else XB_SPIN(xb_ld(&bar[XB_TOPGEN]) == tg, bar);
            __builtin_amdgcn_fence(__ATOMIC_ACQUIRE, "agent");
            xb_add(&bar[XB_XGEN(b.x)], 1u);
            asm volatile("s_waitcnt vmcnt(0)" ::: "memory");
        } else {
            XB_SPIN(xb_ld(&bar[XB_XGEN(b.x)]) == gen, bar);
            __builtin_amdgcn_fence(__ATOMIC_ACQUIRE, "agent");
            asm volatile("s_waitcnt vmcnt(0)" ::: "memory");
        }
    }
    __syncthreads();
}

constexpr int NSTEP = 9;
constexpr int N_PHASES = 1 + NSTEP * NLAYER;
__global__ void __launch_bounds__(512, 2) mega(Args args) {
    extern __shared__ __attribute__((aligned(16))) unsigned char shm[];
    cg::grid_group grid = cg::this_grid();
    LAS unsigned char* lds3 = (LAS unsigned char*)shm;
    float* ldsf = (float*)shm;
    const int ph_lo = args.ph_lo, ph_hi = args.ph_hi;
    volatile LAS unsigned* xst = (volatile LAS unsigned*)(lds3 + 131072);
    if (threadIdx.x == 0) { xst[0] = 0u; xst[1] = 0u; }
    __syncthreads();
    if (ph_hi - ph_lo > 1 && threadIdx.x == 0) (void)xb_add(&((unsigned*)(args.ws + WS_BAR))[XB_XCNT(xb_xcc_id())], 1u);
    for (int ph = ph_lo; ph < ph_hi; ++ph) {
        kargp_t kp = (kargp_t)__builtin_amdgcn_kernarg_segment_ptr();
        asm volatile("" : "+s"(kp));
        KA a; a.p = kp;
        bool need_sync = true;
        if (ph == 0) {
            if (HAS(0)) phase_prep(a, shm);
        } else {
            const int L = (ph - 1) / NSTEP, st = (ph - 1) % NSTEP, kind = L % 3, j = L / 3;
            if ((st == 0 || st == 7) && HAS(1)) {
                pg8::Gemm g; pg8::EpiBf16 E; g.M = MTOK; g.A = (const bf16_t*)(a.ws() + WS_X);
                if (st == 0) { g.N = NH; g.K = (kind == 1) ? 2048 : 1024;
                    g.Bt = (const bf16_t*)(a.ws() + (kind == 0 ? (j == 0 ? WS_W_DN0 : WS_W_DN1) : (kind == 1 ? WS_W_RW : WS_W_ML)));
                    E.O = (bf16_t*)(a.ws() + WS_H); E.ldc = NH; E.act = 0; }
                else { g.N = DM; g.K = DM; g.Bt = (const bf16_t*)(a.ws() + WS_W_GATE + (size_t)L * 2 * MiB);
                    E.O = (bf16_t*)(a.ws() + WS_H + 192 * MiB); E.ldc = DM; E.act = 1; }
                pg8::StaticOrder S; S.init(g.M, g.N, (int)gridDim.x, lbid());
                pg8::gemm_phase(lds3, g, S, E);
            } else if (st == 6 && HAS(1)) {
                pg8::Gemm g; pg8::EpiBf16 E; g.M = MTOK; g.A = (const bf16_t*)(a.ws() + WS_P); g.N = DM; g.K = DPLE; g.Bt = (const bf16_t*)(a.ws() + WS_W_PROJ + (size_t)L * (MiB / 2));
                E.O = (bf16_t*)(a.ws() + WS_H + 128 * MiB); E.ldc = DM; E.act = 0; need_sync = false;
                pg8::StaticOrder S; S.init(g.M, g.N, (int)gridDim.x, lbid());
                pg8::gemm_phase(lds3, g, S, E);
            } else if (st == 4 && HAS(6)) {
                pg8::Gemm g; pg8::EpiBf16 E; g.M = MTOK; g.N = DM; g.K = DM;
                g.A = (const bf16_t*)(a.ws() + WS_X + (kind == 0 ? 0 : 64 * MiB)); g.Bt = (const bf16_t*)(a.ws() + WS_W_OUT + (size_t)L * 2 * MiB);
                E.O = (bf16_t*)(a.ws() + WS_H); E.ldc = DM; E.act = 0;
                pg8::StaticOrder S; S.init(g.M, g.N, (int)gridDim.x, lbid());
                pg8::gemm_phase(lds3, g, S, E);
            } else if (st == 1) {
                if (kind == 0) { if (HAS(2) && HAS(10)) phase_dn_prep2(a, j, shm); } else need_sync = false;
            } else if (st == 2) {
                if (kind == 0) { if (HAS(2) && HAS(11)) phase_dn_chunk2(a, j, shm); } else if (kind == 1) { if (HAS(3)) phase_rw_scan3(a, shm); } else { if (HAS(4)) phase_ml_chunk(a, shm); }
            } else if (st == 3) {
                if (HAS(5)) { if (kind == 0) phase_dn_post(a, j); else if (kind == 1) phase_rw_post(a); else phase_ml_post(a); }
            } else if (st == 5) {
                if (HAS(7)) phase_ln(a, L);
            } else if (st == 8) {
                if (HAS(9)) phase_combine(a, L);
            }
        }
        if (need_sync && ph + 1 < ph_hi) {
            if (ph == 0) grid.sync();
            else { XcdBarrier xb; xb.bar = (unsigned*)(a.ws() + WS_BAR); xb.x = xb_xcc_id(); xb.st = xst; xcd_barrier(xb); }
        }
    }
}

extern "C" void kernel_launch(void* const* d_in, const int* in_sizes, int n_in, void* d_out, int out_size, void* d_ws, size_t ws_size, hipStream_t stream) {
    static int grid = 0;
    if (grid == 0) {
        if (n_in != 31 || out_size != MTOK * DM || ws_size < WS_END) { fprintf(stderr, "kernel_launch: unexpected shapes (n_in %d out %d ws %zu need %zu)\n", n_in, out_size, ws_size, (size_t)WS_END); grid = -1; return; }
        int dev = 0, cus = 0, per_cu = 0;
        (void)hipGetDevice(&dev); (void)hipDeviceGetAttribute(&cus, hipDeviceAttributeMultiprocessorCount, dev);
        if (hipFuncSetAttribute((const void*)mega, hipFuncAttributeMaxDynamicSharedMemorySize, LDS_BYTES) != hipSuccess) { fprintf(stderr, "kernel_launch: hipFuncSetAttribute failed\n"); grid = -1; return; }
        if (hipOccupancyMaxActiveBlocksPerMultiprocessor(&per_cu, (const void*)mega, NTHR, LDS_BYTES) != hipSuccess || per_cu < 1) { fprintf(stderr, "kernel_launch: occupancy query says %d blocks/CU\n", per_cu); per_cu = 1; }
        (void)hipGetLastError();
        grid = cus;
        if (grid <= 0) grid = 256;
    }
    if (grid < 0) return;
    (void)hipMemsetAsync((char*)d_ws + WS_BAR, 0, XCD_BAR_WORDS * sizeof(unsigned), stream);
    Args a{};
    for (int i = 0; i < 31; ++i) a.in[i] = (const float*)d_in[i];
    a.out = (float*)d_out; a.ws = (unsigned char*)d_ws;
#if MULTI_LAUNCH
    for (int ph = 0; ph < N_PHASES; ++ph) { a.ph_lo = ph; a.ph_hi = ph + 1; hipLaunchKernelGGL(mega, dim3(grid), dim3(NTHR), LDS_BYTES, stream, a); }
#else
    a.ph_lo = 0; a.ph_hi = N_PHASES;
    void* kargs[] = {&a};
    hipError_t e = hipLaunchCooperativeKernel((const void*)mega, dim3(grid), dim3(NTHR), kargs, LDS_BYTES, stream);
    if (e != hipSuccess) fprintf(stderr, "cooperative launch failed: %s (grid %d)\n", hipGetErrorString(e), grid);
#endif
}
```

```cpp
#include <hip/hip_runtime.h>
#include <hip/hip_cooperative_groups.h>
#include <cstdio>
#include <cstddef>
namespace cg = cooperative_groups;

#ifndef PHMASK
#define PHMASK 0xFFFF
#endif
#ifndef SOLVE_N
#define SOLVE_N 64
#endif
#define HAS(b) ((PHMASK >> (b)) & 1)
#ifndef MULTI_LAUNCH
#define MULTI_LAUNCH 0
#endif

#define LAS __attribute__((address_space(3)))
typedef unsigned short bf16_t;
typedef short bf16x8 __attribute__((ext_vector_type(8)));
typedef float f32x4 __attribute__((ext_vector_type(4)));
typedef unsigned u32x4 __attribute__((ext_vector_type(4)));
typedef unsigned u32x2 __attribute__((ext_vector_type(2)));

constexpr int MTOK = 32768, DM = 1024, SEQ = 4096, NB = 8, NLAYER = 4, DPLE = 256;
constexpr int NH = 4352;
constexpr float ALPHA = 1.681792830507429f;
constexpr int NTHR = 512;
constexpr int LDS_BYTES = 131072 + 16;

constexpr size_t MiB = 1048576;
constexpr size_t WS_X = 0;
constexpr size_t WS_H = 128 * MiB;
constexpr size_t WS_W = 400 * MiB;
constexpr size_t W_IN_BYTES = (size_t)NH * 1024 * 2;
constexpr size_t WS_W_DN0 = WS_W;
constexpr size_t WS_W_DN1 = WS_W_DN0 + W_IN_BYTES;
constexpr size_t WS_W_RW = WS_W_DN1 + W_IN_BYTES;
constexpr size_t WS_W_ML = WS_W_RW + 2 * W_IN_BYTES;
constexpr size_t WS_W_OUT = WS_W_ML + W_IN_BYTES;
constexpr size_t WS_W_GATE = WS_W_OUT + 4 * 2 * MiB;
constexpr size_t WS_W_PROJ = WS_W_GATE + 4 * 2 * MiB;
constexpr size_t WS_P = WS_W_PROJ + 2 * MiB;
constexpr size_t WS_BONUS = WS_P + 16 * MiB;
constexpr size_t WS_BAR = WS_BONUS + 2 * MiB;
constexpr size_t WS_END = WS_BAR + 65536;

struct Args { const float* in[31]; float* out; unsigned char* ws; int ph_lo, ph_hi; };
#define AS4 __attribute__((address_space(4)))
typedef const AS4 unsigned char* kargp_t;
struct KA { kargp_t p;
    __device__ __forceinline__ const float* in(int i) const { return *(const float* const AS4*)(p + 8 * i); }
    __device__ __forceinline__ float* out() const { return *(float* const AS4*)(p + 248); }
    __device__ __forceinline__ unsigned char* ws() const { return *(unsigned char* const AS4*)(p + 256); }
};
static_assert(offsetof(Args, out) == 248 && offsetof(Args, ws) == 256, "kernarg layout");

__device__ __forceinline__ int ltid() { int t = (int)threadIdx.x; asm volatile("" : "+v"(t)); return t; }
__device__ __forceinline__ int lbid() { int t = (int)blockIdx.x; asm volatile("" : "+s"(t)); return t; }
__device__ __forceinline__ float bf2f(bf16_t b) { return __uint_as_float(((unsigned)b) << 16); }
__device__ __forceinline__ float bflo(unsigned u) { return __uint_as_float(u << 16); }
__device__ __forceinline__ float bfhi(unsigned u) { return __uint_as_float(u & 0xffff0000u); }
typedef float f32x2_ __attribute__((ext_vector_type(2)));
typedef __bf16 bf16x2_ __attribute__((ext_vector_type(2)));
__device__ __forceinline__ unsigned pk_bf16(float lo, float hi) { const f32x2_ v = {lo, hi}; return __builtin_bit_cast(unsigned, __builtin_convertvector(v, bf16x2_)); }
__device__ __forceinline__ float sigmoidf_(float x) { return __builtin_amdgcn_rcpf(1.0f + __expf(-x)); }
__device__ __forceinline__ float siluf_(float x) { return x * __builtin_amdgcn_rcpf(1.0f + __expf(-x)); }
__device__ __forceinline__ float softplusf_(float x) { return x > 20.f ? x : log1pf(__expf(x)); }
template <int CTRL> __device__ __forceinline__ float dppf(float x) { return __builtin_bit_cast(float, __builtin_amdgcn_mov_dpp(__builtin_bit_cast(int, x), CTRL, 0xf, 0xf, true)); }
__device__ __forceinline__ float row16_sum(float v) { v += dppf<0xB1>(v); v += dppf<0x4E>(v); v += dppf<0x124>(v); v += dppf<0x128>(v); return v; }
__device__ __forceinline__ float row8_sum(float v) { v += dppf<0xB1>(v); v += dppf<0x4E>(v); v += dppf<0x141>(v); return v; }
__device__ __forceinline__ float quad_sum(float v) { v += dppf<0xB1>(v); v += dppf<0x4E>(v); return v; }
__device__ __forceinline__ float wave_sum(float v) { v = row16_sum(v); v += __shfl_xor(v, 16, 64); v += __shfl_xor(v, 32, 64); return v; }
template <int CTRL, int RM> __device__ __forceinline__ float dpp_old(float oldv, float x) { return __builtin_bit_cast(float, __builtin_amdgcn_update_dpp(__builtin_bit_cast(int, oldv), __builtin_bit_cast(int, x), CTRL, RM, 0xf, false)); }
__device__ __forceinline__ float wave_scan_add(float v) {
    v += dpp_old<0x111, 0xf>(0.f, v); v += dpp_old<0x112, 0xf>(0.f, v); v += dpp_old<0x114, 0xf>(0.f, v); v += dpp_old<0x118, 0xf>(0.f, v);
    v += dpp_old<0x142, 0xa>(0.f, v); v += dpp_old<0x143, 0xc>(0.f, v); return v; }
__device__ __forceinline__ float wave_scan_max(float v) {
    const float ninf = -__builtin_inff();
    v = fmaxf(v, dpp_old<0x111, 0xf>(ninf, v)); v = fmaxf(v, dpp_old<0x112, 0xf>(ninf, v)); v = fmaxf(v, dpp_old<0x114, 0xf>(ninf, v)); v = fmaxf(v, dpp_old<0x118, 0xf>(ninf, v));
    v = fmaxf(v, dpp_old<0x142, 0xa>(ninf, v)); v = fmaxf(v, dpp_old<0x143, 0xc>(ninf, v)); return v; }
__device__ __forceinline__ void unpack8(const u32x4 r, float (&f)[8]) {
    f[0] = bflo(r.x); f[1] = bfhi(r.x); f[2] = bflo(r.y); f[3] = bfhi(r.y); f[4] = bflo(r.z); f[5] = bfhi(r.z); f[6] = bflo(r.w); f[7] = bfhi(r.w);
}

__device__ __forceinline__ bf16x8 ldfrag(const bf16_t* base, int ld, int r0, int k0, int lane) { return *(const bf16x8*)(base + (r0 + (lane & 15)) * ld + k0 + (lane >> 4) * 8); }
#define MFMA16(a, b, c) __builtin_amdgcn_mfma_f32_16x16x32_bf16(a, b, c, 0, 0, 0)
__device__ __forceinline__ bf16_t f2bf1(float x) { return (bf16_t)(pk_bf16(x, x) & 0xffffu); }

namespace pg8 {
constexpr int BM = 256, BK = 64, HALF = 128, HTB = HALF * BK * 2, STAGE_BYTES = 8 * HTB, NXCD = 8, WGM = 8;
__host__ __device__ __forceinline__ int lds_byte(int r, int c) { const int st = (r >> 4) * 2 + (c >> 5), rr = r & 15, cc = c & 31, ob = rr * 64 + cc * 2; return st * 1024 + (ob ^ (((ob >> 9) & 1) << 5)); }
__host__ __device__ __forceinline__ void stage_rc(int b, int& R, int& C) { const int st = b / 1024, sb = b % 1024, swz = sb ^ (((sb >> 9) & 1) << 5); R = (st >> 1) * 16 + swz / 64; C = (st & 1) * 32 + (swz % 64) / 2; }
__host__ __device__ __forceinline__ int perm32(int rho) { const int n = rho >> 4, i = rho & 15; return 8 * (i >> 2) + 4 * n + (i & 3); }
struct Unit { int pm, pn; };
struct Gemm { const bf16_t* A; const bf16_t* Bt; int M, N, K; };
struct StaticOrder {
    int nM, nN, nwg, G, c;
    __device__ void init(int M, int N, int G_, int c_) { nM = M / BM; nN = N / BM; nwg = nM * nN; G = G_; c = c_; }
    __device__ bool next(int i, Unit& u) const {
        const long L = (long)i * G + c; if (L >= nwg) return false;
        int wgid = (int)L; { const int q = nwg / NXCD, r = nwg % NXCD, xcd = wgid % NXCD, off = wgid / NXCD; wgid = (xcd < r ? xcd * (q + 1) : r * (q + 1) + (xcd - r) * q) + off; }
        const int nig = WGM * nN, gid = wgid / nig, fm = gid * WGM, gsz = (nM - fm) < WGM ? (nM - fm) : WGM;
        u.pm = fm + ((wgid % nig) % gsz); u.pn = (wgid % nig) / gsz; return true;
    }
};
struct EpiBf16 {
    static constexpr bool PERM = true;
    bf16_t* O; int ldc; int act;
    __device__ __forceinline__ void operator()(const f32x4 (&acc)[2][2][4][2], const Unit& u, int wr, int wc, int fr, int fq) const {
        const int row0 = u.pm * BM + wr * 64 + fr; const int col0 = u.pn * BM + wc * 32 + 8 * fq;
#pragma unroll
        for (int ai = 0; ai < 2; ++ai)
#pragma unroll
            for (int m = 0; m < 4; ++m) { bf16_t* rowp = O + (size_t)(row0 + ai * HALF + m * 16) * ldc + col0;
#pragma unroll
                for (int bj = 0; bj < 2; ++bj) { f32x4 v0 = acc[ai][bj][m][0], v1 = acc[ai][bj][m][1];
                    if (act) {
#pragma unroll
                        for (int j = 0; j < 4; ++j) { v0[j] = sigmoidf_(v0[j]); v1[j] = sigmoidf_(v1[j]); } }
                    u32x4 w; w.x = pk_bf16(v0[0], v0[1]); w.y = pk_bf16(v0[2], v0[3]); w.z = pk_bf16(v1[0], v1[1]); w.w = pk_bf16(v1[2], v1[3]);
                    *(u32x4*)(rowp + bj * HALF) = w; } }
    }
};
struct EpiF32 {
    static constexpr bool PERM = false;
    float* C; int ldc; const float* R; float rscale;
    __device__ __forceinline__ void operator()(const f32x4 (&acc)[2][2][4][2], const Unit& u, int wr, int wc, int fr, int fq) const {
        const int row0 = u.pm * BM + wr * 64 + fr, col0 = u.pn * BM + wc * 32 + 4 * fq;
#pragma unroll
        for (int ai = 0; ai < 2; ++ai)
#pragma unroll
            for (int m = 0; m < 4; ++m) { const size_t ro = (size_t)(row0 + ai * HALF + m * 16) * ldc + col0;
#pragma unroll
                for (int bj = 0; bj < 2; ++bj)
#pragma unroll
                    for (int n = 0; n < 2; ++n) { f32x4 v = acc[ai][bj][m][n];
                        if (R) { const f32x4 r = *(const f32x4*)(R + ro + bj * HALF + n * 16); v = v + r * rscale; }
                        *(f32x4*)(C + ro + bj * HALF + n * 16) = v; } }
    }
};

template <class Epi>
__device__ __forceinline__ void gemm_phase(LAS unsigned char* lds, const Gemm g, const StaticOrder& S, const Epi& E) {
    const int tid = ltid(), wid = __builtin_amdgcn_readfirstlane(tid >> 6), lane = tid & 63, wr = wid >> 2, wc = wid & 3, fr = lane & 15, fq = lane >> 4;
    const int K = g.K, nt = K / BK;
    unsigned voffA[2], voffB[2];
#pragma unroll
    for (int i = 0; i < 2; ++i) { int R, C; stage_rc(tid * 16 + i * 8192, R, C); const int Rb = Epi::PERM ? ((R & ~31) + perm32(R & 31)) : R;
        voffA[i] = (unsigned)(R * K + C) * 2u; voffB[i] = (unsigned)(Rb * K + C) * 2u; }
    const size_t kstep = (size_t)(BK * 2);
    const size_t hstep = (size_t)HALF * K * 2;
    const size_t tstep = 2 * hstep;
    const unsigned ldsw = (unsigned)wid * 1024u;
    const int aoff = lds_byte(wr * 64 + fr, fq * 8), boff = lds_byte(wc * 32 + fr, fq * 8);
#define PG8_SA(b, h) (((b) * 2 + (h)) * HTB)
#define PG8_SB(b, h) ((4 + (b) * 2 + (h)) * HTB)
#define PG8_STAGE(bufoff, gbase, voff) do { _Pragma("unroll") for (int _i = 0; _i < 2; ++_i) \
        __builtin_amdgcn_global_load_lds((const unsigned*)((const char*)(gbase) + (voff)[_i]), (LAS unsigned*)(lds + (bufoff) + ldsw + _i * 8192), 16, 0, 0); } while (0)
#define PG8_LDA(dst, b, h) do { _Pragma("unroll") for (int m = 0; m < 4; ++m) _Pragma("unroll") for (int k = 0; k < 2; ++k) dst[m][k] = *(const LAS bf16x8*)(lds + PG8_SA(b, h) + aoff + m * 2048 + k * 1024); } while (0)
#define PG8_LDB(dst, b, h) do { _Pragma("unroll") for (int n = 0; n < 2; ++n) _Pragma("unroll") for (int k = 0; k < 2; ++k) dst[n][k] = *(const LAS bf16x8*)(lds + PG8_SB(b, h) + boff + n * 2048 + k * 1024); } while (0)
#define PG8_MMA(ai, bj, At, Bt) do { __builtin_amdgcn_s_setprio(1); _Pragma("unroll") for (int m = 0; m < 4; ++m) _Pragma("unroll") for (int n = 0; n < 2; ++n) _Pragma("unroll") for (int k = 0; k < 2; ++k) \
        acc[ai][bj][m][n] = __builtin_amdgcn_mfma_f32_16x16x32_bf16(Bt[n][k], At[m][k], acc[ai][bj][m][n], 0, 0, 0); __builtin_amdgcn_s_setprio(0); } while (0)
#define PG8_WAIT_V(n) asm volatile("s_waitcnt vmcnt(" #n ")" ::: "memory")
#define PG8_WAIT_L(n) asm volatile("s_waitcnt lgkmcnt(" #n ")" ::: "memory")
#define PG8_BAR __builtin_amdgcn_s_barrier()
#define PG8_SCHED __builtin_amdgcn_sched_barrier(0)
    Unit cur, nxt; int ui = 0;
    if (!S.next(0, cur)) return;
    f32x4 acc[2][2][4][2];
#pragma unroll
    for (int a = 0; a < 2; ++a)
#pragma unroll
        for (int b = 0; b < 2; ++b)
#pragma unroll
            for (int m = 0; m < 4; ++m)
#pragma unroll
                for (int n = 0; n < 2; ++n) acc[a][b][m][n] = (f32x4){0.f, 0.f, 0.f, 0.f};
    bf16x8 At[4][2], B0[2][2], B1[2][2];
    const char* cA = (const char*)g.A + (size_t)cur.pm * tstep; const char* cB = (const char*)g.Bt + (size_t)cur.pn * tstep;
    PG8_STAGE(PG8_SB(0, 0), cB, voffB); PG8_STAGE(PG8_SA(0, 0), cA, voffA); PG8_STAGE(PG8_SB(0, 1), cB + hstep, voffB); PG8_STAGE(PG8_SA(0, 1), cA + hstep, voffA);
    if (wr == 1) PG8_BAR;
    PG8_WAIT_V(4); PG8_BAR;
    PG8_STAGE(PG8_SB(1, 0), cB + kstep, voffB); PG8_STAGE(PG8_SA(1, 0), cA + kstep, voffA); PG8_STAGE(PG8_SB(1, 1), cB + hstep + kstep, voffB);
    PG8_WAIT_V(6); PG8_BAR;
    for (;;) {
        const bool has_next = S.next(ui + 1, nxt);
        const char* nA = has_next ? (const char*)g.A + (size_t)nxt.pm * tstep : cA; const char* nB = has_next ? (const char*)g.Bt + (size_t)nxt.pn * tstep : cB;
        for (int t = 0; t < nt; t += 2) {
            const bool last = (t == nt - 2);
            const char* a1 = cA + (size_t)(t + 1) * kstep;
            const char* a2 = last ? nA : cA + (size_t)(t + 2) * kstep; const char* b2 = last ? nB : cB + (size_t)(t + 2) * kstep;
            const char* a3 = a2 + kstep; const char* b3 = b2 + kstep;
            PG8_LDB(B0, 0, 0); PG8_SCHED; PG8_LDA(At, 0, 0); PG8_STAGE(PG8_SA(1, 1), a1 + hstep, voffA);
            PG8_WAIT_L(8); PG8_BAR; PG8_WAIT_L(0); PG8_MMA(0, 0, At, B0); PG8_BAR; PG8_SCHED;
            PG8_LDB(B1, 0, 1); PG8_STAGE(PG8_SB(0, 0), b2, voffB);
            PG8_BAR; PG8_WAIT_L(0); PG8_MMA(0, 1, At, B1); PG8_BAR;
            PG8_LDA(At, 0, 1); PG8_STAGE(PG8_SA(0, 0), a2, voffA);
            PG8_BAR; PG8_WAIT_L(0); PG8_MMA(1, 0, At, B0); PG8_BAR; PG8_SCHED;
            PG8_STAGE(PG8_SB(0, 1), b2 + hstep, voffB);
            PG8_WAIT_V(6); PG8_BAR; PG8_MMA(1, 1, At, B1); PG8_BAR;
            PG8_LDB(B0, 1, 0); PG8_SCHED; PG8_LDA(At, 1, 0); PG8_STAGE(PG8_SA(0, 1), a2 + hstep, voffA);
            PG8_WAIT_L(8); PG8_BAR; PG8_WAIT_L(0); PG8_MMA(0, 0, At, B0); PG8_BAR; PG8_SCHED;
            PG8_LDB(B1, 1, 1); PG8_STAGE(PG8_SB(1, 0), b3, voffB);
            PG8_BAR; PG8_WAIT_L(0); PG8_MMA(0, 1, At, B1); PG8_BAR;
            PG8_LDA(At, 1, 1); PG8_STAGE(PG8_SA(1, 0), a3, voffA);
            PG8_BAR; PG8_WAIT_L(0); PG8_MMA(1, 0, At, B0); PG8_BAR; PG8_SCHED;
            PG8_STAGE(PG8_SB(1, 1), b3 + hstep, voffB);
            PG8_WAIT_V(6); PG8_BAR; PG8_MMA(1, 1, At, B1); PG8_BAR;
        }
        E(acc, cur, wr, wc, fr, fq);
        if (!has_next) break;
#pragma unroll
        for (int a = 0; a < 2; ++a)
#pragma unroll
            for (int b = 0; b < 2; ++b)
#pragma unroll
                for (int m = 0; m < 4; ++m)
#pragma unroll
                    for (int n = 0; n < 2; ++n) acc[a][b][m][n] = (f32x4){0.f, 0.f, 0.f, 0.f};
        cur = nxt; cA = nA; cB = nB; ++ui;
    }
    PG8_WAIT_V(0);
    if (wr == 0) PG8_BAR;
    PG8_BAR;
#undef PG8_SA
#undef PG8_SB
#undef PG8_STAGE
#undef PG8_LDA
#undef PG8_LDB
#undef PG8_MMA
#undef PG8_WAIT_V
#undef PG8_WAIT_L
#undef PG8_BAR
#undef PG8_SCHED
}
}

struct Seg { int in_idx, src_off, ldsrc, scol0, len, K, dst_off, ldk, koff, n0, mumode, mu_off; };
#define OFFW(x) ((int)((x) - WS_W))
__constant__ Seg g_segs[] = {
    {7, 0, 4112, 0, 4112, 1024, OFFW(WS_W_DN0), 1024, 0, 0, 0, 0}, {7, 0, 0, 0, 240, 1024, OFFW(WS_W_DN0), 1024, 0, 4112, 3, 0},
    {7, 1024 * 4112, 4112, 0, 4112, 1024, OFFW(WS_W_DN1), 1024, 0, 0, 0, 0}, {7, 0, 0, 0, 240, 1024, OFFW(WS_W_DN1), 1024, 0, 4112, 3, 0},
    {25, 0, 4112, 0, 4112, 1024, OFFW(WS_W_ML), 1024, 0, 0, 0, 0}, {25, 0, 0, 0, 240, 1024, OFFW(WS_W_ML), 1024, 0, 4112, 3, 0},
    {13, 0, 4224, 0, 1024, 1024, OFFW(WS_W_RW), 2048, 0, 0, 1, 0 * 1024}, {13, 0, 4224, 0, 1024, 1024, OFFW(WS_W_RW), 2048, 1024, 0, 2, 0 * 1024},
    {13, 0, 4224, 1088, 1024, 1024, OFFW(WS_W_RW), 2048, 0, 1024, 1, 2 * 1024}, {13, 0, 4224, 1088, 1024, 1024, OFFW(WS_W_RW), 2048, 1024, 1024, 2, 2 * 1024},
    {13, 0, 4224, 2112, 1024, 1024, OFFW(WS_W_RW), 2048, 0, 2048, 1, 3 * 1024}, {13, 0, 4224, 2112, 1024, 1024, OFFW(WS_W_RW), 2048, 1024, 2048, 2, 3 * 1024},
    {13, 0, 4224, 3200, 1024, 1024, OFFW(WS_W_RW), 2048, 0, 3072, 1, 5 * 1024}, {13, 0, 4224, 3200, 1024, 1024, OFFW(WS_W_RW), 2048, 1024, 3072, 2, 5 * 1024},
    {13, 0, 4224, 1024, 64, 1024, OFFW(WS_W_RW), 2048, 0, 4096, 1, 1 * 1024}, {13, 0, 4224, 1024, 64, 1024, OFFW(WS_W_RW), 2048, 1024, 4096, 2, 1 * 1024},
    {13, 0, 4224, 3136, 64, 1024, OFFW(WS_W_RW), 2048, 0, 4160, 1, 4 * 1024}, {13, 0, 4224, 3136, 64, 1024, OFFW(WS_W_RW), 2048, 1024, 4160, 2, 4 * 1024},
    {13, 0, 0, 0, 128, 2048, OFFW(WS_W_RW), 2048, 0, 4224, 3, 0},
    {12, 0, 1024, 0, 1024, 1024, OFFW(WS_W_OUT + 0 * 2 * MiB), 1024, 0, 0, 0, 0}, {24, 0, 1024, 0, 1024, 1024, OFFW(WS_W_OUT + 1 * 2 * MiB), 1024, 0, 0, 0, 0},
    {30, 0, 1024, 0, 1024, 1024, OFFW(WS_W_OUT + 2 * 2 * MiB), 1024, 0, 0, 0, 0}, {12, 1024 * 1024, 1024, 0, 1024, 1024, OFFW(WS_W_OUT + 3 * 2 * MiB), 1024, 0, 0, 0, 0},
    {6, 0 * 1024 * 1024, 1024, 0, 1024, 1024, OFFW(WS_W_GATE + 0 * 2 * MiB), 1024, 0, 0, 0, 0}, {6, 1 * 1024 * 1024, 1024, 0, 1024, 1024, OFFW(WS_W_GATE + 1 * 2 * MiB), 1024, 0, 0, 0, 0},
    {6, 2 * 1024 * 1024, 1024, 0, 1024, 1024, OFFW(WS_W_GATE + 2 * 2 * MiB), 1024, 0, 0, 0, 0}, {6, 3 * 1024 * 1024, 1024, 0, 1024, 1024, OFFW(WS_W_GATE + 3 * 2 * MiB), 1024, 0, 0, 0, 0},
    {4, 0 * 256 * 1024, 1024, 0, 1024, 256, OFFW(WS_W_PROJ + 0 * (MiB / 2)), 256, 0, 0, 0, 0}, {4, 1 * 256 * 1024, 1024, 0, 1024, 256, OFFW(WS_W_PROJ + 1 * (MiB / 2)), 256, 0, 0, 0, 0},
    {4, 2 * 256 * 1024, 1024, 0, 1024, 256, OFFW(WS_W_PROJ + 2 * (MiB / 2)), 256, 0, 0, 0, 0}, {4, 3 * 256 * 1024, 1024, 0, 1024, 256, OFFW(WS_W_PROJ + 3 * (MiB / 2)), 256, 0, 0, 0, 0},
};
constexpr int N_SEGS = 6 + 13 + 4 + 4 + 4;

__device__ __forceinline__ void phase_prep(const KA a, unsigned char* lds_) {
    const size_t gtid = (size_t)lbid() * NTHR + ltid(), gsz = (size_t)gridDim.x * NTHR;
    { const float* x = a.in(0); bf16_t* xb = (bf16_t*)(a.ws() + WS_X);
      const size_t n8 = (size_t)MTOK * DM / 8;
      for (size_t i = gtid; i < n8; i += 4 * gsz) {
          f32x4 v0[4], v1[4];
#pragma unroll
          for (int q = 0; q < 4; ++q) { const size_t ii = i + q * gsz; if (ii < n8) { v0[q] = *(const f32x4*)(x + ii * 8); v1[q] = *(const f32x4*)(x + ii * 8 + 4); } }
#pragma unroll
          for (int q = 0; q < 4; ++q) { const size_t ii = i + q * gsz; if (ii < n8) {
              u32x4 w; w.x = pk_bf16(v0[q][0], v0[q][1]); w.y = pk_bf16(v0[q][2], v0[q][3]); w.z = pk_bf16(v1[q][0], v1[q][1]); w.w = pk_bf16(v1[q][2], v1[q][3]); *(u32x4*)(xb + ii * 8) = w; } } } }
    bf16_t* tl = (bf16_t*)lds_;
    const int tid = ltid(), G = (int)gridDim.x;
    const int lk = tid >> 3, ln8 = (tid & 7) * 8;
#define PREP_NT(SG) ((((SG).len + 63) >> 6) * ((SG).K >> 6))
    int cs = 0, ct = lbid(), cnt = PREP_NT(g_segs[0]);
    while (cs < N_SEGS && ct >= cnt) { ct -= cnt; ++cs; if (cs < N_SEGS) cnt = PREP_NT(g_segs[cs]); }
    f32x4 r0 = {0.f, 0.f, 0.f, 0.f}, r1 = r0; float rsc = 1.f;
#define PREP_LOAD(S_, T_) do { const Seg q = g_segs[S_]; const int ntn = (q.len + 63) >> 6, tn = (T_) % ntn, tk = (T_) / ntn; const int k = tk * 64 + lk, n = tn * 64 + ln8; \
        r0 = (f32x4){0.f, 0.f, 0.f, 0.f}; r1 = r0; rsc = 1.f; \
        if (q.mumode != 3 && n < q.len) { const float* sp = a.in(q.in_idx) + q.src_off + (size_t)k * q.ldsrc + q.scol0 + n; r0 = *(const f32x4*)sp; r1 = *(const f32x4*)(sp + 4); \
            if (q.mumode == 1) rsc = 1.0f - a.in(14)[q.mu_off + k]; else if (q.mumode == 2) rsc = a.in(14)[q.mu_off + k]; } } while (0)
    if (cs < N_SEGS) PREP_LOAD(cs, ct);
    int buf = 0;
    while (cs < N_SEGS) {
        int ns = cs, nt = ct + G, nnt = cnt;
        while (ns < N_SEGS && nt >= nnt) { nt -= nnt; ++ns; if (ns < N_SEGS) nnt = PREP_NT(g_segs[ns]); }
        bf16_t* tb = tl + buf * (64 * 72);
        { const f32x4 v0 = r0 * rsc, v1 = r1 * rsc;
          tb[(ln8 + 0) * 72 + lk] = f2bf1(v0[0]); tb[(ln8 + 1) * 72 + lk] = f2bf1(v0[1]); tb[(ln8 + 2) * 72 + lk] = f2bf1(v0[2]); tb[(ln8 + 3) * 72 + lk] = f2bf1(v0[3]);
          tb[(ln8 + 4) * 72 + lk] = f2bf1(v1[0]); tb[(ln8 + 5) * 72 + lk] = f2bf1(v1[1]); tb[(ln8 + 6) * 72 + lk] = f2bf1(v1[2]); tb[(ln8 + 7) * 72 + lk] = f2bf1(v1[3]); }
        const Seg cq = g_segs[cs]; const int cntn = (cq.len + 63) >> 6, ctn = ct % cntn, ctk = ct / cntn;
        if (ns < N_SEGS) PREP_LOAD(ns, nt);
        __syncthreads();
        { const int n = ctn * 64 + (tid >> 3), kp = (tid & 7) * 8;
          if (n < cq.len) *(u32x4*)((bf16_t*)(a.ws() + WS_W + (size_t)cq.dst_off) + (size_t)(cq.n0 + n) * cq.ldk + cq.koff + ctk * 64 + kp) = *(const u32x4*)(tb + (tid >> 3) * 72 + kp); }
        buf ^= 1; cs = ns; ct = nt; cnt = nnt;
    }
#undef PREP_LOAD
#undef PREP_NT
}

template <int NC, int TC, int FN  >
__device__ __forceinline__ void cols_load(const bf16_t* __restrict__ h, size_t row0, int col0, float* dst, int dstride, int vt) {
    constexpr int NV = NC / 8, NITEM = NV * TC;
    for (int it = vt; it < NITEM; it += NTHR) {
        const int vc = it % NV, t = it / NV, c = vc * 8;
        const u32x4 r = *(const u32x4*)(h + (row0 + t) * NH + col0 + c);
        float f[8]; unpack8(r, f);
        float* d = dst + (size_t)t * dstride + c;
#pragma unroll
        for (int e = 0; e < 8; ++e) d[e] = FN == 1 ? tanhf(f[e]) : f[e];
    }
}
__device__ __forceinline__ int vtid(int shift) { return (int)((ltid() + NTHR - shift) & (NTHR - 1)); }

__device__ __forceinline__ void phase_dn_post(const KA a, int j) {
    const bf16_t* h = (const bf16_t*)(a.ws() + WS_H);
    const bf16_t* O = (const bf16_t*)(a.ws() + WS_X + 64 * MiB);
    bf16_t* Y = (bf16_t*)(a.ws() + WS_X);
#define DNO(R) (O + ((size_t)((((R) >> 12) * 8 + (lane >> 3)) * 64 + (((R) & 4095) >> 6)) * 8192 + ((R) & 63) * 128 + (lane & 7) * 16))
    const int lane = ltid() & 63, wid = ltid() >> 6;
    const float* nw = a.in(11) + j * 128 + (lane & 7) * 16;
    float w[16];
#pragma unroll
    for (int e = 0; e < 16; ++e) w[e] = nw[e];
    const int stride = (int)gridDim.x * 8;
    int row = lbid() * 8 + wid;
    u32x4 no0, no1, nz0, nz1;
    if (row < MTOK) { no0 = *(const u32x4*)DNO(row); no1 = *(const u32x4*)(DNO(row) + 8);
        nz0 = *(const u32x4*)(h + (size_t)row * NH + 3072 + lane * 16); nz1 = *(const u32x4*)(h + (size_t)row * NH + 3072 + lane * 16 + 8); }
    for (; row < MTOK; row += stride) {
        float o[16], z[16];
        unpack8(no0, *(float(*)[8])&o[0]); unpack8(no1, *(float(*)[8])&o[8]); unpack8(nz0, *(float(*)[8])&z[0]); unpack8(nz1, *(float(*)[8])&z[8]);
        const int nr = row + stride;
        if (nr < MTOK) { no0 = *(const u32x4*)DNO(nr); no1 = *(const u32x4*)(DNO(nr) + 8);
            nz0 = *(const u32x4*)(h + (size_t)nr * NH + 3072 + lane * 16); nz1 = *(const u32x4*)(h + (size_t)nr * NH + 3072 + lane * 16 + 8); }
        float ss = 0.f;
#pragma unroll
        for (int e = 0; e < 16; ++e) ss += o[e] * o[e];
        ss = row8_sum(ss);
        const float sc = rsqrtf(ss * (1.0f / 128.0f) + 1e-6f);
        float y[16];
#pragma unroll
        for (int e = 0; e < 16; ++e) y[e] = o[e] * sc * w[e] * siluf_(z[e]);
        u32x4 w0, w1; w0.x = pk_bf16(y[0], y[1]); w0.y = pk_bf16(y[2], y[3]); w0.z = pk_bf16(y[4], y[5]); w0.w = pk_bf16(y[6], y[7]);
        w1.x = pk_bf16(y[8], y[9]); w1.y = pk_bf16(y[10], y[11]); w1.z = pk_bf16(y[12], y[13]); w1.w = pk_bf16(y[14], y[15]);
        *(u32x4*)(Y + (size_t)row * DM + lane * 16) = w0; *(u32x4*)(Y + (size_t)row * DM + lane * 16 + 8) = w1;
    }
#undef DNO
}

__device__ __forceinline__ float tanh_fast(float x) { const float e = __expf(2.0f * x); return 1.0f - 2.0f * __builtin_amdgcn_rcpf(e + 1.0f); }
__device__ __forceinline__ int xcd_unit(int u) { return ((u & 7) << 5) | ((u >> 3) & 31); }
__device__ __forceinline__ void phase_rw_scan3(const KA a, unsigned char* shm_) {
    const bf16_t* h = (const bf16_t*)(a.ws() + WS_H);
    bf16_t* O = (bf16_t*)(a.ws() + WS_X);
    float* bonus = (float*)(a.ws() + WS_BONUS);
    float* osb = (float*)(shm_ + 90112);
    bf16_t* WL = (bf16_t*)(shm_ + 98304); bf16_t* AL = (bf16_t*)(shm_ + 102912); bf16_t* WUPT = (bf16_t*)(shm_ + 107520); bf16_t* AUPT = (bf16_t*)(shm_ + 116736);
    const int tid0 = ltid();
    for (int unit = lbid(); unit < NB * 16 * 2; unit += gridDim.x) {
        const int un_ = (gridDim.x == 256) ? xcd_unit(unit) : unit; const int b = un_ >> 5, hd = (un_ >> 1) & 15, half = un_ & 1;
        const int tid = tid0, wid = tid >> 6, lane = tid & 63, quad = lane >> 4, l15 = lane & 15;
        const bool producer = wid >= 4;
        const int ptid = tid & 255, pw = ptid >> 6;
        __syncthreads();
        for (int i = tid; i < 4096; i += NTHR) { const int jj = i >> 6, c = i & 63;
            WUPT[c * 72 + jj] = f2bf1(a.in(16)[jj * 1024 + hd * 64 + c]); AUPT[c * 72 + jj] = f2bf1(a.in(18)[jj * 1024 + hd * 64 + c]); }
        const int cm = pw * 16 + l15;
        const float w0c = a.in(15)[hd * 64 + cm], a0c = a.in(17)[hd * 64 + cm], kkc = a.in(19)[hd * 64 + cm], kac = a.in(20)[hd * 64 + cm];
        const int rpart = ptid & 7;
        const f32x4 rkA = *(const f32x4*)(a.in(21) + hd * 64 + rpart * 8), rkB = *(const f32x4*)(a.in(21) + hd * 64 + rpart * 8 + 4);
        const int pt = ptid >> 3, pvc = ptid & 7, vt_ = (ptid & 127) >> 2, vvc = ptid & 3;
        const size_t rowb = (size_t)b * SEQ;
        u32x4 p0 = {0u, 0u, 0u, 0u}, p1 = p0, p2 = p0, p3 = p0, p4 = p0;
#define RW3_PREFETCH(CH) do { const size_t rn = rowb + (size_t)(CH) * 32; \
            p0 = *(const u32x4*)(h + (rn + pt) * NH + hd * 64 + pvc * 8); p1 = *(const u32x4*)(h + (rn + pt) * NH + 1024 + hd * 64 + pvc * 8); \
            p2 = *(const u32x4*)(h + (rn + pt) * NH + 4096 + pvc * 8); p3 = *(const u32x4*)(h + (rn + pt) * NH + 4160 + pvc * 8); \
            if (ptid < 128) p4 = *(const u32x4*)(h + (rn + vt_) * NH + 2048 + hd * 64 + half * 32 + vvc * 8); } while (0)
        if (producer) RW3_PREFETCH(0);
        const int crow = (wid & 3) * 8 + (lane >> 3), kq = lane & 7;
        f32x2_ S0 = {0.f, 0.f}, S1 = S0, S2 = S0, S3 = S0;
        for (int c = -1; c < SEQ / 32; ++c) {
            const int cb = c & 1, nb = (c + 1) & 1;
            float* rsC = (float*)(shm_ + cb * 45056); float* dsC = rsC + 2048; float* kpC = rsC + 4096; float* kkC = rsC + 6144; float* kaC = rsC + 8192; float* vsC = rsC + 10240;
            float* rsN = (float*)(shm_ + nb * 45056); float* dsN = rsN + 2048; float* kpN = rsN + 4096; float* kkN = rsN + 6144; float* kaN = rsN + 8192; float* vsN = rsN + 10240;
            float* osC = osb + cb * 1024; float* osP = osb + nb * 1024;
            const bool cact = (c >= 0), pact = (c + 1 < SEQ / 32);
            __syncthreads();
#pragma unroll 1
            for (int seg = 0; seg < 4; ++seg) {
                if (!producer) {
                    if (seg == 0 && c >= 1) {
                        const int t = tid >> 3, c4 = (tid & 7) * 4; const f32x4 v = *(const f32x4*)(osP + t * 32 + c4);
                        u32x2 w; w.x = pk_bf16(v[0], v[1]); w.y = pk_bf16(v[2], v[3]);
                        *(u32x2*)(O + (rowb + (size_t)(c - 1) * 32 + t) * DM + hd * 64 + half * 32 + c4) = w; }
                    if (cact) {
                        float yv[8];
                        f32x4 nkA, nkB, naA, naB, ndA, ndB, npA, npB, nrA, nrB; float nvv;
#define RW3_LD(T) do { const int o_ = (T) * 64 + kq * 8; nkA = *(const f32x4*)(kkC + o_); nkB = *(const f32x4*)(kkC + o_ + 4); naA = *(const f32x4*)(kaC + o_); naB = *(const f32x4*)(kaC + o_ + 4); \
                            ndA = *(const f32x4*)(dsC + o_); ndB = *(const f32x4*)(dsC + o_ + 4); npA = *(const f32x4*)(kpC + o_); npB = *(const f32x4*)(kpC + o_ + 4); \
                            nrA = *(const f32x4*)(rsC + o_); nrB = *(const f32x4*)(rsC + o_ + 4); nvv = vsC[(T) * 32 + crow]; } while (0)
                        RW3_LD(seg * 8);
#pragma unroll
                        for (int tt = 0; tt < 8; ++tt) { const int t = seg * 8 + tt;
                            const f32x4 kkA = nkA, kkB = nkB, kaA = naA, kaB = naB, dA = ndA, dB = ndB, kpA = npA, kpB = npB, rA = nrA, rB = nrB; const float vv = nvv;
                            if (tt < 7) RW3_LD(t + 1);
                            f32x2_ p = S0 * (f32x2_){kkA[0], kkA[1]}; p = S1 * (f32x2_){kkA[2], kkA[3]} + p; p = S2 * (f32x2_){kkB[0], kkB[1]} + p; p = S3 * (f32x2_){kkB[2], kkB[3]} + p;
                            float sa = p[0] + p[1];
                            sa = row8_sum(sa);
                            const f32x2_ sa2 = {sa, sa}, vv2 = {vv, vv};
                            S0 = S0 * (f32x2_){dA[0], dA[1]} + sa2 * (f32x2_){kaA[0], kaA[1]} + vv2 * (f32x2_){kpA[0], kpA[1]};
                            S1 = S1 * (f32x2_){dA[2], dA[3]} + sa2 * (f32x2_){kaA[2], kaA[3]} + vv2 * (f32x2_){kpA[2], kpA[3]};
                            S2 = S2 * (f32x2_){dB[0], dB[1]} + sa2 * (f32x2_){kaB[0], kaB[1]} + vv2 * (f32x2_){kpB[0], kpB[1]};
                            S3 = S3 * (f32x2_){dB[2], dB[3]} + sa2 * (f32x2_){kaB[2], kaB[3]} + vv2 * (f32x2_){kpB[2], kpB[3]};
                            f32x2_ q2 = S0 * (f32x2_){rA[0], rA[1]}; q2 = S1 * (f32x2_){rA[2], rA[3]} + q2; q2 = S2 * (f32x2_){rB[0], rB[1]} + q2; q2 = S3 * (f32x2_){rB[2], rB[3]} + q2;
                            float y = q2[0] + q2[1];
                            y = row8_sum(y);
                            yv[tt] = y;
                        }
#undef RW3_LD
                        if (kq == 0) {
#pragma unroll
                            for (int tt = 0; tt < 8; ++tt) osC[(seg * 8 + tt) * 32 + crow] = yv[tt]; }
                    }
                } else if (pact) {
                    if (seg == 0) {
                        float f[8];
                        unpack8(p0, f); { float* d = rsN + pt * 64 + pvc * 8; *(f32x4*)d = (f32x4){f[0], f[1], f[2], f[3]}; *(f32x4*)(d + 4) = (f32x4){f[4], f[5], f[6], f[7]}; }
                        unpack8(p1, f); { float* d = kpN + pt * 64 + pvc * 8; *(f32x4*)d = (f32x4){f[0], f[1], f[2], f[3]}; *(f32x4*)(d + 4) = (f32x4){f[4], f[5], f[6], f[7]}; }
                        unpack8(p2, f); { u32x4 w; w.x = pk_bf16(tanh_fast(f[0]), tanh_fast(f[1])); w.y = pk_bf16(tanh_fast(f[2]), tanh_fast(f[3]));
                            w.z = pk_bf16(tanh_fast(f[4]), tanh_fast(f[5])); w.w = pk_bf16(tanh_fast(f[6]), tanh_fast(f[7])); *(u32x4*)(WL + pt * 72 + pvc * 8) = w; }
                        *(u32x4*)(AL + pt * 72 + pvc * 8) = p3;
                        if (ptid < 128) { unpack8(p4, f); float* dv = vsN + vt_ * 32 + vvc * 8; *(f32x4*)dv = (f32x4){f[0], f[1], f[2], f[3]}; *(f32x4*)(dv + 4) = (f32x4){f[4], f[5], f[6], f[7]}; }
                        if (c + 2 < SEQ / 32) RW3_PREFETCH(c + 2);
                    } else if (seg == 1) {
#pragma unroll
                        for (int rt = 0; rt < 2; ++rt) {
                            f32x4 aw = {0.f, 0.f, 0.f, 0.f}, aa = {0.f, 0.f, 0.f, 0.f};
                            aw = MFMA16(ldfrag(WL, 72, rt * 16, 0, lane), ldfrag(WUPT, 72, pw * 16, 0, lane), aw); aw = MFMA16(ldfrag(WL, 72, rt * 16, 32, lane), ldfrag(WUPT, 72, pw * 16, 32, lane), aw);
                            aa = MFMA16(ldfrag(AL, 72, rt * 16, 0, lane), ldfrag(AUPT, 72, pw * 16, 0, lane), aa); aa = MFMA16(ldfrag(AL, 72, rt * 16, 32, lane), ldfrag(AUPT, 72, pw * 16, 32, lane), aa);
#pragma unroll
                            for (int jj = 0; jj < 4; ++jj) { const int t = rt * 16 + quad * 4 + jj;
                                const float sw = w0c + aw[jj], sa_ = a0c + aa[jj];
                                const float av = sigmoidf_(sa_);
                                const float kraw = kpN[t * 64 + cm];
                                dsN[t * 64 + cm] = __expf(-0.6065306597f * sigmoidf_(sw));
                                kkN[t * 64 + cm] = kraw * kkc;
                                kpN[t * 64 + cm] = kraw * (1.0f + (av - 1.0f) * kac);
                                kaN[t * 64 + cm] = av; } }
                    } else if (seg == 2) {
                        const int t = ptid >> 3;
                        float* pk_ = kkN + t * 64 + rpart * 8; float* pa_ = kaN + t * 64 + rpart * 8;
                        const f32x4 k0 = *(const f32x4*)pk_, k1 = *(const f32x4*)(pk_ + 4), a0 = *(const f32x4*)pa_, a1 = *(const f32x4*)(pa_ + 4);
                        const f32x4 r0 = *(const f32x4*)(rsN + t * 64 + rpart * 8), r1 = *(const f32x4*)(rsN + t * 64 + rpart * 8 + 4);
                        const f32x4 q0 = *(const f32x4*)(kpN + t * 64 + rpart * 8), q1 = *(const f32x4*)(kpN + t * 64 + rpart * 8 + 4);
                        const float ss = row8_sum(k0[0] * k0[0] + k0[1] * k0[1] + k0[2] * k0[2] + k0[3] * k0[3] + k1[0] * k1[0] + k1[1] * k1[1] + k1[2] * k1[2] + k1[3] * k1[3]);
                        const float inv = rsqrtf(ss + 1e-6f);
                        const f32x4 n0 = k0 * inv, n1 = k1 * inv;
                        *(f32x4*)pk_ = -n0; *(f32x4*)(pk_ + 4) = -n1; *(f32x4*)pa_ = n0 * a0; *(f32x4*)(pa_ + 4) = n1 * a1;
                        const float bo = row8_sum(r0[0] * q0[0] * rkA[0] + r0[1] * q0[1] * rkA[1] + r0[2] * q0[2] * rkA[2] + r0[3] * q0[3] * rkA[3]
                                                  + r1[0] * q1[0] * rkB[0] + r1[1] * q1[1] * rkB[1] + r1[2] * q1[2] * rkB[2] + r1[3] * q1[3] * rkB[3]);
                        if (half == 0 && rpart == 0) bonus[(rowb + (size_t)(c + 1) * 32 + t) * 16 + hd] = bo;
                    }
                }
                if (seg < 3) __syncthreads();
            }
        }
        __syncthreads();
        if (!producer) {
            const int cl = SEQ / 32 - 1; const float* osL = osb + (cl & 1) * 1024;
            const int t = tid >> 3, c4 = (tid & 7) * 4; const f32x4 v = *(const f32x4*)(osL + t * 32 + c4);
            u32x2 w; w.x = pk_bf16(v[0], v[1]); w.y = pk_bf16(v[2], v[3]);
            *(u32x2*)(O + (rowb + (size_t)cl * 32 + t) * DM + hd * 64 + half * 32 + c4) = w; }
#undef RW3_PREFETCH
    }
}
__device__ __forceinline__ void phase_rw_post(const KA a) {
    const bf16_t* h = (const bf16_t*)(a.ws() + WS_H);
    const bf16_t* O = (const bf16_t*)(a.ws() + WS_X);
    const float* bonus = (const float*)(a.ws() + WS_BONUS);
    bf16_t* Y = (bf16_t*)(a.ws() + WS_X + 64 * MiB);
    const int lane = ltid() & 63, wid = ltid() >> 6;
    float gw[16], gb[16];
#pragma unroll
    for (int e = 0; e < 16; ++e) { gw[e] = a.in(22)[lane * 16 + e]; gb[e] = a.in(23)[lane * 16 + e]; }
    const int stride = (int)gridDim.x * 8;
    int row = lbid() * 8 + wid;
    u32x4 n0[6]; float nbo = 0.f;
#define RWP_LOAD(R) do { n0[0] = *(const u32x4*)(O + (size_t)(R) * DM + lane * 16); n0[1] = *(const u32x4*)(O + (size_t)(R) * DM + lane * 16 + 8); \
        n0[2] = *(const u32x4*)(h + (size_t)(R) * NH + 3072 + lane * 16); n0[3] = *(const u32x4*)(h + (size_t)(R) * NH + 3072 + lane * 16 + 8); \
        n0[4] = *(const u32x4*)(h + (size_t)(R) * NH + 2048 + lane * 16); n0[5] = *(const u32x4*)(h + (size_t)(R) * NH + 2048 + lane * 16 + 8); \
        nbo = bonus[(size_t)(R) * 16 + (lane >> 2)]; } while (0)
    if (row < MTOK) RWP_LOAD(row);
    for (; row < MTOK; row += stride) {
        float o[16], z[16], v[16];
        unpack8(n0[0], *(float(*)[8])&o[0]); unpack8(n0[1], *(float(*)[8])&o[8]); unpack8(n0[2], *(float(*)[8])&z[0]); unpack8(n0[3], *(float(*)[8])&z[8]);
        unpack8(n0[4], *(float(*)[8])&v[0]); unpack8(n0[5], *(float(*)[8])&v[8]);
        const float bo = nbo;
        const int nr = row + stride;
        if (nr < MTOK) RWP_LOAD(nr);
        float s = 0.f;
#pragma unroll
        for (int e = 0; e < 16; ++e) s += o[e];
        s = quad_sum(s);
        const float mu = s * (1.0f / 64.0f);
        float ss = 0.f;
#pragma unroll
        for (int e = 0; e < 16; ++e) { const float d = o[e] - mu; ss += d * d; }
        ss = quad_sum(ss);
        const float sc = rsqrtf(ss * (1.0f / 64.0f) + 64e-5f);
        float y[16];
#pragma unroll
        for (int e = 0; e < 16; ++e) y[e] = ((o[e] - mu) * sc * gw[e] + gb[e] + bo * v[e]) * siluf_(z[e]);
        u32x4 w0, w1; w0.x = pk_bf16(y[0], y[1]); w0.y = pk_bf16(y[2], y[3]); w0.z = pk_bf16(y[4], y[5]); w0.w = pk_bf16(y[6], y[7]);
        w1.x = pk_bf16(y[8], y[9]); w1.y = pk_bf16(y[10], y[11]); w1.z = pk_bf16(y[12], y[13]); w1.w = pk_bf16(y[14], y[15]);
        *(u32x4*)(Y + (size_t)row * DM + lane * 16) = w0; *(u32x4*)(Y + (size_t)row * DM + lane * 16 + 8) = w1;
    }
#undef RWP_LOAD
}

__device__ __forceinline__ bf16_t* dn_seg(bf16_t* h, size_t row0, int hd, int sgi) { const int ar = sgi / 61, r = sgi - ar * 61; return h + (row0 + r) * NH + ar * 1024 + hd * 128; }
__device__ __forceinline__ void phase_dn_prep2(const KA a, int j, unsigned char* shm_) {
    bf16_t* h = (bf16_t*)(a.ws() + WS_H);
    float* E63 = (float*)(a.ws() + WS_BONUS);
    const float* convw = a.in(8) + (size_t)j * 4 * 3072;
    bf16_t* Kraw = (bf16_t*)shm_; bf16_t* KT = (bf16_t*)(shm_ + 17408); bf16_t* VT = (bf16_t*)(shm_ + 35840);
    float* Ap = (float*)(shm_ + 54272); bf16_t* T1 = (bf16_t*)(shm_ + 70656); bf16_t* T2 = (bf16_t*)(shm_ + 79872);
    float* gt = (float*)(shm_ + 89088); float* bet = gt; float* Gs = gt + 64; float* eG = gt + 128; float* rk = gt + 192;
    bf16_t* Vraw = (bf16_t*)(shm_ + 90112); bf16_t* Qraw = (bf16_t*)(shm_ + 107520);
    float* rq = (float*)(shm_ + 124928); float* kds = rq + 64; float* rqp = rq + 128;
    const int tid0 = ltid();
#define DNP_IDX(T) const int tid = (T), wid = tid >> 6, lane = tid & 63, quad = lane >> 4, l15 = lane & 15, cidx = tid & 255, cvc = cidx & 31, ctg = cidx >> 5, cisv = tid >> 8, qc2 = tid & 63, qtg = tid >> 6; (void)quad; (void)l15
    u32x2 praw[11]; unsigned qraw[11]; float pbp = 0.f, pap = 0.f;
#define DNP_PREFETCH(U) do { const int ch_ = (U) & 63, hd_ = ((U) >> 6) & 7, b_ = (U) >> 9; const int t0p = ch_ * 64; const size_t rowp = (size_t)b_ * SEQ + t0p; \
        const int hc = 1024 + cisv * 1024 + hd_ * 128 + cvc * 4; const int hq = hd_ * 128 + qc2 * 2; \
        _Pragma("unroll") for (int i = 0; i < 11; ++i) { const int tl = ctg * 8 - 3 + i; \
            if (t0p + tl >= 0) praw[i] = *(const u32x2*)(h + (size_t)((long)rowp + tl) * NH + hc); else praw[i] = (u32x2){0u, 0u}; } \
        _Pragma("unroll") for (int i = 0; i < 11; ++i) { const int tl = qtg * 8 - 3 + i; \
            if (t0p + tl >= 0) qraw[i] = *(const unsigned*)(h + (size_t)((long)rowp + tl) * NH + hq); else qraw[i] = 0u; } \
        if (wid == 5) { pbp = bf2f(h[(rowp + lane) * NH + 4096 + hd_]); pap = bf2f(h[(rowp + lane) * NH + 4104 + hd_]); } } while (0)
    { DNP_IDX(tid0); const int u0 = lbid(); if (u0 < NB * 8 * 64) DNP_PREFETCH(u0); }
    for (int unit = lbid(); unit < NB * 8 * 64; unit += gridDim.x) {
        int tl_ = tid0; asm volatile("" : "+v"(tl_));
        DNP_IDX(tl_);
        const int ch = unit & 63, hd = (unit >> 6) & 7, b = unit >> 9;
        const int t0 = ch * 64; const size_t row0 = (size_t)b * SEQ + t0;
        bf16_t* Wg = (bf16_t*)(a.ws() + WS_X + (size_t)unit * 16384); bf16_t* Ug = (bf16_t*)(a.ws() + WS_X + 64 * MiB + (size_t)unit * 16384);
        f32x4 pwv[4]; f32x2_ qwv[4];
#pragma unroll
        for (int jw = 0; jw < 4; ++jw) { pwv[jw] = *(const f32x4*)(convw + jw * 3072 + 1024 + cisv * 1024 + hd * 128 + cvc * 4); qwv[jw] = *(const f32x2_*)(convw + jw * 3072 + hd * 128 + qc2 * 2); }
        __syncthreads();
        {
            bf16_t* rm = cisv ? Vraw : Kraw;
            f32x4 x0, x1, x2, x3;
#define DN_X(i) ((f32x4){bflo(praw[i].x), bfhi(praw[i].x), bflo(praw[i].y), bfhi(praw[i].y)})
            x1 = DN_X(0); x2 = DN_X(1); x3 = DN_X(2);
#pragma unroll
            for (int i = 3; i < 11; ++i) {
                x0 = x1; x1 = x2; x2 = x3; x3 = DN_X(i);
                const f32x4 y = pwv[0] * x0 + pwv[1] * x1 + pwv[2] * x2 + pwv[3] * x3;
                u32x2 o; o.x = pk_bf16(siluf_(y[0]), siluf_(y[1])); o.y = pk_bf16(siluf_(y[2]), siluf_(y[3]));
                *(u32x2*)(rm + (ctg * 8 + i - 3) * 136 + cvc * 4) = o;
            }
#undef DN_X
            __builtin_amdgcn_sched_barrier(0);
            f32x2_ q0, q1, q2, q3;
#define DN_Q(i) ((f32x2_){bflo(qraw[i]), bfhi(qraw[i])})
            q1 = DN_Q(0); q2 = DN_Q(1); q3 = DN_Q(2);
#pragma unroll
            for (int i = 3; i < 11; ++i) {
                q0 = q1; q1 = q2; q2 = q3; q3 = DN_Q(i);
                const f32x2_ y = qwv[0] * q0 + qwv[1] * q1 + qwv[2] * q2 + qwv[3] * q3;
                *(unsigned*)(Qraw + (qtg * 8 + i - 3) * 136 + qc2 * 2) = pk_bf16(siluf_(y[0]), siluf_(y[1]));
            }
#undef DN_Q
        }
        if (wid == 5) { const int t = lane;
            float g = -__expf(a.in(9)[j * 8 + hd]) * softplusf_(pap + a.in(10)[j * 8 + hd]);
#pragma unroll
            for (int off = 1; off < 64; off <<= 1) { const float y = __shfl_up(g, off, 64); if (lane >= off) g += y; }
            bet[t] = sigmoidf_(pbp); Gs[t] = g; eG[t] = __expf(g);
            if (lane == 63) E63[unit] = __expf(g); }
        __syncthreads();
        {
            const int row = tid >> 2, part = tid & 3, which = row >> 6, t = row & 63;
            const bf16_t* src = (which ? Kraw : Qraw) + t * 136 + part * 32;
            float ss = 0.f;
#pragma unroll
            for (int q8 = 0; q8 < 4; ++q8) { float f[8]; unpack8(*(const u32x4*)(src + q8 * 8), f);
#pragma unroll
                for (int e = 0; e < 8; ++e) ss += f[e] * f[e]; }
            ss = quad_sum(ss);
            if (part == 0) { const float r = rsqrtf(ss + 1e-6f);
                if (which) { rk[t] = r; kds[t] = r * __expf(Gs[63] - Gs[t]); } else { rqp[t] = r * 0.08838834764831845f; rq[t] = r * 0.08838834764831845f * eG[t]; } } }
        __syncthreads();
        { const int d = tid & 127, jg = tid >> 7;
#pragma unroll
          for (int r = 0; r < 2; ++r) { const bf16_t* src = r ? Vraw : Kraw; bf16_t* dst = r ? VT : KT;
            bf16_t raw[16];
#pragma unroll
            for (int jj = 0; jj < 16; ++jj) raw[jj] = src[(jg * 16 + jj) * 136 + d];
            u32x4 w0, w1; w0.x = raw[0] | ((unsigned)raw[1] << 16); w0.y = raw[2] | ((unsigned)raw[3] << 16); w0.z = raw[4] | ((unsigned)raw[5] << 16); w0.w = raw[6] | ((unsigned)raw[7] << 16);
            w1.x = raw[8] | ((unsigned)raw[9] << 16); w1.y = raw[10] | ((unsigned)raw[11] << 16); w1.z = raw[12] | ((unsigned)raw[13] << 16); w1.w = raw[14] | ((unsigned)raw[15] << 16);
            *(u32x4*)(dst + d * 72 + jg * 16) = w0; *(u32x4*)(dst + d * 72 + jg * 16 + 8) = w1;
            if (r == 0) { float kv[16];
#pragma unroll
                for (int jj = 0; jj < 16; ++jj) kv[jj] = bf2f(raw[jj]) * kds[jg * 16 + jj];
                u32x4 g0, g1; g0.x = pk_bf16(kv[0], kv[1]); g0.y = pk_bf16(kv[2], kv[3]); g0.z = pk_bf16(kv[4], kv[5]); g0.w = pk_bf16(kv[6], kv[7]);
                g1.x = pk_bf16(kv[8], kv[9]); g1.y = pk_bf16(kv[10], kv[11]); g1.z = pk_bf16(kv[12], kv[13]); g1.w = pk_bf16(kv[14], kv[15]);
                bf16_t* kp_ = dn_seg(h, row0, hd, 64 + (d >> 1)) + (d & 1) * 64 + jg * 16;
                *(u32x4*)kp_ = g0; *(u32x4*)(kp_ + 8) = g1; }
            __builtin_amdgcn_sched_barrier(0); } }
        {
            const int t = tid >> 3, c16 = (tid & 7) * 16; const float sc = rq[t];
            float f[8]; u32x4 o0, o1;
            unpack8(*(const u32x4*)(Qraw + t * 136 + c16), f);
            o0.x = pk_bf16(f[0] * sc, f[1] * sc); o0.y = pk_bf16(f[2] * sc, f[3] * sc); o0.z = pk_bf16(f[4] * sc, f[5] * sc); o0.w = pk_bf16(f[6] * sc, f[7] * sc);
            unpack8(*(const u32x4*)(Qraw + t * 136 + c16 + 8), f);
            o1.x = pk_bf16(f[0] * sc, f[1] * sc); o1.y = pk_bf16(f[2] * sc, f[3] * sc); o1.z = pk_bf16(f[4] * sc, f[5] * sc); o1.w = pk_bf16(f[6] * sc, f[7] * sc);
            bf16_t* qp_ = dn_seg(h, row0, hd, t) + c16;
            *(u32x4*)qp_ = o0; *(u32x4*)(qp_ + 8) = o1; }
        __builtin_amdgcn_sched_barrier(0);
        { const int rt = wid >> 1;
#pragma unroll
          for (int c2 = 0; c2 < 2; ++c2) { const int ct = (wid & 1) * 2 + c2;
            f32x4 acc = {0.f, 0.f, 0.f, 0.f}, accp = {0.f, 0.f, 0.f, 0.f};
#pragma unroll
            for (int k0 = 0; k0 < 128; k0 += 32) { const bf16x8 bk = ldfrag(Kraw, 136, ct * 16, k0, lane);
                acc = MFMA16(ldfrag(Kraw, 136, rt * 16, k0, lane), bk, acc); accp = MFMA16(ldfrag(Qraw, 136, rt * 16, k0, lane), bk, accp); }
            const int jc = ct * 16 + l15; const float rkj = rk[jc], Gj = Gs[jc];
#pragma unroll
            for (int jj = 0; jj < 4; ++jj) { const int i = rt * 16 + quad * 4 + jj;
                const float dec = __expf(Gs[i] - Gj);
                const float av = (jc < i) ? bet[i] * rk[i] * rkj * dec * acc[jj] : 0.f;
                Ap[i * 64 + (jc & 7) * 8 + (jc >> 3)] = av;
                const float pv = (jc <= i) ? rqp[i] * rkj * dec * accp[jj] : 0.f;
                dn_seg(h, row0, hd, 128 + (i >> 1))[(i & 1) * 64 + jc] = f2bf1(pv); } } }
        __syncthreads();
        { const int un = unit + (int)gridDim.x; if (un < NB * 8 * 64) DNP_PREFETCH(un); }
        {
            const int c = wid * 8 + (lane >> 3), js = lane & 7;
            float Tl[8];
#pragma unroll
            for (int m = 0; m < 8; ++m) Tl[m] = 0.f;
            if (js == 0) Tl[0] = (c == 0) ? 1.f : 0.f;
#pragma unroll
            for (int i = 1; i < 64; ++i) {
                const f32x4 c0 = *(const f32x4*)(Ap + i * 64 + js * 8);
                f32x4 c1 = {0.f, 0.f, 0.f, 0.f};
                if (i > 32) c1 = *(const f32x4*)(Ap + i * 64 + js * 8 + 4);
                float part = 0.f;
#pragma unroll
                for (int m = 0; m < (i + 7) / 8; ++m) part += (m < 4 ? c0[m & 3] : c1[m & 3]) * Tl[m];
                const float sres = row8_sum(part);
                const float val = ((i == c) ? 1.f : 0.f) - sres;
                if (js == (i & 7)) Tl[i >> 3] = val;
            }
            const float s1 = bet[c], s2 = bet[c] * eG[c] * rk[c];
#pragma unroll
            for (int m = 0; m < 8; ++m) { const int i = js + 8 * m; T1[i * 72 + c] = f2bf1(Tl[m] * s1); T2[i * 72 + c] = f2bf1(Tl[m] * s2); }
        }
        __syncthreads();
        {
            const bf16x8 bv0 = ldfrag(VT, 72, wid * 16, 0, lane), bv1 = ldfrag(VT, 72, wid * 16, 32, lane);
            const bf16x8 bk0 = ldfrag(KT, 72, wid * 16, 0, lane), bk1 = ldfrag(KT, 72, wid * 16, 32, lane);
#pragma unroll
            for (int rt = 0; rt < 4; ++rt) {
                f32x4 au = {0.f, 0.f, 0.f, 0.f}, aw = {0.f, 0.f, 0.f, 0.f};
                au = MFMA16(ldfrag(T1, 72, rt * 16, 0, lane), bv0, au); au = MFMA16(ldfrag(T1, 72, rt * 16, 32, lane), bv1, au);
                aw = MFMA16(ldfrag(T2, 72, rt * 16, 0, lane), bk0, aw); aw = MFMA16(ldfrag(T2, 72, rt * 16, 32, lane), bk1, aw);
#pragma unroll
                for (int jj = 0; jj < 4; ++jj) { const int i = rt * 16 + quad * 4 + jj;
                    Ug[i * 128 + wid * 16 + l15] = f2bf1(au[jj]); Wg[i * 128 + wid * 16 + l15] = f2bf1(aw[jj]); } }
        }
    }
#undef DNP_PREFETCH
#undef DNP_IDX
}
__device__ __forceinline__ void phase_dn_chunk2(const KA a, int j, unsigned char* shm_) {
    bf16_t* h = (bf16_t*)(a.ws() + WS_H);
    const float* E63 = (const float*)(a.ws() + WS_BONUS);
    bf16_t* Qsl = (bf16_t*)shm_; bf16_t* KdT = (bf16_t*)(shm_ + 34816); bf16_t* Wbf = (bf16_t*)(shm_ + 53248);
    bf16_t* ST = (bf16_t*)(shm_ + 70656); bf16_t* Pbf = (bf16_t*)(shm_ + 79360); bf16_t* VnT = (bf16_t*)(shm_ + 88576);
    const int tid = ltid(), wid = tid >> 6, lane = tid & 63, quad = lane >> 4, l15 = lane & 15;
    for (int unit = lbid(); unit < NB * 8 * 4; unit += gridDim.x) {
        const int un_ = (gridDim.x == 256) ? xcd_unit(unit) : unit; const int b = un_ >> 5, hd = (un_ >> 2) & 7, q4 = un_ & 3;
        f32x4 st0 = {0.f, 0.f, 0.f, 0.f}, st1 = {0.f, 0.f, 0.f, 0.f};
        __syncthreads();
        for (int i = tid; i < 32 * 136 / 2; i += NTHR) ((unsigned*)ST)[i] = 0u;
        const int rt = wid >> 1, et = wid & 1;
        const size_t rowb = (size_t)b * SEQ;
        const bf16_t* Wg0 = (const bf16_t*)(a.ws() + WS_X + (size_t)((b * 8 + hd) * 64) * 16384);
        bf16_t* Ug0 = (bf16_t*)(a.ws() + WS_X + 64 * MiB + (size_t)((b * 8 + hd) * 64) * 16384);
        u32x4 pq[2], pk_[2], pp, pw[2]; bf16_t pu[4]; float pe = 0.f;
#define DN2_PREFETCH(CH) do { const size_t r0p = rowb + (size_t)(CH) * 64; const bf16_t* Wgp = Wg0 + (size_t)(CH) * 8192; const bf16_t* Ugp = Ug0 + (size_t)(CH) * 8192; \
            _Pragma("unroll") for (int r = 0; r < 2; ++r) { const int p = tid + NTHR * r; \
                pq[r] = *(const u32x4*)(dn_seg(h, r0p, hd, p >> 4) + (p & 15) * 8); \
                const int d = p >> 3; pk_[r] = *(const u32x4*)(dn_seg(h, r0p, hd, 64 + (d >> 1)) + (d & 1) * 64 + (p & 7) * 8); \
                pw[r] = *(const u32x4*)(Wgp + (p >> 4) * 128 + (p & 15) * 8); } \
            { const int i = tid >> 3; pp = *(const u32x4*)(dn_seg(h, r0p, hd, 128 + (i >> 1)) + (i & 1) * 64 + (tid & 7) * 8); } \
            _Pragma("unroll") for (int jj = 0; jj < 4; ++jj) pu[jj] = Ugp[(rt * 16 + quad * 4 + jj) * 128 + q4 * 32 + et * 16 + l15]; \
            pe = E63[(b * 8 + hd) * 64 + (CH)]; } while (0)
        DN2_PREFETCH(0);
        for (int ch = 0; ch < SEQ / 64; ++ch) {
            __syncthreads();
#pragma unroll
            for (int r = 0; r < 2; ++r) { const int p = tid + NTHR * r;
                *(u32x4*)(Qsl + (p >> 4) * 136 + (p & 15) * 8) = pq[r];
                *(u32x4*)(KdT + (p >> 3) * 72 + (p & 7) * 8) = pk_[r];
                *(u32x4*)(Wbf + (p >> 4) * 136 + (p & 15) * 8) = pw[r]; }
            *(u32x4*)(Pbf + (tid >> 3) * 72 + (tid & 7) * 8) = pp;
            float ureg[4];
#pragma unroll
            for (int jj = 0; jj < 4; ++jj) ureg[jj] = bf2f(pu[jj]);
            const float eg63 = pe;
            if (ch + 1 < SEQ / 64) DN2_PREFETCH(ch + 1);
            __syncthreads();
            f32x4 accv = {0.f, 0.f, 0.f, 0.f}, acco = {0.f, 0.f, 0.f, 0.f};
#pragma unroll
            for (int k0 = 0; k0 < 128; k0 += 32) { const bf16x8 bs = ldfrag(ST, 136, et * 16, k0, lane);
                accv = MFMA16(ldfrag(Wbf, 136, rt * 16, k0, lane), bs, accv);
                acco = MFMA16(ldfrag(Qsl, 136, rt * 16, k0, lane), bs, acco); }
            { u32x2 w; w.x = pk_bf16(ureg[0] - accv[0], ureg[1] - accv[1]); w.y = pk_bf16(ureg[2] - accv[2], ureg[3] - accv[3]);
              *(u32x2*)(VnT + (et * 16 + l15) * 72 + rt * 16 + quad * 4) = w; }
            __syncthreads();
            acco = MFMA16(ldfrag(Pbf, 72, rt * 16, 0, lane), ldfrag(VnT, 72, et * 16, 0, lane), acco);
            acco = MFMA16(ldfrag(Pbf, 72, rt * 16, 32, lane), ldfrag(VnT, 72, et * 16, 32, lane), acco);
#pragma unroll
            for (int jj = 0; jj < 4; ++jj) { const int i = rt * 16 + quad * 4 + jj;
                Ug0[(size_t)ch * 8192 + i * 128 + q4 * 32 + et * 16 + l15] = f2bf1(acco[jj]); }
            { const bf16x8 ak0 = ldfrag(KdT, 72, wid * 16, 0, lane), ak1 = ldfrag(KdT, 72, wid * 16, 32, lane);
              st0 = st0 * eg63; st1 = st1 * eg63;
              st0 = MFMA16(ak0, ldfrag(VnT, 72, 0, 0, lane), st0); st0 = MFMA16(ak1, ldfrag(VnT, 72, 0, 32, lane), st0);
              st1 = MFMA16(ak0, ldfrag(VnT, 72, 16, 0, lane), st1); st1 = MFMA16(ak1, ldfrag(VnT, 72, 16, 32, lane), st1);
              u32x2 w; w.x = pk_bf16(st0[0], st0[1]); w.y = pk_bf16(st0[2], st0[3]);
              *(u32x2*)(ST + (l15) * 136 + wid * 16 + quad * 4) = w;
              w.x = pk_bf16(st1[0], st1[1]); w.y = pk_bf16(st1[2], st1[3]);
              *(u32x2*)(ST + (16 + l15) * 136 + wid * 16 + quad * 4) = w; }
        }
#undef DN2_PREFETCH
    }
}
__device__ __forceinline__ void phase_ml_chunk(const KA a, unsigned char* shm_) {
    const bf16_t* h = (const bf16_t*)(a.ws() + WS_H);
    bf16_t* O = (bf16_t*)(a.ws() + WS_X);
    const float* convw = a.in(26);
    float* qs = (float*)shm_; float* ks = qs + 4096; float* vs = qs + 8192; float* Hout = qs + 10240;
    bf16_t* Qbf = (bf16_t*)(shm_ + 53248); bf16_t* Kbf = Qbf + 64 * 72; bf16_t* KwT = Kbf + 64 * 72; bf16_t* Wbf = KwT + 64 * 72; bf16_t* VT = Wbf + 64 * 72; bf16_t* CT = VT + 48 * 72;
    float* gt = (float*)(shm_ + 103936);
    float* il = gt; float* fl = gt + 64; float* ra = gt + 128; float* cb = gt + 192; float* inter = gt + 256; float* kscale = gt + 320; float* em = gt + 384; float* misc = gt + 448;
    const int tid = ltid(), wid = tid >> 6, lane = tid & 63, quad = lane >> 4, l15 = lane & 15;
    for (int unit = lbid(); unit < NB * 8 * 4; unit += gridDim.x) {
        const int un_ = (gridDim.x == 256) ? xcd_unit(unit) : unit; const int b = un_ >> 5, hd = (un_ >> 2) & 7, q4 = un_ & 3;
        const float ib = a.in(27)[hd], fb = a.in(28)[hd];
        f32x4 st0 = {0.f, 0.f, 0.f, 0.f}, st1 = {0.f, 0.f, 0.f, 0.f};
        float m_prev = -1e30f;
        __syncthreads();
        for (int i = tid; i < 48 * 72 / 2; i += NTHR) ((unsigned*)CT)[i] = 0u;
        for (int i = tid; i < 16 * 72; i += NTHR) VT[32 * 72 + i] = (i < 72) ? (bf16_t)0x3F80 : (bf16_t)0;
        const int cidx = tid & 127, cvc = cidx & 15, ctg = cidx >> 4, cisk = (tid >> 7) & 1;
        const int chc = cisk * 512 + hd * 64 + cvc * 4;
        const int vt_ = (tid & 255) >> 2, vvc = tid & 3, vcol = 1024 + hd * 128 + q4 * 32 + vvc * 8;
        const size_t rowb = (size_t)b * SEQ;
        f32x4 cwv[4];
#pragma unroll
        for (int jw = 0; jw < 4; ++jw) cwv[jw] = *(const f32x4*)(convw + jw * 1024 + chc);
        u32x2 praw[11]; u32x4 pv = {0u, 0u, 0u, 0u}; float pip = 0.f, pfp = 0.f;
#define ML_PREFETCH(CH) do { const int t0p = (CH) * 64; \
            if (tid < 256) { _Pragma("unroll") for (int i = 0; i < 11; ++i) { const int tl = ctg * 8 - 3 + i; \
                if (t0p + tl >= 0) praw[i] = *(const u32x2*)(h + (size_t)((long)(rowb + t0p) + tl) * NH + chc); else praw[i] = (u32x2){0u, 0u}; } } \
            else pv = *(const u32x4*)(h + (rowb + t0p + vt_) * NH + vcol); \
            if (wid == 6) { pip = bf2f(h[(rowb + t0p + lane) * NH + 4096 + hd]); pfp = bf2f(h[(rowb + t0p + lane) * NH + 4104 + hd]); } } while (0)
        ML_PREFETCH(0);
        for (int ch = 0; ch < SEQ / 64; ++ch) {
            const int t0 = ch * 64; const size_t row0 = (size_t)b * SEQ + t0;
            __syncthreads();
            if (tid < 256) {
                float* dst = (cisk ? ks : qs) + cvc * 4; const float sc = cisk ? 0.125f : 1.0f;
                f32x4 x0, x1, x2, x3;
#define ML_X(i) ((f32x4){bflo(praw[i].x), bfhi(praw[i].x), bflo(praw[i].y), bfhi(praw[i].y)})
                x1 = ML_X(0); x2 = ML_X(1); x3 = ML_X(2);
#pragma unroll
                for (int i = 3; i < 11; ++i) {
                    x0 = x1; x1 = x2; x2 = x3; x3 = ML_X(i);
                    const f32x4 y = cwv[0] * x0 + cwv[1] * x1 + cwv[2] * x2 + cwv[3] * x3;
                    *(f32x4*)(dst + (ctg * 8 + i - 3) * 64) = (f32x4){siluf_(y[0]) * sc, siluf_(y[1]) * sc, siluf_(y[2]) * sc, siluf_(y[3]) * sc};
                }
#undef ML_X
            } else { float f[8]; unpack8(pv, f); float* dv = vs + vt_ * 32 + vvc * 8;
                *(f32x4*)dv = (f32x4){f[0], f[1], f[2], f[3]}; *(f32x4*)(dv + 4) = (f32x4){f[4], f[5], f[6], f[7]}; }
            if (wid == 6) { il[lane] = pip + ib; fl[lane] = -softplusf_(-(pfp + fb)); }
            if (ch + 1 < SEQ / 64) ML_PREFETCH(ch + 1);
            __syncthreads();
            {
                const int t = tid >> 3, c8 = (tid & 7) * 8;
                const f32x4 q0 = *(const f32x4*)(qs + t * 64 + c8), q1 = *(const f32x4*)(qs + t * 64 + c8 + 4);
                const f32x4 k0 = *(const f32x4*)(ks + t * 64 + c8), k1 = *(const f32x4*)(ks + t * 64 + c8 + 4);
                u32x4 w; w.x = pk_bf16(q0[0], q0[1]); w.y = pk_bf16(q0[2], q0[3]); w.z = pk_bf16(q1[0], q1[1]); w.w = pk_bf16(q1[2], q1[3]); *(u32x4*)(Qbf + t * 72 + c8) = w;
                w.x = pk_bf16(k0[0], k0[1]); w.y = pk_bf16(k0[2], k0[3]); w.z = pk_bf16(k1[0], k1[1]); w.w = pk_bf16(k1[2], k1[3]); *(u32x4*)(Kbf + t * 72 + c8) = w;
                const int c = tid & 31, jg = tid >> 5;
                u32x2 v2; v2.x = pk_bf16(vs[(jg * 4 + 0) * 32 + c], vs[(jg * 4 + 1) * 32 + c]); v2.y = pk_bf16(vs[(jg * 4 + 2) * 32 + c], vs[(jg * 4 + 3) * 32 + c]);
                *(u32x2*)(VT + c * 72 + jg * 4) = v2;
            }
            if (wid == 7) {
                const float f = fl[lane], iv = il[lane];
                const float bs = wave_scan_add(f);
                const float cbv = iv - bs;
                const float cm = wave_scan_max(cbv);
                const float mi = fmaxf(m_prev + bs, bs + cm);
                const float b63 = __shfl(bs, 63, 64), mnew = __shfl(mi, 63, 64);
                ra[lane] = bs - mi; cb[lane] = cbv; inter[lane] = __expf(m_prev + bs - mi); kscale[lane] = __expf(b63 - mnew + cbv); em[lane] = __expf(-mi);
                if (lane == 0) misc[0] = __expf(m_prev + b63 - mnew);
                m_prev = mnew;
            }
            __syncthreads();
            {
                const int rt = wid >> 1;
#pragma unroll
                for (int c2 = 0; c2 < 2; ++c2) { const int ct = (wid & 1) * 2 + c2;
                    f32x4 acc = {0.f, 0.f, 0.f, 0.f};
                    acc = MFMA16(ldfrag(Qbf, 72, rt * 16, 0, lane), ldfrag(Kbf, 72, ct * 16, 0, lane), acc);
                    acc = MFMA16(ldfrag(Qbf, 72, rt * 16, 32, lane), ldfrag(Kbf, 72, ct * 16, 32, lane), acc);
                    const int jc = ct * 16 + l15; const float cbj = cb[jc];
#pragma unroll
                    for (int jj = 0; jj < 4; ++jj) { const int i = rt * 16 + quad * 4 + jj;
                        const float wv = (jc <= i) ? __expf(ra[i] + cbj) * acc[jj] : 0.f;
                        Wbf[i * 72 + jc] = f2bf1(wv); } }
                const int d = tid & 63, jg = tid >> 6;
                float kv[8];
#pragma unroll
                for (int jj = 0; jj < 8; ++jj) kv[jj] = ks[(jg * 8 + jj) * 64 + d] * kscale[jg * 8 + jj];
                u32x4 w; w.x = pk_bf16(kv[0], kv[1]); w.y = pk_bf16(kv[2], kv[3]); w.z = pk_bf16(kv[4], kv[5]); w.w = pk_bf16(kv[6], kv[7]);
                *(u32x4*)(KwT + d * 72 + jg * 8) = w;
            }
            __syncthreads();
            { const float carry = misc[0];
#pragma unroll
              for (int r = 0; r < 2; ++r) { const int id = wid + 8 * r;
                if (id < 12) { const int rt = id / 3, ct = id - rt * 3;
                    f32x4 acc = {0.f, 0.f, 0.f, 0.f};
                    acc = MFMA16(ldfrag(Qbf, 72, rt * 16, 0, lane), ldfrag(CT, 72, ct * 16, 0, lane), acc);
                    acc = MFMA16(ldfrag(Qbf, 72, rt * 16, 32, lane), ldfrag(CT, 72, ct * 16, 32, lane), acc);
#pragma unroll
                    for (int jj = 0; jj < 4; ++jj) acc[jj] *= inter[rt * 16 + quad * 4 + jj];
                    acc = MFMA16(ldfrag(Wbf, 72, rt * 16, 0, lane), ldfrag(VT, 72, ct * 16, 0, lane), acc);
                    acc = MFMA16(ldfrag(Wbf, 72, rt * 16, 32, lane), ldfrag(VT, 72, ct * 16, 32, lane), acc);
#pragma unroll
                    for (int jj = 0; jj < 4; ++jj) Hout[(rt * 16 + quad * 4 + jj) * 48 + ct * 16 + l15] = acc[jj];
                    f32x4 st = r ? st1 : st0;
                    st = st * carry;
                    st = MFMA16(ldfrag(KwT, 72, rt * 16, 0, lane), ldfrag(VT, 72, ct * 16, 0, lane), st);
                    st = MFMA16(ldfrag(KwT, 72, rt * 16, 32, lane), ldfrag(VT, 72, ct * 16, 32, lane), st);
                    if (r) st1 = st; else st0 = st; } } }
            __syncthreads();
#pragma unroll
            for (int r = 0; r < 2; ++r) { const int id = wid + 8 * r;
                if (id < 12) { const int dt = id / 3, ct = id - dt * 3; const f32x4 st = r ? st1 : st0;
                    u32x2 w; w.x = pk_bf16(st[0], st[1]); w.y = pk_bf16(st[2], st[3]);
                    *(u32x2*)(CT + (ct * 16 + l15) * 72 + dt * 16 + quad * 4) = w; } }
            { const int t = tid >> 3, c4 = (tid & 7) * 4;
              const f32x4 num = *(const f32x4*)(Hout + t * 48 + c4); const float den = Hout[t * 48 + 32];
              const float dd = 1.0f / fmaxf(fabsf(den), em[t]);
              u32x2 w; w.x = pk_bf16(num[0] * dd, num[1] * dd); w.y = pk_bf16(num[2] * dd, num[3] * dd);
              *(u32x2*)(O + (row0 + t) * DM + hd * 128 + q4 * 32 + c4) = w; }
        }
    }
#undef ML_PREFETCH
}
__device__ __forceinline__ void phase_ml_post(const KA a) {
    const bf16_t* h = (const bf16_t*)(a.ws() + WS_H);
    const bf16_t* O = (const bf16_t*)(a.ws() + WS_X);
    bf16_t* Y = (bf16_t*)(a.ws() + WS_X + 64 * MiB);
    const int lane = ltid() & 63, wid = ltid() >> 6;
    float gw[16];
#pragma unroll
    for (int e = 0; e < 16; ++e) gw[e] = a.in(29)[lane * 16 + e];
    const int stride = (int)gridDim.x * 8;
    int row = lbid() * 8 + wid;
    u32x4 n0[6];
#define MLP_LOAD(R) do { n0[0] = *(const u32x4*)(O + (size_t)(R) * DM + lane * 16); n0[1] = *(const u32x4*)(O + (size_t)(R) * DM + lane * 16 + 8); \
        n0[2] = *(const u32x4*)(h + (size_t)(R) * NH + 3072 + lane * 16); n0[3] = *(const u32x4*)(h + (size_t)(R) * NH + 3072 + lane * 16 + 8); \
        n0[4] = *(const u32x4*)(h + (size_t)(R) * NH + 2048 + lane * 16); n0[5] = *(const u32x4*)(h + (size_t)(R) * NH + 2048 + lane * 16 + 8); } while (0)
    if (row < MTOK) MLP_LOAD(row);
    for (; row < MTOK; row += stride) {
        float o[16], z[16], g[16];
        unpack8(n0[0], *(float(*)[8])&o[0]); unpack8(n0[1], *(float(*)[8])&o[8]); unpack8(n0[2], *(float(*)[8])&z[0]); unpack8(n0[3], *(float(*)[8])&z[8]);
        unpack8(n0[4], *(float(*)[8])&g[0]); unpack8(n0[5], *(float(*)[8])&g[8]);
        const int nr = row + stride;
        if (nr < MTOK) MLP_LOAD(nr);
        float s = 0.f;
#pragma unroll
        for (int e = 0; e < 16; ++e) { o[e] *= sigmoidf_(g[e]); s += o[e]; }
        s = row8_sum(s);
        const float mu = s * (1.0f / 128.0f);
        float ss = 0.f;
#pragma unroll
        for (int e = 0; e < 16; ++e) { const float d = o[e] - mu; ss += d * d; }
        ss = row8_sum(ss);
        const float sc = rsqrtf(ss * (1.0f / 128.0f) + 1e-6f);
        float y[16];
#pragma unroll
        for (int e = 0; e < 16; ++e) y[e] = (o[e] - mu) * sc * gw[e] * siluf_(z[e]);
        u32x4 w0, w1; w0.x = pk_bf16(y[0], y[1]); w0.y = pk_bf16(y[2], y[3]); w0.z = pk_bf16(y[4], y[5]); w0.w = pk_bf16(y[6], y[7]);
        w1.x = pk_bf16(y[8], y[9]); w1.y = pk_bf16(y[10], y[11]); w1.z = pk_bf16(y[12], y[13]); w1.w = pk_bf16(y[14], y[15]);
        *(u32x4*)(Y + (size_t)row * DM + lane * 16) = w0; *(u32x4*)(Y + (size_t)row * DM + lane * 16 + 8) = w1;
    }
#undef MLP_LOAD
}

__device__ __forceinline__ void phase_ln(const KA a, int L) {
    const bf16_t* Yb = (const bf16_t*)(a.ws() + WS_H);
    const float* xr = (L == 0) ? a.in(0) : (const float*)a.out();
    bf16_t* xb = (bf16_t*)(a.ws() + WS_X);
    bf16_t* pb = (bf16_t*)(a.ws() + WS_P);
    const float* p = a.in(1) + (size_t)L * MTOK * DPLE;
    const float* lg = a.in(2) + L * DM; const float* lb = a.in(3) + L * DM;
    const int lane = ltid() & 63, wid = ltid() >> 6;
    f32x4 g[4], bb[4];
#pragma unroll
    for (int i = 0; i < 4; ++i) { g[i] = *(const f32x4*)(lg + i * 256 + lane * 4); bb[i] = *(const f32x4*)(lb + i * 256 + lane * 4); }
    const int stride = (int)gridDim.x * 8;
    int row = lbid() * 8 + wid;
    f32x4 nv[4], npv; u32x2 ny[4];
    if (row < MTOK) {
#pragma unroll
        for (int i = 0; i < 4; ++i) { nv[i] = *(const f32x4*)(xr + (size_t)row * DM + i * 256 + lane * 4); ny[i] = *(const u32x2*)(Yb + (size_t)row * DM + i * 256 + lane * 4); }
        npv = *(const f32x4*)(p + (size_t)row * DPLE + lane * 4); }
    for (; row < MTOK; row += stride) {
        f32x4 v[4]; const f32x4 pv = npv; float s = 0.f;
#pragma unroll
        for (int i = 0; i < 4; ++i) { v[i] = nv[i] * ALPHA + (f32x4){bflo(ny[i].x), bfhi(ny[i].x), bflo(ny[i].y), bfhi(ny[i].y)}; s += v[i][0] + v[i][1] + v[i][2] + v[i][3]; }
        const int nr = row + stride;
        if (nr < MTOK) {
#pragma unroll
            for (int i = 0; i < 4; ++i) { nv[i] = *(const f32x4*)(xr + (size_t)nr * DM + i * 256 + lane * 4); ny[i] = *(const u32x2*)(Yb + (size_t)nr * DM + i * 256 + lane * 4); }
            npv = *(const f32x4*)(p + (size_t)nr * DPLE + lane * 4); }
        const float mu = wave_sum(s) * (1.0f / 1024.0f);
        float ss = 0.f;
#pragma unroll
        for (int i = 0; i < 4; ++i) { v[i] = v[i] - mu; ss += v[i][0] * v[i][0] + v[i][1] * v[i][1] + v[i][2] * v[i][2] + v[i][3] * v[i][3]; }
        const float sc = rsqrtf(wave_sum(ss) * (1.0f / 1024.0f) + 1e-5f);
#pragma unroll
        for (int i = 0; i < 4; ++i) { const f32x4 y = v[i] * sc * g[i] + bb[i];
            u32x2 w; w.x = pk_bf16(y[0], y[1]); w.y = pk_bf16(y[2], y[3]); *(u32x2*)(xb + (size_t)row * DM + i * 256 + lane * 4) = w; }
        { u32x2 w; w.x = pk_bf16(pv[0], pv[1]); w.y = pk_bf16(pv[2], pv[3]); *(u32x2*)(pb + (size_t)row * DPLE + lane * 4) = w; }
    }
}
__device__ __forceinline__ void phase_combine(const KA a, int L) {
    const bf16_t* Yb = (const bf16_t*)(a.ws() + WS_H);
    const float* xr = (L == 0) ? a.in(0) : (const float*)a.out();
    const bf16_t* PP = (const bf16_t*)(a.ws() + WS_H + 128 * MiB);
    const bf16_t* G = (const bf16_t*)(a.ws() + WS_H + 192 * MiB);
    bf16_t* xb = (bf16_t*)(a.ws() + WS_X);
    const float* nw = a.in(5) + L * DM; const float* lg = a.in(2) + L * DM; const float* lb = a.in(3) + L * DM;
    const int lane = ltid() & 63, wid = ltid() >> 6;
    const int next_kind = (L + 1 < NLAYER) ? ((L + 1) % 3) : -1;
    const int stride = (int)gridDim.x * 8;
    int row = lbid() * 8 + wid;
    f32x4 ntv[4]; u32x2 npr[4], ngr[4], nyr[4];
    if (row < MTOK) {
#pragma unroll
        for (int i = 0; i < 4; ++i) { const size_t o = (size_t)row * DM + i * 256 + lane * 4; ntv[i] = *(const f32x4*)(xr + o); nyr[i] = *(const u32x2*)(Yb + o); npr[i] = *(const u32x2*)(PP + o); ngr[i] = *(const u32x2*)(G + o); } }
    for (; row < MTOK; row += stride) {
        f32x4 tv[4], pp[4]; u32x2 gr[4]; float s = 0.f, ss = 0.f;
#pragma unroll
        for (int i = 0; i < 4; ++i) { tv[i] = ntv[i] * ALPHA + (f32x4){bflo(nyr[i].x), bfhi(nyr[i].x), bflo(nyr[i].y), bfhi(nyr[i].y)}; gr[i] = ngr[i]; s += tv[i][0] + tv[i][1] + tv[i][2] + tv[i][3];
            pp[i] = (f32x4){bflo(npr[i].x), bfhi(npr[i].x), bflo(npr[i].y), bfhi(npr[i].y)};
            ss += pp[i][0] * pp[i][0] + pp[i][1] * pp[i][1] + pp[i][2] * pp[i][2] + pp[i][3] * pp[i][3]; }
        const int nr = row + stride;
        if (nr < MTOK) {
#pragma unroll
            for (int i = 0; i < 4; ++i) { const size_t o = (size_t)nr * DM + i * 256 + lane * 4; ntv[i] = *(const f32x4*)(xr + o); nyr[i] = *(const u32x2*)(Yb + o); npr[i] = *(const u32x2*)(PP + o); ngr[i] = *(const u32x2*)(G + o); } }
        const float mu = wave_sum(s) * (1.0f / 1024.0f);
        const float psc = rsqrtf(wave_sum(ss) * (1.0f / 1024.0f) + 1e-6f);
        float vs_ = 0.f;
#pragma unroll
        for (int i = 0; i < 4; ++i) { tv[i] = tv[i] - mu; vs_ += tv[i][0] * tv[i][0] + tv[i][1] * tv[i][1] + tv[i][2] * tv[i][2] + tv[i][3] * tv[i][3]; }
        const float lsc = rsqrtf(wave_sum(vs_) * (1.0f / 1024.0f) + 1e-5f);
#pragma unroll
        for (int i = 0; i < 4; ++i) {
            const int c = i * 256 + lane * 4; const size_t o = (size_t)row * DM + c;
            const f32x4 x1 = tv[i] * lsc * *(const f32x4*)(lg + c) + *(const f32x4*)(lb + c);
            const f32x4 gg = {bflo(gr[i].x), bfhi(gr[i].x), bflo(gr[i].y), bfhi(gr[i].y)};
            const f32x4 y = x1 + gg * pp[i] * psc * *(const f32x4*)(nw + c);
            *(f32x4*)(a.out() + o) = y;
            u32x2 w; w.x = pk_bf16(y[0], y[1]); w.y = pk_bf16(y[2], y[3]);
            if (next_kind == 1) {
                *(u32x2*)(xb + (size_t)row * 2048 + c) = w;
                if ((row & (SEQ - 1)) != SEQ - 1) *(u32x2*)(xb + (size_t)(row + 1) * 2048 + 1024 + c) = w;
                if ((row & (SEQ - 1)) == 0) { u32x2 zz; zz.x = 0u; zz.y = 0u; *(u32x2*)(xb + (size_t)row * 2048 + 1024 + c) = zz; }
            } else if (next_kind >= 0) {
                *(u32x2*)(xb + o) = w;
            }
        }
    }
}

#define XB_TMO      128
#define XB_XCNT(j)  (256  + 64 * (j))
#define XB_XSUB(j)  (1280 + 64 * (j))
#define XB_XGEN(j)  (2304 + 64 * (j))
#define XB_TOP      3328
#define XB_TOPGEN   3392
#define XCD_BAR_WORDS 3456
#define XB_SPIN_CAP (1u << 18)
__device__ __forceinline__ unsigned xb_ld(unsigned* p)              { return __hip_atomic_load(p, __ATOMIC_RELAXED, __HIP_MEMORY_SCOPE_AGENT); }
__device__ __forceinline__ unsigned xb_add(unsigned* p, unsigned v) { return __hip_atomic_fetch_add(p, v, __ATOMIC_RELAXED, __HIP_MEMORY_SCOPE_AGENT); }
__device__ __forceinline__ unsigned xb_xcc_id() { return (unsigned)__builtin_amdgcn_s_getreg((3 << 11) | 20) & 0xFu; }
#define XB_SPIN(cond, bar) do { unsigned _sp = 0; while (cond) { __builtin_amdgcn_s_sleep(1); \
    if ((++_sp & 255u) == 0u) { if (xb_ld(&(bar)[XB_TMO])) break; if (_sp > XB_SPIN_CAP) { atomicAdd(&(bar)[XB_TMO], 1u); break; } } } } while (0)
struct XcdBarrier { unsigned* bar; unsigned x; volatile LAS unsigned* st; };
__device__ __forceinline__ void xcd_barrier_complete(unsigned* bar, unsigned x, unsigned& nloc, unsigned& nx) {
    const unsigned G = gridDim.x * gridDim.y * gridDim.z;
    unsigned sum, cnt, mine, sp = 0u;
    for (;;) {
        sum = 0u; cnt = 0u; mine = 0u;
#pragma unroll
        for (unsigned j = 0; j < 16; ++j) { const unsigned c = xb_ld(&bar[XB_XCNT(j)]); sum += c; cnt += (c > 0u) ? 1u : 0u; mine = (j == x) ? c : mine; }
        if (sum == G) break;
        __builtin_amdgcn_s_sleep(1);
        if ((++sp & 255u) == 0u) { if (xb_ld(&bar[XB_TMO])) break; if (sp > XB_SPIN_CAP) { atomicAdd(&bar[XB_TMO], 1u); break; } }
    }
    nloc = mine > 0u ? mine : 1u; nx = cnt > 0u ? cnt : 1u;
}
__device__ __forceinline__ void xcd_barrier(const XcdBarrier& b) {
    asm volatile("s_waitcnt vmcnt(0)" ::: "memory");
    __syncthreads();
    if (threadIdx.x == 0) {
        unsigned* bar = b.bar;
        __builtin_amdgcn_s_waitcnt(0);
        unsigned nloc = b.st[0], nx = b.st[1];
        if (nloc == 0u) { xcd_barrier_complete(bar, b.x, nloc, nx); b.st[0] = nloc; b.st[1] = nx; }
        const unsigned old = xb_add(&bar[XB_XSUB(b.x)], 1u);
        const unsigned gen = old / nloc;
        if (old + 1u == (gen + 1u) * nloc) {
            __builtin_amdgcn_fence(__ATOMIC_RELEASE, "agent");
            asm volatile("s_waitcnt vmcnt(0)" ::: "memory");
            const unsigned og = xb_add(&bar[XB_TOP], 1u);
            const unsigned tg = og / nx;
            if (og + 1u == (tg + 1u) * nx) xb_add(&bar[XB_TOPGEN], 1u);
            else XB_SPIN(xb_ld(&bar[XB_TOPGEN]) == tg, bar);
            __builtin_amdgcn_fence(__ATOMIC_ACQUIRE, "agent");
            xb_add(&bar[XB_XGEN(b.x)], 1u);
            asm volatile("s_waitcnt vmcnt(0)" ::: "memory");
        } else {
            XB_SPIN(xb_ld(&bar[XB_XGEN(b.x)]) == gen, bar);
            __builtin_amdgcn_fence(__ATOMIC_ACQUIRE, "agent");
            asm volatile("s_waitcnt vmcnt(0)" ::: "memory");
        }
    }
    __syncthreads();
}

constexpr int NSTEP = 9;
constexpr int N_PHASES = 1 + NSTEP * NLAYER;
__global__ void __launch_bounds__(512, 2) mega(Args args) {
    extern __shared__ __attribute__((aligned(16))) unsigned char shm[];
    cg::grid_group grid = cg::this_grid();
    LAS unsigned char* lds3 = (LAS unsigned char*)shm;
    float* ldsf = (float*)shm;
    const int ph_lo = args.ph_lo, ph_hi = args.ph_hi;
    volatile LAS unsigned* xst = (volatile LAS unsigned*)(lds3 + 131072);
    if (threadIdx.x == 0) { xst[0] = 0u; xst[1] = 0u; }
    __syncthreads();
    if (ph_hi - ph_lo > 1 && threadIdx.x == 0) (void)xb_add(&((unsigned*)(args.ws + WS_BAR))[XB_XCNT(xb_xcc_id())], 1u);
    for (int ph = ph_lo; ph < ph_hi; ++ph) {
        kargp_t kp = (kargp_t)__builtin_amdgcn_kernarg_segment_ptr();
        asm volatile("" : "+s"(kp));
        KA a; a.p = kp;
        bool need_sync = true;
        if (ph == 0) {
            if (HAS(0)) phase_prep(a, shm);
        } else {
            const int L = (ph - 1) / NSTEP, st = (ph - 1) % NSTEP, kind = L % 3, j = L / 3;
            if ((st == 0 || st == 7) && HAS(1)) {
                pg8::Gemm g; pg8::EpiBf16 E; g.M = MTOK; g.A = (const bf16_t*)(a.ws() + WS_X);
                if (st == 0) { g.N = NH; g.K = (kind == 1) ? 2048 : 1024;
                    g.Bt = (const bf16_t*)(a.ws() + (kind == 0 ? (j == 0 ? WS_W_DN0 : WS_W_DN1) : (kind == 1 ? WS_W_RW : WS_W_ML)));
                    E.O = (bf16_t*)(a.ws() + WS_H); E.ldc = NH; E.act = 0; }
                else { g.N = DM; g.K = DM; g.Bt = (const bf16_t*)(a.ws() + WS_W_GATE + (size_t)L * 2 * MiB);
                    E.O = (bf16_t*)(a.ws() + WS_H + 192 * MiB); E.ldc = DM; E.act = 1; }
                pg8::StaticOrder S; S.init(g.M, g.N, (int)gridDim.x, lbid());
                pg8::gemm_phase(lds3, g, S, E);
            } else if (st == 6 && HAS(1)) {
                pg8::Gemm g; pg8::EpiBf16 E; g.M = MTOK; g.A = (const bf16_t*)(a.ws() + WS_P); g.N = DM; g.K = DPLE; g.Bt = (const bf16_t*)(a.ws() + WS_W_PROJ + (size_t)L * (MiB / 2));
                E.O = (bf16_t*)(a.ws() + WS_H + 128 * MiB); E.ldc = DM; E.act = 0; need_sync = false;
                pg8::StaticOrder S; S.init(g.M, g.N, (int)gridDim.x, lbid());
                pg8::gemm_phase(lds3, g, S, E);
            } else if (st == 4 && HAS(6)) {
                pg8::Gemm g; pg8::EpiBf16 E; g.M = MTOK; g.N = DM; g.K = DM;
                g.A = (const bf16_t*)(a.ws() + WS_X + (kind == 0 ? 0 : 64 * MiB)); g.Bt = (const bf16_t*)(a.ws() + WS_W_OUT + (size_t)L * 2 * MiB);
                E.O = (bf16_t*)(a.ws() + WS_H); E.ldc = DM; E.act = 0;
                pg8::StaticOrder S; S.init(g.M, g.N, (int)gridDim.x, lbid());
                pg8::gemm_phase(lds3, g, S, E);
            } else if (st == 1) {
                if (kind == 0) { if (HAS(2) && HAS(10)) phase_dn_prep2(a, j, shm); } else need_sync = false;
            } else if (st == 2) {
                if (kind == 0) { if (HAS(2) && HAS(11)) phase_dn_chunk2(a, j, shm); } else if (kind == 1) { if (HAS(3)) phase_rw_scan3(a, shm); } else { if (HAS(4)) phase_ml_chunk(a, shm); }
            } else if (st == 3) {
                if (HAS(5)) { if (kind == 0) phase_dn_post(a, j); else if (kind == 1) phase_rw_post(a); else phase_ml_post(a); }
            } else if (st == 5) {
                if (HAS(7)) phase_ln(a, L);
            } else if (st == 8) {
                if (HAS(9)) phase_combine(a, L);
            }
        }
        if (need_sync && ph + 1 < ph_hi) {
            if (ph == 0) grid.sync();
            else { XcdBarrier xb; xb.bar = (unsigned*)(a.ws() + WS_BAR); xb.x = xb_xcc_id(); xb.st = xst; xcd_barrier(xb); }
        }
    }
}

extern "C" void kernel_launch(void* const* d_in, const int* in_sizes, int n_in, void* d_out, int out_size, void* d_ws, size_t ws_size, hipStream_t stream) {
    static int grid = 0;
    if (grid == 0) {
        if (n_in != 31 || out_size != MTOK * DM || ws_size < WS_END) { fprintf(stderr, "kernel_launch: unexpected shapes (n_in %d out %d ws %zu need %zu)\n", n_in, out_size, ws_size, (size_t)WS_END); grid = -1; return; }
        int dev = 0, cus = 0, per_cu = 0;
        (void)hipGetDevice(&dev); (void)hipDeviceGetAttribute(&cus, hipDeviceAttributeMultiprocessorCount, dev);
        if (hipFuncSetAttribute((const void*)mega, hipFuncAttributeMaxDynamicSharedMemorySize, LDS_BYTES) != hipSuccess) { fprintf(stderr, "kernel_launch: hipFuncSetAttribute failed\n"); grid = -1; return; }
        if (hipOccupancyMaxActiveBlocksPerMultiprocessor(&per_cu, (const void*)mega, NTHR, LDS_BYTES) != hipSuccess || per_cu < 1) { fprintf(stderr, "kernel_launch: occupancy query says %d blocks/CU\n", per_cu); per_cu = 1; }
        (void)hipGetLastError();
        grid = cus;
        if (grid <= 0) grid = 256;
    }
    if (grid < 0) return;
    (void)hipMemsetAsync((char*)d_ws + WS_BAR, 0, XCD_BAR_WORDS * sizeof(unsigned), stream);
    Args a{};
    for (int i = 0; i < 31; ++i) a.in[i] = (const float*)d_in[i];
    a.out = (float*)d_out; a.ws = (unsigned char*)d_ws;
#if MULTI_LAUNCH
    for (int ph = 0; ph < N_PHASES; ++ph) { a.ph_lo = ph; a.ph_hi = ph + 1; hipLaunchKernelGGL(mega, dim3(grid), dim3(NTHR), LDS_BYTES, stream, a); }
#else
    a.ph_lo = 0; a.ph_hi = N_PHASES;
    void* kargs[] = {&a};
    hipError_t e = hipLaunchCooperativeKernel((const void*)mega, dim3(grid), dim3(NTHR), kargs, LDS_BYTES, stream);
    if (e != hipSuccess) fprintf(stderr, "cooperative launch failed: %s (grid %d)\n", hipGetErrorString(e), grid);
#endif
}
```

```cpp
#include <hip/hip_runtime.h>
#include <hip/hip_cooperative_groups.h>
#include <cstdio>
#include <cstddef>
namespace cg = cooperative_groups;

#ifndef PHMASK
#define PHMASK 0xFFFF
#endif
#ifndef SOLVE_N
#define SOLVE_N 64
#endif
#define HAS(b) ((PHMASK >> (b)) & 1)
#ifndef MULTI_LAUNCH
#define MULTI_LAUNCH 0
#endif

#define LAS __attribute__((address_space(3)))
typedef unsigned short bf16_t;
typedef short bf16x8 __attribute__((ext_vector_type(8)));
typedef float f32x4 __attribute__((ext_vector_type(4)));
typedef unsigned u32x4 __attribute__((ext_vector_type(4)));
typedef unsigned u32x2 __attribute__((ext_vector_type(2)));

constexpr int MTOK = 32768, DM = 1024, SEQ = 4096, NB = 8, NLAYER = 4, DPLE = 256;
constexpr int NH = 4352;
constexpr float ALPHA = 1.681792830507429f;
constexpr int NTHR = 512;
constexpr int LDS_BYTES = 131072 + 16;

constexpr size_t MiB = 1048576;
constexpr size_t WS_X = 0;
constexpr size_t WS_H = 128 * MiB;
constexpr size_t WS_W = 400 * MiB;
constexpr size_t W_IN_BYTES = (size_t)NH * 1024 * 2;
constexpr size_t WS_W_DN0 = WS_W;
constexpr size_t WS_W_DN1 = WS_W_DN0 + W_IN_BYTES;
constexpr size_t WS_W_RW = WS_W_DN1 + W_IN_BYTES;
constexpr size_t WS_W_ML = WS_W_RW + 2 * W_IN_BYTES;
constexpr size_t WS_W_OUT = WS_W_ML + W_IN_BYTES;
constexpr size_t WS_W_GATE = WS_W_OUT + 4 * 2 * MiB;
constexpr size_t WS_W_PROJ = WS_W_GATE + 4 * 2 * MiB;
constexpr size_t WS_P = WS_W_PROJ + 2 * MiB;
constexpr size_t WS_BONUS = WS_P + 16 * MiB;
constexpr size_t WS_BAR = WS_BONUS + 2 * MiB;
constexpr size_t WS_END = WS_BAR + 65536;

struct Args { const float* in[31]; float* out; unsigned char* ws; int ph_lo, ph_hi; };
#define AS4 __attribute__((address_space(4)))
typedef const AS4 unsigned char* kargp_t;
struct KA { kargp_t p;
    __device__ __forceinline__ const float* in(int i) const { return *(const float* const AS4*)(p + 8 * i); }
    __device__ __forceinline__ float* out() const { return *(float* const AS4*)(p + 248); }
    __device__ __forceinline__ unsigned char* ws() const { return *(unsigned char* const AS4*)(p + 256); }
};
static_assert(offsetof(Args, out) == 248 && offsetof(Args, ws) == 256, "kernarg layout");

__device__ __forceinline__ int ltid() { int t = (int)threadIdx.x; asm volatile("" : "+v"(t)); return t; }
__device__ __forceinline__ int lbid() { int t = (int)blockIdx.x; asm volatile("" : "+s"(t)); return t; }
__device__ __forceinline__ float bf2f(bf16_t b) { return __uint_as_float(((unsigned)b) << 16); }
__device__ __forceinline__ float bflo(unsigned u) { return __uint_as_float(u << 16); }
__device__ __forceinline__ float bfhi(unsigned u) { return __uint_as_float(u & 0xffff0000u); }
typedef float f32x2_ __attribute__((ext_vector_type(2)));
typedef __bf16 bf16x2_ __attribute__((ext_vector_type(2)));
__device__ __forceinline__ unsigned pk_bf16(float lo, float hi) { const f32x2_ v = {lo, hi}; return __builtin_bit_cast(unsigned, __builtin_convertvector(v, bf16x2_)); }
__device__ __forceinline__ float sigmoidf_(float x) { return __builtin_amdgcn_rcpf(1.0f + __expf(-x)); }
__device__ __forceinline__ float siluf_(float x) { return x * __builtin_amdgcn_rcpf(1.0f + __expf(-x)); }
__device__ __forceinline__ float softplusf_(float x) { return x > 20.f ? x : log1pf(__expf(x)); }
template <int CTRL> __device__ __forceinline__ float dppf(float x) { return __builtin_bit_cast(float, __builtin_amdgcn_mov_dpp(__builtin_bit_cast(int, x), CTRL, 0xf, 0xf, true)); }
__device__ __forceinline__ float row16_sum(float v) { v += dppf<0xB1>(v); v += dppf<0x4E>(v); v += dppf<0x124>(v); v += dppf<0x128>(v); return v; }
__device__ __forceinline__ float row8_sum(float v) { v += dppf<0xB1>(v); v += dppf<0x4E>(v); v += dppf<0x141>(v); return v; }
__device__ __forceinline__ float quad_sum(float v) { v += dppf<0xB1>(v); v += dppf<0x4E>(v); return v; }
__device__ __forceinline__ float wave_sum(float v) { v = row16_sum(v); v += __shfl_xor(v, 16, 64); v += __shfl_xor(v, 32, 64); return v; }
template <class T> __device__ __forceinline__ T ntl(const T* p) { return __builtin_nontemporal_load(p); }
template <class T> __device__ __forceinline__ void nts(T* p, T v) { __builtin_nontemporal_store(v, p); }
template <int CTRL, int RM> __device__ __forceinline__ float dpp_old(float oldv, float x) { return __builtin_bit_cast(float, __builtin_amdgcn_update_dpp(__builtin_bit_cast(int, oldv), __builtin_bit_cast(int, x), CTRL, RM, 0xf, false)); }
__device__ __forceinline__ float wave_scan_add(float v) {
    v += dpp_old<0x111, 0xf>(0.f, v); v += dpp_old<0x112, 0xf>(0.f, v); v += dpp_old<0x114, 0xf>(0.f, v); v += dpp_old<0x118, 0xf>(0.f, v);
    v += dpp_old<0x142, 0xa>(0.f, v); v += dpp_old<0x143, 0xc>(0.f, v); return v; }
__device__ __forceinline__ float wave_scan_max(float v) {
    const float ninf = -__builtin_inff();
    v = fmaxf(v, dpp_old<0x111, 0xf>(ninf, v)); v = fmaxf(v, dpp_old<0x112, 0xf>(ninf, v)); v = fmaxf(v, dpp_old<0x114, 0xf>(ninf, v)); v = fmaxf(v, dpp_old<0x118, 0xf>(ninf, v));
    v = fmaxf(v, dpp_old<0x142, 0xa>(ninf, v)); v = fmaxf(v, dpp_old<0x143, 0xc>(ninf, v)); return v; }
__device__ __forceinline__ void unpack8(const u32x4 r, float (&f)[8]) {
    f[0] = bflo(r.x); f[1] = bfhi(r.x); f[2] = bflo(r.y); f[3] = bfhi(r.y); f[4] = bflo(r.z); f[5] = bfhi(r.z); f[6] = bflo(r.w); f[7] = bfhi(r.w);
}

__device__ __forceinline__ bf16x8 ldfrag(const bf16_t* base, int ld, int r0, int k0, int lane) { return *(const bf16x8*)(base + (r0 + (lane & 15)) * ld + k0 + (lane >> 4) * 8); }
#define MFMA16(a, b, c) __builtin_amdgcn_mfma_f32_16x16x32_bf16(a, b, c, 0, 0, 0)
__device__ __forceinline__ bf16_t f2bf1(float x) { return (bf16_t)(pk_bf16(x, x) & 0xffffu); }

namespace pg8 {
constexpr int BM = 256, BK = 64, HALF = 128, HTB = HALF * BK * 2, STAGE_BYTES = 8 * HTB, NXCD = 8, WGM = 8;
__host__ __device__ __forceinline__ int lds_byte(int r, int c) { const int st = (r >> 4) * 2 + (c >> 5), rr = r & 15, cc = c & 31, ob = rr * 64 + cc * 2; return st * 1024 + (ob ^ (((ob >> 9) & 1) << 5)); }
__host__ __device__ __forceinline__ void stage_rc(int b, int& R, int& C) { const int st = b / 1024, sb = b % 1024, swz = sb ^ (((sb >> 9) & 1) << 5); R = (st >> 1) * 16 + swz / 64; C = (st & 1) * 32 + (swz % 64) / 2; }
__host__ __device__ __forceinline__ int perm32(int rho) { const int n = rho >> 4, i = rho & 15; return 8 * (i >> 2) + 4 * n + (i & 3); }
struct Unit { int pm, pn; };
struct Gemm { const bf16_t* A; const bf16_t* Bt; int M, N, K; };
struct StaticOrder {
    int nM, nN, nwg, G, c;
    __device__ void init(int M, int N, int G_, int c_) { nM = M / BM; nN = N / BM; nwg = nM * nN; G = G_; c = c_; }
    __device__ bool next(int i, Unit& u) const {
        const long L = (long)i * G + c; if (L >= nwg) return false;
        int wgid = (int)L; { const int q = nwg / NXCD, r = nwg % NXCD, xcd = wgid % NXCD, off = wgid / NXCD; wgid = (xcd < r ? xcd * (q + 1) : r * (q + 1) + (xcd - r) * q) + off; }
        const int nig = WGM * nN, gid = wgid / nig, fm = gid * WGM, gsz = (nM - fm) < WGM ? (nM - fm) : WGM;
        u.pm = fm + ((wgid % nig) % gsz); u.pn = (wgid % nig) / gsz; return true;
    }
};
struct EpiBf16 {
    static constexpr bool PERM = true;
    bf16_t* O; int ldc; int act;
    __device__ __forceinline__ void operator()(const f32x4 (&acc)[2][2][4][2], const Unit& u, int wr, int wc, int fr, int fq) const {
        const int row0 = u.pm * BM + wr * 64 + fr; const int col0 = u.pn * BM + wc * 32 + 8 * fq;
#pragma unroll
        for (int ai = 0; ai < 2; ++ai)
#pragma unroll
            for (int m = 0; m < 4; ++m) { bf16_t* rowp = O + (size_t)(row0 + ai * HALF + m * 16) * ldc + col0;
#pragma unroll
                for (int bj = 0; bj < 2; ++bj) { f32x4 v0 = acc[ai][bj][m][0], v1 = acc[ai][bj][m][1];
                    if (act) {
#pragma unroll
                        for (int j = 0; j < 4; ++j) { v0[j] = sigmoidf_(v0[j]); v1[j] = sigmoidf_(v1[j]); } }
                    u32x4 w; w.x = pk_bf16(v0[0], v0[1]); w.y = pk_bf16(v0[2], v0[3]); w.z = pk_bf16(v1[0], v1[1]); w.w = pk_bf16(v1[2], v1[3]);
                    *(u32x4*)(rowp + bj * HALF) = w; } }
    }
};
struct EpiF32 {
    static constexpr bool PERM = false;
    float* C; int ldc; const float* R; float rscale;
    __device__ __forceinline__ void operator()(const f32x4 (&acc)[2][2][4][2], const Unit& u, int wr, int wc, int fr, int fq) const {
        const int row0 = u.pm * BM + wr * 64 + fr, col0 = u.pn * BM + wc * 32 + 4 * fq;
#pragma unroll
        for (int ai = 0; ai < 2; ++ai)
#pragma unroll
            for (int m = 0; m < 4; ++m) { const size_t ro = (size_t)(row0 + ai * HALF + m * 16) * ldc + col0;
#pragma unroll
                for (int bj = 0; bj < 2; ++bj)
#pragma unroll
                    for (int n = 0; n < 2; ++n) { f32x4 v = acc[ai][bj][m][n];
                        if (R) { const f32x4 r = *(const f32x4*)(R + ro + bj * HALF + n * 16); v = v + r * rscale; }
                        *(f32x4*)(C + ro + bj * HALF + n * 16) = v; } }
    }
};

template <class Epi>
__device__ __forceinline__ void gemm_phase(LAS unsigned char* lds, const Gemm g, const StaticOrder& S, const Epi& E) {
    const int tid = ltid(), wid = __builtin_amdgcn_readfirstlane(tid >> 6), lane = tid & 63, wr = wid >> 2, wc = wid & 3, fr = lane & 15, fq = lane >> 4;
    const int K = g.K, nt = K / BK;
    unsigned voffA[2], voffB[2];
#pragma unroll
    for (int i = 0; i < 2; ++i) { int R, C; stage_rc(tid * 16 + i * 8192, R, C); const int Rb = Epi::PERM ? ((R & ~31) + perm32(R & 31)) : R;
        voffA[i] = (unsigned)(R * K + C) * 2u; voffB[i] = (unsigned)(Rb * K + C) * 2u; }
    const size_t kstep = (size_t)(BK * 2);
    const size_t hstep = (size_t)HALF * K * 2;
    const size_t tstep = 2 * hstep;
    const unsigned ldsw = (unsigned)wid * 1024u;
    const int aoff = lds_byte(wr * 64 + fr, fq * 8), boff = lds_byte(wc * 32 + fr, fq * 8);
#define PG8_SA(b, h) (((b) * 2 + (h)) * HTB)
#define PG8_SB(b, h) ((4 + (b) * 2 + (h)) * HTB)
#define PG8_STAGE(bufoff, gbase, voff) do { _Pragma("unroll") for (int _i = 0; _i < 2; ++_i) \
        __builtin_amdgcn_global_load_lds((const unsigned*)((const char*)(gbase) + (voff)[_i]), (LAS unsigned*)(lds + (bufoff) + ldsw + _i * 8192), 16, 0, 0); } while (0)
#define PG8_LDA(dst, b, h) do { _Pragma("unroll") for (int m = 0; m < 4; ++m) _Pragma("unroll") for (int k = 0; k < 2; ++k) dst[m][k] = *(const LAS bf16x8*)(lds + PG8_SA(b, h) + aoff + m * 2048 + k * 1024); } while (0)
#define PG8_LDB(dst, b, h) do { _Pragma("unroll") for (int n = 0; n < 2; ++n) _Pragma("unroll") for (int k = 0; k < 2; ++k) dst[n][k] = *(const LAS bf16x8*)(lds + PG8_SB(b, h) + boff + n * 2048 + k * 1024); } while (0)
#define PG8_MMA(ai, bj, At, Bt) do { __builtin_amdgcn_s_setprio(1); _Pragma("unroll") for (int m = 0; m < 4; ++m) _Pragma("unroll") for (int n = 0; n < 2; ++n) _Pragma("unroll") for (int k = 0; k < 2; ++k) \
        acc[ai][bj][m][n] = __builtin_amdgcn_mfma_f32_16x16x32_bf16(Bt[n][k], At[m][k], acc[ai][bj][m][n], 0, 0, 0); __builtin_amdgcn_s_setprio(0); } while (0)
#define PG8_WAIT_V(n) asm volatile("s_waitcnt vmcnt(" #n ")" ::: "memory")
#define PG8_WAIT_L(n) asm volatile("s_waitcnt lgkmcnt(" #n ")" ::: "memory")
#define PG8_BAR __builtin_amdgcn_s_barrier()
#define PG8_SCHED __builtin_amdgcn_sched_barrier(0)
    Unit cur, nxt; int ui = 0;
    if (!S.next(0, cur)) return;
    f32x4 acc[2][2][4][2];
#pragma unroll
    for (int a = 0; a < 2; ++a)
#pragma unroll
        for (int b = 0; b < 2; ++b)
#pragma unroll
            for (int m = 0; m < 4; ++m)
#pragma unroll
                for (int n = 0; n < 2; ++n) acc[a][b][m][n] = (f32x4){0.f, 0.f, 0.f, 0.f};
    bf16x8 At[4][2], B0[2][2], B1[2][2];
    const char* cA = (const char*)g.A + (size_t)cur.pm * tstep; const char* cB = (const char*)g.Bt + (size_t)cur.pn * tstep;
    PG8_STAGE(PG8_SB(0, 0), cB, voffB); PG8_STAGE(PG8_SA(0, 0), cA, voffA); PG8_STAGE(PG8_SB(0, 1), cB + hstep, voffB); PG8_STAGE(PG8_SA(0, 1), cA + hstep, voffA);
    if (wr == 1) PG8_BAR;
    PG8_WAIT_V(4); PG8_BAR;
    PG8_STAGE(PG8_SB(1, 0), cB + kstep, voffB); PG8_STAGE(PG8_SA(1, 0), cA + kstep, voffA); PG8_STAGE(PG8_SB(1, 1), cB + hstep + kstep, voffB);
    PG8_WAIT_V(6); PG8_BAR;
    for (;;) {
        const bool has_next = S.next(ui + 1, nxt);
        const char* nA = has_next ? (const char*)g.A + (size_t)nxt.pm * tstep : cA; const char* nB = has_next ? (const char*)g.Bt + (size_t)nxt.pn * tstep : cB;
        for (int t = 0; t < nt; t += 2) {
            const bool last = (t == nt - 2);
            const char* a1 = cA + (size_t)(t + 1) * kstep;
            const char* a2 = last ? nA : cA + (size_t)(t + 2) * kstep; const char* b2 = last ? nB : cB + (size_t)(t + 2) * kstep;
            const char* a3 = a2 + kstep; const char* b3 = b2 + kstep;
            PG8_LDB(B0, 0, 0); PG8_SCHED; PG8_LDA(At, 0, 0); PG8_STAGE(PG8_SA(1, 1), a1 + hstep, voffA);
            PG8_WAIT_L(8); PG8_BAR; PG8_WAIT_L(0); PG8_MMA(0, 0, At, B0); PG8_BAR; PG8_SCHED;
            PG8_LDB(B1, 0, 1); PG8_STAGE(PG8_SB(0, 0), b2, voffB);
            PG8_BAR; PG8_WAIT_L(0); PG8_MMA(0, 1, At, B1); PG8_BAR;
            PG8_LDA(At, 0, 1); PG8_STAGE(PG8_SA(0, 0), a2, voffA);
            PG8_BAR; PG8_WAIT_L(0); PG8_MMA(1, 0, At, B0); PG8_BAR; PG8_SCHED;
            PG8_STAGE(PG8_SB(0, 1), b2 + hstep, voffB);
            PG8_WAIT_V(6); PG8_BAR; PG8_MMA(1, 1, At, B1); PG8_BAR;
            PG8_LDB(B0, 1, 0); PG8_SCHED; PG8_LDA(At, 1, 0); PG8_STAGE(PG8_SA(0, 1), a2 + hstep, voffA);
            PG8_WAIT_L(8); PG8_BAR; PG8_WAIT_L(0); PG8_MMA(0, 0, At, B0); PG8_BAR; PG8_SCHED;
            PG8_LDB(B1, 1, 1); PG8_STAGE(PG8_SB(1, 0), b3, voffB);
            PG8_BAR; PG8_WAIT_L(0); PG8_MMA(0, 1, At, B1); PG8_BAR;
            PG8_LDA(At, 1, 1); PG8_STAGE(PG8_SA(1, 0), a3, voffA);
            PG8_BAR; PG8_WAIT_L(0); PG8_MMA(1, 0, At, B0); PG8_BAR; PG8_SCHED;
            PG8_STAGE(PG8_SB(1, 1), b3 + hstep, voffB);
            PG8_WAIT_V(6); PG8_BAR; PG8_MMA(1, 1, At, B1); PG8_BAR;
        }
        E(acc, cur, wr, wc, fr, fq);
        if (!has_next) break;
#pragma unroll
        for (int a = 0; a < 2; ++a)
#pragma unroll
            for (int b = 0; b < 2; ++b)
#pragma unroll
                for (int m = 0; m < 4; ++m)
#pragma unroll
                    for (int n = 0; n < 2; ++n) acc[a][b][m][n] = (f32x4){0.f, 0.f, 0.f, 0.f};
        cur = nxt; cA = nA; cB = nB; ++ui;
    }
    PG8_WAIT_V(0);
    if (wr == 0) PG8_BAR;
    PG8_BAR;
#undef PG8_SA
#undef PG8_SB
#undef PG8_STAGE
#undef PG8_LDA
#undef PG8_LDB
#undef PG8_MMA
#undef PG8_WAIT_V
#undef PG8_WAIT_L
#undef PG8_BAR
#undef PG8_SCHED
}
}

struct Seg { int in_idx, src_off, ldsrc, scol0, len, K, dst_off, ldk, koff, n0, mumode, mu_off; };
#define OFFW(x) ((int)((x) - WS_W))
__constant__ Seg g_segs[] = {
    {7, 0, 4112, 0, 4112, 1024, OFFW(WS_W_DN0), 1024, 0, 0, 0, 0}, {7, 0, 0, 0, 240, 1024, OFFW(WS_W_DN0), 1024, 0, 4112, 3, 0},
    {7, 1024 * 4112, 4112, 0, 4112, 1024, OFFW(WS_W_DN1), 1024, 0, 0, 0, 0}, {7, 0, 0, 0, 240, 1024, OFFW(WS_W_DN1), 1024, 0, 4112, 3, 0},
    {25, 0, 4112, 0, 4112, 1024, OFFW(WS_W_ML), 1024, 0, 0, 0, 0}, {25, 0, 0, 0, 240, 1024, OFFW(WS_W_ML), 1024, 0, 4112, 3, 0},
    {13, 0, 4224, 0, 1024, 1024, OFFW(WS_W_RW), 2048, 0, 0, 1, 0 * 1024}, {13, 0, 4224, 0, 1024, 1024, OFFW(WS_W_RW), 2048, 1024, 0, 2, 0 * 1024},
    {13, 0, 4224, 1088, 1024, 1024, OFFW(WS_W_RW), 2048, 0, 1024, 1, 2 * 1024}, {13, 0, 4224, 1088, 1024, 1024, OFFW(WS_W_RW), 2048, 1024, 1024, 2, 2 * 1024},
    {13, 0, 4224, 2112, 1024, 1024, OFFW(WS_W_RW), 2048, 0, 2048, 1, 3 * 1024}, {13, 0, 4224, 2112, 1024, 1024, OFFW(WS_W_RW), 2048, 1024, 2048, 2, 3 * 1024},
    {13, 0, 4224, 3200, 1024, 1024, OFFW(WS_W_RW), 2048, 0, 3072, 1, 5 * 1024}, {13, 0, 4224, 3200, 1024, 1024, OFFW(WS_W_RW), 2048, 1024, 3072, 2, 5 * 1024},
    {13, 0, 4224, 1024, 64, 1024, OFFW(WS_W_RW), 2048, 0, 4096, 1, 1 * 1024}, {13, 0, 4224, 1024, 64, 1024, OFFW(WS_W_RW), 2048, 1024, 4096, 2, 1 * 1024},
    {13, 0, 4224, 3136, 64, 1024, OFFW(WS_W_RW), 2048, 0, 4160, 1, 4 * 1024}, {13, 0, 4224, 3136, 64, 1024, OFFW(WS_W_RW), 2048, 1024, 4160, 2, 4 * 1024},
    {13, 0, 0, 0, 128, 2048, OFFW(WS_W_RW), 2048, 0, 4224, 3, 0},
    {12, 0, 1024, 0, 1024, 1024, OFFW(WS_W_OUT + 0 * 2 * MiB), 1024, 0, 0, 0, 0}, {24, 0, 1024, 0, 1024, 1024, OFFW(WS_W_OUT + 1 * 2 * MiB), 1024, 0, 0, 0, 0},
    {30, 0, 1024, 0, 1024, 1024, OFFW(WS_W_OUT + 2 * 2 * MiB), 1024, 0, 0, 0, 0}, {12, 1024 * 1024, 1024, 0, 1024, 1024, OFFW(WS_W_OUT + 3 * 2 * MiB), 1024, 0, 0, 0, 0},
    {6, 0 * 1024 * 1024, 1024, 0, 1024, 1024, OFFW(WS_W_GATE + 0 * 2 * MiB), 1024, 0, 0, 0, 0}, {6, 1 * 1024 * 1024, 1024, 0, 1024, 1024, OFFW(WS_W_GATE + 1 * 2 * MiB), 1024, 0, 0, 0, 0},
    {6, 2 * 1024 * 1024, 1024, 0, 1024, 1024, OFFW(WS_W_GATE + 2 * 2 * MiB), 1024, 0, 0, 0, 0}, {6, 3 * 1024 * 1024, 1024, 0, 1024, 1024, OFFW(WS_W_GATE + 3 * 2 * MiB), 1024, 0, 0, 0, 0},
    {4, 0 * 256 * 1024, 1024, 0, 1024, 256, OFFW(WS_W_PROJ + 0 * (MiB / 2)), 256, 0, 0, 0, 0}, {4, 1 * 256 * 1024, 1024, 0, 1024, 256, OFFW(WS_W_PROJ + 1 * (MiB / 2)), 256, 0, 0, 0, 0},
    {4, 2 * 256 * 1024, 1024, 0, 1024, 256, OFFW(WS_W_PROJ + 2 * (MiB / 2)), 256, 0, 0, 0, 0}, {4, 3 * 256 * 1024, 1024, 0, 1024, 256, OFFW(WS_W_PROJ + 3 * (MiB / 2)), 256, 0, 0, 0, 0},
};
constexpr int N_SEGS = 6 + 13 + 4 + 4 + 4;

__device__ __forceinline__ void phase_prep(const KA a, unsigned char* lds_) {
    const size_t gtid = (size_t)lbid() * NTHR + ltid(), gsz = (size_t)gridDim.x * NTHR;
    { const float* x = a.in(0); bf16_t* xb = (bf16_t*)(a.ws() + WS_X);
      const size_t n8 = (size_t)MTOK * DM / 8;
      for (size_t i = gtid; i < n8; i += 4 * gsz) {
          f32x4 v0[4], v1[4];
#pragma unroll
          for (int q = 0; q < 4; ++q) { const size_t ii = i + q * gsz; if (ii < n8) { v0[q] = *(const f32x4*)(x + ii * 8); v1[q] = *(const f32x4*)(x + ii * 8 + 4); } }
#pragma unroll
          for (int q = 0; q < 4; ++q) { const size_t ii = i + q * gsz; if (ii < n8) {
              u32x4 w; w.x = pk_bf16(v0[q][0], v0[q][1]); w.y = pk_bf16(v0[q][2], v0[q][3]); w.z = pk_bf16(v1[q][0], v1[q][1]); w.w = pk_bf16(v1[q][2], v1[q][3]); *(u32x4*)(xb + ii * 8) = w; } } } }
    bf16_t* tl = (bf16_t*)lds_;
    const int tid = ltid(), G = (int)gridDim.x;
    const int lk = tid >> 3, ln8 = (tid & 7) * 8;
#define PREP_NT(SG) ((((SG).len + 63) >> 6) * ((SG).K >> 6))
    int cs = 0, ct = lbid(), cnt = PREP_NT(g_segs[0]);
    while (cs < N_SEGS && ct >= cnt) { ct -= cnt; ++cs; if (cs < N_SEGS) cnt = PREP_NT(g_segs[cs]); }
    f32x4 r0 = {0.f, 0.f, 0.f, 0.f}, r1 = r0; float rsc = 1.f;
#define PREP_LOAD(S_, T_) do { const Seg q = g_segs[S_]; const int ntn = (q.len + 63) >> 6, tn = (T_) % ntn, tk = (T_) / ntn; const int k = tk * 64 + lk, n = tn * 64 + ln8; \
        r0 = (f32x4){0.f, 0.f, 0.f, 0.f}; r1 = r0; rsc = 1.f; \
        if (q.mumode != 3 && n < q.len) { const float* sp = a.in(q.in_idx) + q.src_off + (size_t)k * q.ldsrc + q.scol0 + n; r0 = *(const f32x4*)sp; r1 = *(const f32x4*)(sp + 4); \
            if (q.mumode == 1) rsc = 1.0f - a.in(14)[q.mu_off + k]; else if (q.mumode == 2) rsc = a.in(14)[q.mu_off + k]; } } while (0)
    if (cs < N_SEGS) PREP_LOAD(cs, ct);
    int buf = 0;
    while (cs < N_SEGS) {
        int ns = cs, nt = ct + G, nnt = cnt;
        while (ns < N_SEGS && nt >= nnt) { nt -= nnt; ++ns; if (ns < N_SEGS) nnt = PREP_NT(g_segs[ns]); }
        bf16_t* tb = tl + buf * (64 * 72);
        { const f32x4 v0 = r0 * rsc, v1 = r1 * rsc;
          tb[(ln8 + 0) * 72 + lk] = f2bf1(v0[0]); tb[(ln8 + 1) * 72 + lk] = f2bf1(v0[1]); tb[(ln8 + 2) * 72 + lk] = f2bf1(v0[2]); tb[(ln8 + 3) * 72 + lk] = f2bf1(v0[3]);
          tb[(ln8 + 4) * 72 + lk] = f2bf1(v1[0]); tb[(ln8 + 5) * 72 + lk] = f2bf1(v1[1]); tb[(ln8 + 6) * 72 + lk] = f2bf1(v1[2]); tb[(ln8 + 7) * 72 + lk] = f2bf1(v1[3]); }
        const Seg cq = g_segs[cs]; const int cntn = (cq.len + 63) >> 6, ctn = ct % cntn, ctk = ct / cntn;
        if (ns < N_SEGS) PREP_LOAD(ns, nt);
        __syncthreads();
        { const int n = ctn * 64 + (tid >> 3), kp = (tid & 7) * 8;
          if (n < cq.len) *(u32x4*)((bf16_t*)(a.ws() + WS_W + (size_t)cq.dst_off) + (size_t)(cq.n0 + n) * cq.ldk + cq.koff + ctk * 64 + kp) = *(const u32x4*)(tb + (tid >> 3) * 72 + kp); }
        buf ^= 1; cs = ns; ct = nt; cnt = nnt;
    }
#undef PREP_LOAD
#undef PREP_NT
}

template <int NC, int TC, int FN  >
__device__ __forceinline__ void cols_load(const bf16_t* __restrict__ h, size_t row0, int col0, float* dst, int dstride, int vt) {
    constexpr int NV = NC / 8, NITEM = NV * TC;
    for (int it = vt; it < NITEM; it += NTHR) {
        const int vc = it % NV, t = it / NV, c = vc * 8;
        const u32x4 r = *(const u32x4*)(h + (row0 + t) * NH + col0 + c);
        float f[8]; unpack8(r, f);
        float* d = dst + (size_t)t * dstride + c;
#pragma unroll
        for (int e = 0; e < 8; ++e) d[e] = FN == 1 ? tanhf(f[e]) : f[e];
    }
}
__device__ __forceinline__ int vtid(int shift) { return (int)((ltid() + NTHR - shift) & (NTHR - 1)); }

__device__ __forceinline__ void phase_dn_post(const KA a, int j) {
    const bf16_t* h = (const bf16_t*)(a.ws() + WS_H);
    const bf16_t* O = (const bf16_t*)(a.ws() + WS_X + 64 * MiB);
    bf16_t* Y = (bf16_t*)(a.ws() + WS_X);
#define DNO(R) (O + ((size_t)((((R) >> 12) * 8 + (lane >> 3)) * 64 + (((R) & 4095) >> 6)) * 8192 + ((R) & 63) * 128 + (lane & 7) * 16))
    const int lane = ltid() & 63, wid = ltid() >> 6;
    const float* nw = a.in(11) + j * 128 + (lane & 7) * 16;
    float w[16];
#pragma unroll
    for (int e = 0; e < 16; ++e) w[e] = nw[e];
    const int stride = (int)gridDim.x * 8;
    int row = lbid() * 8 + wid;
    u32x4 no0, no1, nz0, nz1;
    if (row < MTOK) { no0 = ntl((const u32x4*)DNO(row)); no1 = ntl((const u32x4*)(DNO(row) + 8));
        nz0 = ntl((const u32x4*)(h + (size_t)row * NH + 3072 + lane * 16)); nz1 = ntl((const u32x4*)(h + (size_t)row * NH + 3072 + lane * 16 + 8)); }
    for (; row < MTOK; row += stride) {
        float o[16], z[16];
        unpack8(no0, *(float(*)[8])&o[0]); unpack8(no1, *(float(*)[8])&o[8]); unpack8(nz0, *(float(*)[8])&z[0]); unpack8(nz1, *(float(*)[8])&z[8]);
        const int nr = row + stride;
        if (nr < MTOK) { no0 = ntl((const u32x4*)DNO(nr)); no1 = ntl((const u32x4*)(DNO(nr) + 8));
            nz0 = ntl((const u32x4*)(h + (size_t)nr * NH + 3072 + lane * 16)); nz1 = ntl((const u32x4*)(h + (size_t)nr * NH + 3072 + lane * 16 + 8)); }
        float ss = 0.f;
#pragma unroll
        for (int e = 0; e < 16; ++e) ss += o[e] * o[e];
        ss = row8_sum(ss);
        const float sc = rsqrtf(ss * (1.0f / 128.0f) + 1e-6f);
        float y[16];
#pragma unroll
        for (int e = 0; e < 16; ++e) y[e] = o[e] * sc * w[e] * siluf_(z[e]);
        u32x4 w0, w1; w0.x = pk_bf16(y[0], y[1]); w0.y = pk_bf16(y[2], y[3]); w0.z = pk_bf16(y[4], y[5]); w0.w = pk_bf16(y[6], y[7]);
        w1.x = pk_bf16(y[8], y[9]); w1.y = pk_bf16(y[10], y[11]); w1.z = pk_bf16(y[12], y[13]); w1.w = pk_bf16(y[14], y[15]);
        *(u32x4*)(Y + (size_t)row * DM + lane * 16) = w0; *(u32x4*)(Y + (size_t)row * DM + lane * 16 + 8) = w1;
    }
#undef DNO
}

__device__ __forceinline__ float tanh_fast(float x) { const float e = __expf(2.0f * x); return 1.0f - 2.0f * __builtin_amdgcn_rcpf(e + 1.0f); }
__device__ __forceinline__ int xcd_unit(int u) { return ((u & 7) << 5) | ((u >> 3) & 31); }
__device__ __forceinline__ void phase_rw_scan3(const KA a, unsigned char* shm_) {
    const bf16_t* h = (const bf16_t*)(a.ws() + WS_H);
    bf16_t* O = (bf16_t*)(a.ws() + WS_X);
    float* bonus = (float*)(a.ws() + WS_BONUS);
    float* osb = (float*)(shm_ + 90112);
    bf16_t* WL = (bf16_t*)(shm_ + 98304); bf16_t* AL = (bf16_t*)(shm_ + 102912); bf16_t* WUPT = (bf16_t*)(shm_ + 107520); bf16_t* AUPT = (bf16_t*)(shm_ + 116736);
    const int tid0 = ltid();
    for (int unit = lbid(); unit < NB * 16 * 2; unit += gridDim.x) {
        const int un_ = (gridDim.x == 256) ? xcd_unit(unit) : unit; const int b = un_ >> 5, hd = (un_ >> 1) & 15, half = un_ & 1;
        const int tid = tid0, wid = tid >> 6, lane = tid & 63, quad = lane >> 4, l15 = lane & 15;
        const bool producer = wid >= 4;
        const int ptid = tid & 255, pw = ptid >> 6;
        __syncthreads();
        for (int i = tid; i < 4096; i += NTHR) { const int jj = i >> 6, c = i & 63;
            WUPT[c * 72 + jj] = f2bf1(a.in(16)[jj * 1024 + hd * 64 + c]); AUPT[c * 72 + jj] = f2bf1(a.in(18)[jj * 1024 + hd * 64 + c]); }
        const int cm = pw * 16 + l15;
        const float w0c = a.in(15)[hd * 64 + cm], a0c = a.in(17)[hd * 64 + cm], kkc = a.in(19)[hd * 64 + cm], kac = a.in(20)[hd * 64 + cm];
        const int rpart = ptid & 7;
        const f32x4 rkA = *(const f32x4*)(a.in(21) + hd * 64 + rpart * 8), rkB = *(const f32x4*)(a.in(21) + hd * 64 + rpart * 8 + 4);
        const int pt = ptid >> 3, pvc = ptid & 7, vt_ = (ptid & 127) >> 2, vvc = ptid & 3;
        const size_t rowb = (size_t)b * SEQ;
        u32x4 p0 = {0u, 0u, 0u, 0u}, p1 = p0, p2 = p0, p3 = p0, p4 = p0;
#define RW3_PREFETCH(CH) do { const size_t rn = rowb + (size_t)(CH) * 32; \
            p0 = *(const u32x4*)(h + (rn + pt) * NH + hd * 64 + pvc * 8); p1 = *(const u32x4*)(h + (rn + pt) * NH + 1024 + hd * 64 + pvc * 8); \
            p2 = *(const u32x4*)(h + (rn + pt) * NH + 4096 + pvc * 8); p3 = *(const u32x4*)(h + (rn + pt) * NH + 4160 + pvc * 8); \
            if (ptid < 128) p4 = *(const u32x4*)(h + (rn + vt_) * NH + 2048 + hd * 64 + half * 32 + vvc * 8); } while (0)
        if (producer) RW3_PREFETCH(0);
        const int crow = (wid & 3) * 8 + (lane >> 3), kq = lane & 7;
        f32x2_ S0 = {0.f, 0.f}, S1 = S0, S2 = S0, S3 = S0;
        for (int c = -1; c < SEQ / 32; ++c) {
            const int cb = c & 1, nb = (c + 1) & 1;
            float* rsC = (float*)(shm_ + cb * 45056); float* dsC = rsC + 2048; float* kpC = rsC + 4096; float* kkC = rsC + 6144; float* kaC = rsC + 8192; float* vsC = rsC + 10240;
            float* rsN = (float*)(shm_ + nb * 45056); float* dsN = rsN + 2048; float* kpN = rsN + 4096; float* kkN = rsN + 6144; float* kaN = rsN + 8192; float* vsN = rsN + 10240;
            float* osC = osb + cb * 1024; float* osP = osb + nb * 1024;
            const bool cact = (c >= 0), pact = (c + 1 < SEQ / 32);
            __syncthreads();
#pragma unroll 1
            for (int seg = 0; seg < 4; ++seg) {
                if (!producer) {
                    if (seg == 0 && c >= 1) {
                        const int t = tid >> 3, c4 = (tid & 7) * 4; const f32x4 v = *(const f32x4*)(osP + t * 32 + c4);
                        u32x2 w; w.x = pk_bf16(v[0], v[1]); w.y = pk_bf16(v[2], v[3]);
                        *(u32x2*)(O + (rowb + (size_t)(c - 1) * 32 + t) * DM + hd * 64 + half * 32 + c4) = w; }
                    if (cact) {
                        float yv[8];
                        f32x4 nkA, nkB, naA, naB, ndA, ndB, npA, npB, nrA, nrB; float nvv;
#define RW3_LD(T) do { const int o_ = (T) * 64 + kq * 8; nkA = *(const f32x4*)(kkC + o_); nkB = *(const f32x4*)(kkC + o_ + 4); naA = *(const f32x4*)(kaC + o_); naB = *(const f32x4*)(kaC + o_ + 4); \
                            ndA = *(const f32x4*)(dsC + o_); ndB = *(const f32x4*)(dsC + o_ + 4); npA = *(const f32x4*)(kpC + o_); npB = *(const f32x4*)(kpC + o_ + 4); \
                            nrA = *(const f32x4*)(rsC + o_); nrB = *(const f32x4*)(rsC + o_ + 4); nvv = vsC[(T) * 32 + crow]; } while (0)
                        RW3_LD(seg * 8);
#pragma unroll
                        for (int tt = 0; tt < 8; ++tt) { const int t = seg * 8 + tt;
                            const f32x4 kkA = nkA, kkB = nkB, kaA = naA, kaB = naB, dA = ndA, dB = ndB, kpA = npA, kpB = npB, rA = nrA, rB = nrB; const float vv = nvv;
                            if (tt < 7) RW3_LD(t + 1);
                            f32x2_ p = S0 * (f32x2_){kkA[0], kkA[1]}; p = S1 * (f32x2_){kkA[2], kkA[3]} + p; p = S2 * (f32x2_){kkB[0], kkB[1]} + p; p = S3 * (f32x2_){kkB[2], kkB[3]} + p;
                            float sa = p[0] + p[1];
                            sa = row8_sum(sa);
                            const f32x2_ sa2 = {sa, sa}, vv2 = {vv, vv};
                            S0 = S0 * (f32x2_){dA[0], dA[1]} + sa2 * (f32x2_){kaA[0], kaA[1]} + vv2 * (f32x2_){kpA[0], kpA[1]};
                            S1 = S1 * (f32x2_){dA[2], dA[3]} + sa2 * (f32x2_){kaA[2], kaA[3]} + vv2 * (f32x2_){kpA[2], kpA[3]};
                            S2 = S2 * (f32x2_){dB[0], dB[1]} + sa2 * (f32x2_){kaB[0], kaB[1]} + vv2 * (f32x2_){kpB[0], kpB[1]};
                            S3 = S3 * (f32x2_){dB[2], dB[3]} + sa2 * (f32x2_){kaB[2], kaB[3]} + vv2 * (f32x2_){kpB[2], kpB[3]};
                            f32x2_ q2 = S0 * (f32x2_){rA[0], rA[1]}; q2 = S1 * (f32x2_){rA[2], rA[3]} + q2; q2 = S2 * (f32x2_){rB[0], rB[1]} + q2; q2 = S3 * (f32x2_){rB[2], rB[3]} + q2;
                            float y = q2[0] + q2[1];
                            y = row8_sum(y);
                            yv[tt] = y;
                        }
#undef RW3_LD
                        if (kq == 0) {
#pragma unroll
                            for (int tt = 0; tt < 8; ++tt) osC[(seg * 8 + tt) * 32 + crow] = yv[tt]; }
                    }
                } else if (pact) {
                    if (seg == 0) {
                        float f[8];
                        unpack8(p0, f); { float* d = rsN + pt * 64 + pvc * 8; *(f32x4*)d = (f32x4){f[0], f[1], f[2], f[3]}; *(f32x4*)(d + 4) = (f32x4){f[4], f[5], f[6], f[7]}; }
                        unpack8(p1, f); { float* d = kpN + pt * 64 + pvc * 8; *(f32x4*)d = (f32x4){f[0], f[1], f[2], f[3]}; *(f32x4*)(d + 4) = (f32x4){f[4], f[5], f[6], f[7]}; }
                        unpack8(p2, f); { u32x4 w; w.x = pk_bf16(tanh_fast(f[0]), tanh_fast(f[1])); w.y = pk_bf16(tanh_fast(f[2]), tanh_fast(f[3]));
                            w.z = pk_bf16(tanh_fast(f[4]), tanh_fast(f[5])); w.w = pk_bf16(tanh_fast(f[6]), tanh_fast(f[7])); *(u32x4*)(WL + pt * 72 + pvc * 8) = w; }
                        *(u32x4*)(AL + pt * 72 + pvc * 8) = p3;
                        if (ptid < 128) { unpack8(p4, f); float* dv = vsN + vt_ * 32 + vvc * 8; *(f32x4*)dv = (f32x4){f[0], f[1], f[2], f[3]}; *(f32x4*)(dv + 4) = (f32x4){f[4], f[5], f[6], f[7]}; }
                        if (c + 2 < SEQ / 32) RW3_PREFETCH(c + 2);
                    } else if (seg == 1) {
#pragma unroll
                        for (int rt = 0; rt < 2; ++rt) {
                            f32x4 aw = {0.f, 0.f, 0.f, 0.f}, aa = {0.f, 0.f, 0.f, 0.f};
                            aw = MFMA16(ldfrag(WL, 72, rt * 16, 0, lane), ldfrag(WUPT, 72, pw * 16, 0, lane), aw); aw = MFMA16(ldfrag(WL, 72, rt * 16, 32, lane), ldfrag(WUPT, 72, pw * 16, 32, lane), aw);
                            aa = MFMA16(ldfrag(AL, 72, rt * 16, 0, lane), ldfrag(AUPT, 72, pw * 16, 0, lane), aa); aa = MFMA16(ldfrag(AL, 72, rt * 16, 32, lane), ldfrag(AUPT, 72, pw * 16, 32, lane), aa);
#pragma unroll
                            for (int jj = 0; jj < 4; ++jj) { const int t = rt * 16 + quad * 4 + jj;
                                const float sw = w0c + aw[jj], sa_ = a0c + aa[jj];
                                const float av = sigmoidf_(sa_);
                                const float kraw = kpN[t * 64 + cm];
                                dsN[t * 64 + cm] = __expf(-0.6065306597f * sigmoidf_(sw));
                                kkN[t * 64 + cm] = kraw * kkc;
                                kpN[t * 64 + cm] = kraw * (1.0f + (av - 1.0f) * kac);
                                kaN[t * 64 + cm] = av; } }
                    } else if (seg == 2) {
                        const int t = ptid >> 3;
                        float* pk_ = kkN + t * 64 + rpart * 8; float* pa_ = kaN + t * 64 + rpart * 8;
                        const f32x4 k0 = *(const f32x4*)pk_, k1 = *(const f32x4*)(pk_ + 4), a0 = *(const f32x4*)pa_, a1 = *(const f32x4*)(pa_ + 4);
                        const f32x4 r0 = *(const f32x4*)(rsN + t * 64 + rpart * 8), r1 = *(const f32x4*)(rsN + t * 64 + rpart * 8 + 4);
                        const f32x4 q0 = *(const f32x4*)(kpN + t * 64 + rpart * 8), q1 = *(const f32x4*)(kpN + t * 64 + rpart * 8 + 4);
                        const float ss = row8_sum(k0[0] * k0[0] + k0[1] * k0[1] + k0[2] * k0[2] + k0[3] * k0[3] + k1[0] * k1[0] + k1[1] * k1[1] + k1[2] * k1[2] + k1[3] * k1[3]);
                        const float inv = rsqrtf(ss + 1e-6f);
                        const f32x4 n0 = k0 * inv, n1 = k1 * inv;
                        *(f32x4*)pk_ = -n0; *(f32x4*)(pk_ + 4) = -n1; *(f32x4*)pa_ = n0 * a0; *(f32x4*)(pa_ + 4) = n1 * a1;
                        const float bo = row8_sum(r0[0] * q0[0] * rkA[0] + r0[1] * q0[1] * rkA[1] + r0[2] * q0[2] * rkA[2] + r0[3] * q0[3] * rkA[3]
                                                  + r1[0] * q1[0] * rkB[0] + r1[1] * q1[1] * rkB[1] + r1[2] * q1[2] * rkB[2] + r1[3] * q1[3] * rkB[3]);
                        if (half == 0 && rpart == 0) bonus[(rowb + (size_t)(c + 1) * 32 + t) * 16 + hd] = bo;
                    }
                }
                if (seg < 3) __syncthreads();
            }
        }
        __syncthreads();
        if (!producer) {
            const int cl = SEQ / 32 - 1; const float* osL = osb + (cl & 1) * 1024;
            const int t = tid >> 3, c4 = (tid & 7) * 4; const f32x4 v = *(const f32x4*)(osL + t * 32 + c4);
            u32x2 w; w.x = pk_bf16(v[0], v[1]); w.y = pk_bf16(v[2], v[3]);
            *(u32x2*)(O + (rowb + (size_t)cl * 32 + t) * DM + hd * 64 + half * 32 + c4) = w; }
#undef RW3_PREFETCH
    }
}
__device__ __forceinline__ void phase_rw_post(const KA a) {
    const bf16_t* h = (const bf16_t*)(a.ws() + WS_H);
    const bf16_t* O = (const bf16_t*)(a.ws() + WS_X);
    const float* bonus = (const float*)(a.ws() + WS_BONUS);
    bf16_t* Y = (bf16_t*)(a.ws() + WS_X + 64 * MiB);
    const int lane = ltid() & 63, wid = ltid() >> 6;
    float gw[16], gb[16];
#pragma unroll
    for (int e = 0; e < 16; ++e) { gw[e] = a.in(22)[lane * 16 + e]; gb[e] = a.in(23)[lane * 16 + e]; }
    const int stride = (int)gridDim.x * 8;
    int row = lbid() * 8 + wid;
    u32x4 n0[6]; float nbo = 0.f;
#define RWP_LOAD(R) do { n0[0] = ntl((const u32x4*)(O + (size_t)(R) * DM + lane * 16)); n0[1] = ntl((const u32x4*)(O + (size_t)(R) * DM + lane * 16 + 8)); \
        n0[2] = ntl((const u32x4*)(h + (size_t)(R) * NH + 3072 + lane * 16)); n0[3] = ntl((const u32x4*)(h + (size_t)(R) * NH + 3072 + lane * 16 + 8)); \
        n0[4] = ntl((const u32x4*)(h + (size_t)(R) * NH + 2048 + lane * 16)); n0[5] = ntl((const u32x4*)(h + (size_t)(R) * NH + 2048 + lane * 16 + 8)); \
        nbo = bonus[(size_t)(R) * 16 + (lane >> 2)]; } while (0)
    if (row < MTOK) RWP_LOAD(row);
    for (; row < MTOK; row += stride) {
        float o[16], z[16], v[16];
        unpack8(n0[0], *(float(*)[8])&o[0]); unpack8(n0[1], *(float(*)[8])&o[8]); unpack8(n0[2], *(float(*)[8])&z[0]); unpack8(n0[3], *(float(*)[8])&z[8]);
        unpack8(n0[4], *(float(*)[8])&v[0]); unpack8(n0[5], *(float(*)[8])&v[8]);
        const float bo = nbo;
        const int nr = row + stride;
        if (nr < MTOK) RWP_LOAD(nr);
        float s = 0.f;
#pragma unroll
        for (int e = 0; e < 16; ++e) s += o[e];
        s = quad_sum(s);
        const float mu = s * (1.0f / 64.0f);
        float ss = 0.f;
#pragma unroll
        for (int e = 0; e < 16; ++e) { const float d = o[e] - mu; ss += d * d; }
        ss = quad_sum(ss);
        const float sc = rsqrtf(ss * (1.0f / 64.0f) + 64e-5f);
        float y[16];
#pragma unroll
        for (int e = 0; e < 16; ++e) y[e] = ((o[e] - mu) * sc * gw[e] + gb[e] + bo * v[e]) * siluf_(z[e]);
        u32x4 w0, w1; w0.x = pk_bf16(y[0], y[1]); w0.y = pk_bf16(y[2], y[3]); w0.z = pk_bf16(y[4], y[5]); w0.w = pk_bf16(y[6], y[7]);
        w1.x = pk_bf16(y[8], y[9]); w1.y = pk_bf16(y[10], y[11]); w1.z = pk_bf16(y[12], y[13]); w1.w = pk_bf16(y[14], y[15]);
        *(u32x4*)(Y + (size_t)row * DM + lane * 16) = w0; *(u32x4*)(Y + (size_t)row * DM + lane * 16 + 8) = w1;
    }
#undef RWP_LOAD
}

__device__ __forceinline__ bf16_t* dn_seg(bf16_t* h, size_t row0, int hd, int sgi) { const int ar = sgi / 61, r = sgi - ar * 61; return h + (row0 + r) * NH + ar * 1024 + hd * 128; }
__device__ __forceinline__ void phase_dn_prep2(const KA a, int j, unsigned char* shm_) {
    bf16_t* h = (bf16_t*)(a.ws() + WS_H);
    float* E63 = (float*)(a.ws() + WS_BONUS);
    const float* convw = a.in(8) + (size_t)j * 4 * 3072;
    bf16_t* Kraw = (bf16_t*)shm_; bf16_t* KT = (bf16_t*)(shm_ + 17408); bf16_t* VT = (bf16_t*)(shm_ + 35840);
    float* Ap = (float*)(shm_ + 54272); bf16_t* T1 = (bf16_t*)(shm_ + 70656); bf16_t* T2 = (bf16_t*)(shm_ + 79872);
    float* gt = (float*)(shm_ + 89088); float* bet = gt; float* Gs = gt + 64; float* eG = gt + 128; float* rk = gt + 192;
    bf16_t* Vraw = (bf16_t*)(shm_ + 90112); bf16_t* Qraw = (bf16_t*)(shm_ + 107520);
    float* rq = (float*)(shm_ + 124928); float* kds = rq + 64; float* rqp = rq + 128;
    const int tid0 = ltid();
#define DNP_IDX(T) const int tid = (T), wid = tid >> 6, lane = tid & 63, quad = lane >> 4, l15 = lane & 15, cidx = tid & 255, cvc = cidx & 31, ctg = cidx >> 5, cisv = tid >> 8, qc2 = tid & 63, qtg = tid >> 6; (void)quad; (void)l15
    u32x2 praw[11]; unsigned qraw[11]; float pbp = 0.f, pap = 0.f;
#define DNP_PREFETCH(U) do { const int ch_ = (U) & 63, hd_ = ((U) >> 6) & 7, b_ = (U) >> 9; const int t0p = ch_ * 64; const size_t rowp = (size_t)b_ * SEQ + t0p; \
        const int hc = 1024 + cisv * 1024 + hd_ * 128 + cvc * 4; const int hq = hd_ * 128 + qc2 * 2; \
        _Pragma("unroll") for (int i = 0; i < 11; ++i) { const int tl = ctg * 8 - 3 + i; \
            if (t0p + tl >= 0) praw[i] = *(const u32x2*)(h + (size_t)((long)rowp + tl) * NH + hc); else praw[i] = (u32x2){0u, 0u}; } \
        _Pragma("unroll") for (int i = 0; i < 11; ++i) { const int tl = qtg * 8 - 3 + i; \
            if (t0p + tl >= 0) qraw[i] = *(const unsigned*)(h + (size_t)((long)rowp + tl) * NH + hq); else qraw[i] = 0u; } \
        if (wid == 5) { pbp = bf2f(h[(rowp + lane) * NH + 4096 + hd_]); pap = bf2f(h[(rowp + lane) * NH + 4104 + hd_]); } } while (0)
    { DNP_IDX(tid0); const int u0 = lbid(); if (u0 < NB * 8 * 64) DNP_PREFETCH(u0); }
    for (int unit = lbid(); unit < NB * 8 * 64; unit += gridDim.x) {
        int tl_ = tid0; asm volatile("" : "+v"(tl_));
        DNP_IDX(tl_);
        const int ch = unit & 63, hd = (unit >> 6) & 7, b = unit >> 9;
        const int t0 = ch * 64; const size_t row0 = (size_t)b * SEQ + t0;
        bf16_t* Wg = (bf16_t*)(a.ws() + WS_X + (size_t)unit * 16384); bf16_t* Ug = (bf16_t*)(a.ws() + WS_X + 64 * MiB + (size_t)unit * 16384);
        f32x4 pwv[4]; f32x2_ qwv[4];
#pragma unroll
        for (int jw = 0; jw < 4; ++jw) { pwv[jw] = *(const f32x4*)(convw + jw * 3072 + 1024 + cisv * 1024 + hd * 128 + cvc * 4); qwv[jw] = *(const f32x2_*)(convw + jw * 3072 + hd * 128 + qc2 * 2); }
        __syncthreads();
        {
            bf16_t* rm = cisv ? Vraw : Kraw;
            f32x4 x0, x1, x2, x3;
#define DN_X(i) ((f32x4){bflo(praw[i].x), bfhi(praw[i].x), bflo(praw[i].y), bfhi(praw[i].y)})
            x1 = DN_X(0); x2 = DN_X(1); x3 = DN_X(2);
#pragma unroll
            for (int i = 3; i < 11; ++i) {
                x0 = x1; x1 = x2; x2 = x3; x3 = DN_X(i);
                const f32x4 y = pwv[0] * x0 + pwv[1] * x1 + pwv[2] * x2 + pwv[3] * x3;
                u32x2 o; o.x = pk_bf16(siluf_(y[0]), siluf_(y[1])); o.y = pk_bf16(siluf_(y[2]), siluf_(y[3]));
                *(u32x2*)(rm + (ctg * 8 + i - 3) * 136 + cvc * 4) = o;
            }
#undef DN_X
            __builtin_amdgcn_sched_barrier(0);
            f32x2_ q0, q1, q2, q3;
#define DN_Q(i) ((f32x2_){bflo(qraw[i]), bfhi(qraw[i])})
            q1 = DN_Q(0); q2 = DN_Q(1); q3 = DN_Q(2);
#pragma unroll
            for (int i = 3; i < 11; ++i) {
                q0 = q1; q1 = q2; q2 = q3; q3 = DN_Q(i);
                const f32x2_ y = qwv[0] * q0 + qwv[1] * q1 + qwv[2] * q2 + qwv[3] * q3;
                *(unsigned*)(Qraw + (qtg * 8 + i - 3) * 136 + qc2 * 2) = pk_bf16(siluf_(y[0]), siluf_(y[1]));
            }
#undef DN_Q
        }
        if (wid == 5) { const int t = lane;
            float g = -__expf(a.in(9)[j * 8 + hd]) * softplusf_(pap + a.in(10)[j * 8 + hd]);
#pragma unroll
            for (int off = 1; off < 64; off <<= 1) { const float y = __shfl_up(g, off, 64); if (lane >= off) g += y; }
            bet[t] = sigmoidf_(pbp); Gs[t] = g; eG[t] = __expf(g);
            if (lane == 63) E63[unit] = __expf(g); }
        __syncthreads();
        {
            const int row = tid >> 2, part = tid & 3, which = row >> 6, t = row & 63;
            const bf16_t* src = (which ? Kraw : Qraw) + t * 136 + part * 32;
            float ss = 0.f;
#pragma unroll
            for (int q8 = 0; q8 < 4; ++q8) { float f[8]; unpack8(*(const u32x4*)(src + q8 * 8), f);
#pragma unroll
                for (int e = 0; e < 8; ++e) ss += f[e] * f[e]; }
            ss = quad_sum(ss);
            if (part == 0) { const float r = rsqrtf(ss + 1e-6f);
                if (which) { rk[t] = r; kds[t] = r * __expf(Gs[63] - Gs[t]); } else { rqp[t] = r * 0.08838834764831845f; rq[t] = r * 0.08838834764831845f * eG[t]; } } }
        __syncthreads();
        { const int d = tid & 127, jg = tid >> 7;
#pragma unroll
          for (int r = 0; r < 2; ++r) { const bf16_t* src = r ? Vraw : Kraw; bf16_t* dst = r ? VT : KT;
            bf16_t raw[16];
#pragma unroll
            for (int jj = 0; jj < 16; ++jj) raw[jj] = src[(jg * 16 + jj) * 136 + d];
            u32x4 w0, w1; w0.x = raw[0] | ((unsigned)raw[1] << 16); w0.y = raw[2] | ((unsigned)raw[3] << 16); w0.z = raw[4] | ((unsigned)raw[5] << 16); w0.w = raw[6] | ((unsigned)raw[7] << 16);
            w1.x = raw[8] | ((unsigned)raw[9] << 16); w1.y = raw[10] | ((unsigned)raw[11] << 16); w1.z = raw[12] | ((unsigned)raw[13] << 16); w1.w = raw[14] | ((unsigned)raw[15] << 16);
            *(u32x4*)(dst + d * 72 + jg * 16) = w0; *(u32x4*)(dst + d * 72 + jg * 16 + 8) = w1;
            if (r == 0) { float kv[16];
#pragma unroll
                for (int jj = 0; jj < 16; ++jj) kv[jj] = bf2f(raw[jj]) * kds[jg * 16 + jj];
                u32x4 g0, g1; g0.x = pk_bf16(kv[0], kv[1]); g0.y = pk_bf16(kv[2], kv[3]); g0.z = pk_bf16(kv[4], kv[5]); g0.w = pk_bf16(kv[6], kv[7]);
                g1.x = pk_bf16(kv[8], kv[9]); g1.y = pk_bf16(kv[10], kv[11]); g1.z = pk_bf16(kv[12], kv[13]); g1.w = pk_bf16(kv[14], kv[15]);
                bf16_t* kp_ = dn_seg(h, row0, hd, 64 + (d >> 1)) + (d & 1) * 64 + jg * 16;
                *(u32x4*)kp_ = g0; *(u32x4*)(kp_ + 8) = g1; }
            __builtin_amdgcn_sched_barrier(0); } }
        {
            const int t = tid >> 3, c16 = (tid & 7) * 16; const float sc = rq[t];
            float f[8]; u32x4 o0, o1;
            unpack8(*(const u32x4*)(Qraw + t * 136 + c16), f);
            o0.x = pk_bf16(f[0] * sc, f[1] * sc); o0.y = pk_bf16(f[2] * sc, f[3] * sc); o0.z = pk_bf16(f[4] * sc, f[5] * sc); o0.w = pk_bf16(f[6] * sc, f[7] * sc);
            unpack8(*(const u32x4*)(Qraw + t * 136 + c16 + 8), f);
            o1.x = pk_bf16(f[0] * sc, f[1] * sc); o1.y = pk_bf16(f[2] * sc, f[3] * sc); o1.z = pk_bf16(f[4] * sc, f[5] * sc); o1.w = pk_bf16(f[6] * sc, f[7] * sc);
            bf16_t* qp_ = dn_seg(h, row0, hd, t) + c16;
            *(u32x4*)qp_ = o0; *(u32x4*)(qp_ + 8) = o1; }
        __builtin_amdgcn_sched_barrier(0);
        { const int rt = wid >> 1;
#pragma unroll
          for (int c2 = 0; c2 < 2; ++c2) { const int ct = (wid & 1) * 2 + c2;
            f32x4 acc = {0.f, 0.f, 0.f, 0.f}, accp = {0.f, 0.f, 0.f, 0.f};
#pragma unroll
            for (int k0 = 0; k0 < 128; k0 += 32) { const bf16x8 bk = ldfrag(Kraw, 136, ct * 16, k0, lane);
                acc = MFMA16(ldfrag(Kraw, 136, rt * 16, k0, lane), bk, acc); accp = MFMA16(ldfrag(Qraw, 136, rt * 16, k0, lane), bk, accp); }
            const int jc = ct * 16 + l15; const float rkj = rk[jc], Gj = Gs[jc];
#pragma unroll
            for (int jj = 0; jj < 4; ++jj) { const int i = rt * 16 + quad * 4 + jj;
                const float dec = __expf(Gs[i] - Gj);
                const float av = (jc < i) ? bet[i] * rk[i] * rkj * dec * acc[jj] : 0.f;
                Ap[i * 64 + (jc & 7) * 8 + (jc >> 3)] = av;
                const float pv = (jc <= i) ? rqp[i] * rkj * dec * accp[jj] : 0.f;
                dn_seg(h, row0, hd, 128 + (i >> 1))[(i & 1) * 64 + jc] = f2bf1(pv); } } }
        __syncthreads();
        { const int un = unit + (int)gridDim.x; if (un < NB * 8 * 64) DNP_PREFETCH(un); }
        {
            const int c = wid * 8 + (lane >> 3), js = lane & 7;
            float Tl[8];
#pragma unroll
            for (int m = 0; m < 8; ++m) Tl[m] = 0.f;
            if (js == 0) Tl[0] = (c == 0) ? 1.f : 0.f;
#pragma unroll
            for (int i = 1; i < 64; ++i) {
                const f32x4 c0 = *(const f32x4*)(Ap + i * 64 + js * 8);
                f32x4 c1 = {0.f, 0.f, 0.f, 0.f};
                if (i > 32) c1 = *(const f32x4*)(Ap + i * 64 + js * 8 + 4);
                float part = 0.f;
#pragma unroll
                for (int m = 0; m < (i + 7) / 8; ++m) part += (m < 4 ? c0[m & 3] : c1[m & 3]) * Tl[m];
                const float sres = row8_sum(part);
                const float val = ((i == c) ? 1.f : 0.f) - sres;
                if (js == (i & 7)) Tl[i >> 3] = val;
            }
            const float s1 = bet[c], s2 = bet[c] * eG[c] * rk[c];
#pragma unroll
            for (int m = 0; m < 8; ++m) { const int i = js + 8 * m; T1[i * 72 + c] = f2bf1(Tl[m] * s1); T2[i * 72 + c] = f2bf1(Tl[m] * s2); }
        }
        __syncthreads();
        {
            const bf16x8 bv0 = ldfrag(VT, 72, wid * 16, 0, lane), bv1 = ldfrag(VT, 72, wid * 16, 32, lane);
            const bf16x8 bk0 = ldfrag(KT, 72, wid * 16, 0, lane), bk1 = ldfrag(KT, 72, wid * 16, 32, lane);
#pragma unroll
            for (int rt = 0; rt < 4; ++rt) {
                f32x4 au = {0.f, 0.f, 0.f, 0.f}, aw = {0.f, 0.f, 0.f, 0.f};
                au = MFMA16(ldfrag(T1, 72, rt * 16, 0, lane), bv0, au); au = MFMA16(ldfrag(T1, 72, rt * 16, 32, lane), bv1, au);
                aw = MFMA16(ldfrag(T2, 72, rt * 16, 0, lane), bk0, aw); aw = MFMA16(ldfrag(T2, 72, rt * 16, 32, lane), bk1, aw);
#pragma unroll
                for (int jj = 0; jj < 4; ++jj) { const int i = rt * 16 + quad * 4 + jj;
                    Ug[i * 128 + wid * 16 + l15] = f2bf1(au[jj]); Wg[i * 128 + wid * 16 + l15] = f2bf1(aw[jj]); } }
        }
    }
#undef DNP_PREFETCH
#undef DNP_IDX
}
__device__ __forceinline__ void phase_dn_chunk2(const KA a, int j, unsigned char* shm_) {
    bf16_t* h = (bf16_t*)(a.ws() + WS_H);
    const float* E63 = (const float*)(a.ws() + WS_BONUS);
    bf16_t* Qsl = (bf16_t*)shm_; bf16_t* KdT = (bf16_t*)(shm_ + 34816); bf16_t* Wbf = (bf16_t*)(shm_ + 53248);
    bf16_t* ST = (bf16_t*)(shm_ + 70656); bf16_t* Pbf = (bf16_t*)(shm_ + 79360); bf16_t* VnT = (bf16_t*)(shm_ + 88576);
    const int tid = ltid(), wid = tid >> 6, lane = tid & 63, quad = lane >> 4, l15 = lane & 15;
    for (int unit = lbid(); unit < NB * 8 * 4; unit += gridDim.x) {
        const int un_ = (gridDim.x == 256) ? xcd_unit(unit) : unit; const int b = un_ >> 5, hd = (un_ >> 2) & 7, q4 = un_ & 3;
        f32x4 st0 = {0.f, 0.f, 0.f, 0.f}, st1 = {0.f, 0.f, 0.f, 0.f};
        __syncthreads();
        for (int i = tid; i < 32 * 136 / 2; i += NTHR) ((unsigned*)ST)[i] = 0u;
        const int rt = wid >> 1, et = wid & 1;
        const size_t rowb = (size_t)b * SEQ;
        const bf16_t* Wg0 = (const bf16_t*)(a.ws() + WS_X + (size_t)((b * 8 + hd) * 64) * 16384);
        bf16_t* Ug0 = (bf16_t*)(a.ws() + WS_X + 64 * MiB + (size_t)((b * 8 + hd) * 64) * 16384);
        u32x4 pq[2], pk_[2], pp, pw[2]; bf16_t pu[4]; float pe = 0.f;
#define DN2_PREFETCH(CH) do { const size_t r0p = rowb + (size_t)(CH) * 64; const bf16_t* Wgp = Wg0 + (size_t)(CH) * 8192; const bf16_t* Ugp = Ug0 + (size_t)(CH) * 8192; \
            _Pragma("unroll") for (int r = 0; r < 2; ++r) { const int p = tid + NTHR * r; \
                pq[r] = *(const u32x4*)(dn_seg(h, r0p, hd, p >> 4) + (p & 15) * 8); \
                const int d = p >> 3; pk_[r] = *(const u32x4*)(dn_seg(h, r0p, hd, 64 + (d >> 1)) + (d & 1) * 64 + (p & 7) * 8); \
                pw[r] = *(const u32x4*)(Wgp + (p >> 4) * 128 + (p & 15) * 8); } \
            { const int i = tid >> 3; pp = *(const u32x4*)(dn_seg(h, r0p, hd, 128 + (i >> 1)) + (i & 1) * 64 + (tid & 7) * 8); } \
            _Pragma("unroll") for (int jj = 0; jj < 4; ++jj) pu[jj] = Ugp[(rt * 16 + quad * 4 + jj) * 128 + q4 * 32 + et * 16 + l15]; \
            pe = E63[(b * 8 + hd) * 64 + (CH)]; } while (0)
        DN2_PREFETCH(0);
        for (int ch = 0; ch < SEQ / 64; ++ch) {
            __syncthreads();
#pragma unroll
            for (int r = 0; r < 2; ++r) { const int p = tid + NTHR * r;
                *(u32x4*)(Qsl + (p >> 4) * 136 + (p & 15) * 8) = pq[r];
                *(u32x4*)(KdT + (p >> 3) * 72 + (p & 7) * 8) = pk_[r];
                *(u32x4*)(Wbf + (p >> 4) * 136 + (p & 15) * 8) = pw[r]; }
            *(u32x4*)(Pbf + (tid >> 3) * 72 + (tid & 7) * 8) = pp;
            float ureg[4];
#pragma unroll
            for (int jj = 0; jj < 4; ++jj) ureg[jj] = bf2f(pu[jj]);
            const float eg63 = pe;
            if (ch + 1 < SEQ / 64) DN2_PREFETCH(ch + 1);
            __syncthreads();
            f32x4 accv = {0.f, 0.f, 0.f, 0.f}, acco = {0.f, 0.f, 0.f, 0.f};
#pragma unroll
            for (int k0 = 0; k0 < 128; k0 += 32) { const bf16x8 bs = ldfrag(ST, 136, et * 16, k0, lane);
                accv = MFMA16(ldfrag(Wbf, 136, rt * 16, k0, lane), bs, accv);
                acco = MFMA16(ldfrag(Qsl, 136, rt * 16, k0, lane), bs, acco); }
            { u32x2 w; w.x = pk_bf16(ureg[0] - accv[0], ureg[1] - accv[1]); w.y = pk_bf16(ureg[2] - accv[2], ureg[3] - accv[3]);
              *(u32x2*)(VnT + (et * 16 + l15) * 72 + rt * 16 + quad * 4) = w; }
            __syncthreads();
            acco = MFMA16(ldfrag(Pbf, 72, rt * 16, 0, lane), ldfrag(VnT, 72, et * 16, 0, lane), acco);
            acco = MFMA16(ldfrag(Pbf, 72, rt * 16, 32, lane), ldfrag(VnT, 72, et * 16, 32, lane), acco);
#pragma unroll
            for (int jj = 0; jj < 4; ++jj) { const int i = rt * 16 + quad * 4 + jj;
                Ug0[(size_t)ch * 8192 + i * 128 + q4 * 32 + et * 16 + l15] = f2bf1(acco[jj]); }
            { const bf16x8 ak0 = ldfrag(KdT, 72, wid * 16, 0, lane), ak1 = ldfrag(KdT, 72, wid * 16, 32, lane);
              st0 = st0 * eg63; st1 = st1 * eg63;
              st0 = MFMA16(ak0, ldfrag(VnT, 72, 0, 0, lane), st0); st0 = MFMA16(ak1, ldfrag(VnT, 72, 0, 32, lane), st0);
              st1 = MFMA16(ak0, ldfrag(VnT, 72, 16, 0, lane), st1); st1 = MFMA16(ak1, ldfrag(VnT, 72, 16, 32, lane), st1);
              u32x2 w; w.x = pk_bf16(st0[0], st0[1]); w.y = pk_bf16(st0[2], st0[3]);
              *(u32x2*)(ST + (l15) * 136 + wid * 16 + quad * 4) = w;
              w.x = pk_bf16(st1[0], st1[1]); w.y = pk_bf16(st1[2], st1[3]);
              *(u32x2*)(ST + (16 + l15) * 136 + wid * 16 + quad * 4) = w; }
        }
#undef DN2_PREFETCH
    }
}
__device__ __forceinline__ void phase_ml_chunk(const KA a, unsigned char* shm_) {
    const bf16_t* h = (const bf16_t*)(a.ws() + WS_H);
    bf16_t* O = (bf16_t*)(a.ws() + WS_X);
    const float* convw = a.in(26);
    float* qs = (float*)shm_; float* ks = qs + 4096; float* vs = qs + 8192; float* Hout = qs + 10240;
    bf16_t* Qbf = (bf16_t*)(shm_ + 53248); bf16_t* Kbf = Qbf + 64 * 72; bf16_t* KwT = Kbf + 64 * 72; bf16_t* Wbf = KwT + 64 * 72; bf16_t* VT = Wbf + 64 * 72; bf16_t* CT = VT + 48 * 72;
    float* gt = (float*)(shm_ + 103936);
    float* il = gt; float* fl = gt + 64; float* ra = gt + 128; float* cb = gt + 192; float* inter = gt + 256; float* kscale = gt + 320; float* em = gt + 384; float* misc = gt + 448;
    const int tid = ltid(), wid = tid >> 6, lane = tid & 63, quad = lane >> 4, l15 = lane & 15;
    for (int unit = lbid(); unit < NB * 8 * 4; unit += gridDim.x) {
        const int un_ = (gridDim.x == 256) ? xcd_unit(unit) : unit; const int b = un_ >> 5, hd = (un_ >> 2) & 7, q4 = un_ & 3;
        const float ib = a.in(27)[hd], fb = a.in(28)[hd];
        f32x4 st0 = {0.f, 0.f, 0.f, 0.f}, st1 = {0.f, 0.f, 0.f, 0.f};
        float m_prev = -1e30f;
        __syncthreads();
        for (int i = tid; i < 48 * 72 / 2; i += NTHR) ((unsigned*)CT)[i] = 0u;
        for (int i = tid; i < 16 * 72; i += NTHR) VT[32 * 72 + i] = (i < 72) ? (bf16_t)0x3F80 : (bf16_t)0;
        const int cidx = tid & 127, cvc = cidx & 15, ctg = cidx >> 4, cisk = (tid >> 7) & 1;
        const int chc = cisk * 512 + hd * 64 + cvc * 4;
        const int vt_ = (tid & 255) >> 2, vvc = tid & 3, vcol = 1024 + hd * 128 + q4 * 32 + vvc * 8;
        const size_t rowb = (size_t)b * SEQ;
        f32x4 cwv[4];
#pragma unroll
        for (int jw = 0; jw < 4; ++jw) cwv[jw] = *(const f32x4*)(convw + jw * 1024 + chc);
        u32x2 praw[11]; u32x4 pv = {0u, 0u, 0u, 0u}; float pip = 0.f, pfp = 0.f;
#define ML_PREFETCH(CH) do { const int t0p = (CH) * 64; \
            if (tid < 256) { _Pragma("unroll") for (int i = 0; i < 11; ++i) { const int tl = ctg * 8 - 3 + i; \
                if (t0p + tl >= 0) praw[i] = *(const u32x2*)(h + (size_t)((long)(rowb + t0p) + tl) * NH + chc); else praw[i] = (u32x2){0u, 0u}; } } \
            else pv = *(const u32x4*)(h + (rowb + t0p + vt_) * NH + vcol); \
            if (wid == 6) { pip = bf2f(h[(rowb + t0p + lane) * NH + 4096 + hd]); pfp = bf2f(h[(rowb + t0p + lane) * NH + 4104 + hd]); } } while (0)
        ML_PREFETCH(0);
        for (int ch = 0; ch < SEQ / 64; ++ch) {
            const int t0 = ch * 64; const size_t row0 = (size_t)b * SEQ + t0;
            __syncthreads();
            if (tid < 256) {
                float* dst = (cisk ? ks : qs) + cvc * 4; const float sc = cisk ? 0.125f : 1.0f;
                f32x4 x0, x1, x2, x3;
#define ML_X(i) ((f32x4){bflo(praw[i].x), bfhi(praw[i].x), bflo(praw[i].y), bfhi(praw[i].y)})
                x1 = ML_X(0); x2 = ML_X(1); x3 = ML_X(2);
#pragma unroll
                for (int i = 3; i < 11; ++i) {
                    x0 = x1; x1 = x2; x2 = x3; x3 = ML_X(i);
                    const f32x4 y = cwv[0] * x0 + cwv[1] * x1 + cwv[2] * x2 + cwv[3] * x3;
                    *(f32x4*)(dst + (ctg * 8 + i - 3) * 64) = (f32x4){siluf_(y[0]) * sc, siluf_(y[1]) * sc, siluf_(y[2]) * sc, siluf_(y[3]) * sc};
                }
#undef ML_X
            } else { float f[8]; unpack8(pv, f); float* dv = vs + vt_ * 32 + vvc * 8;
                *(f32x4*)dv = (f32x4){f[0], f[1], f[2], f[3]}; *(f32x4*)(dv + 4) = (f32x4){f[4], f[5], f[6], f[7]}; }
            if (wid == 6) { il[lane] = pip + ib; fl[lane] = -softplusf_(-(pfp + fb)); }
            if (ch + 1 < SEQ / 64) ML_PREFETCH(ch + 1);
            __syncthreads();
            {
                const int t = tid >> 3, c8 = (tid & 7) * 8;
                const f32x4 q0 = *(const f32x4*)(qs + t * 64 + c8), q1 = *(const f32x4*)(qs + t * 64 + c8 + 4);
                const f32x4 k0 = *(const f32x4*)(ks + t * 64 + c8), k1 = *(const f32x4*)(ks + t * 64 + c8 + 4);
                u32x4 w; w.x = pk_bf16(q0[0], q0[1]); w.y = pk_bf16(q0[2], q0[3]); w.z = pk_bf16(q1[0], q1[1]); w.w = pk_bf16(q1[2], q1[3]); *(u32x4*)(Qbf + t * 72 + c8) = w;
                w.x = pk_bf16(k0[0], k0[1]); w.y = pk_bf16(k0[2], k0[3]); w.z = pk_bf16(k1[0], k1[1]); w.w = pk_bf16(k1[2], k1[3]); *(u32x4*)(Kbf + t * 72 + c8) = w;
                const int c = tid & 31, jg = tid >> 5;
                u32x2 v2; v2.x = pk_bf16(vs[(jg * 4 + 0) * 32 + c], vs[(jg * 4 + 1) * 32 + c]); v2.y = pk_bf16(vs[(jg * 4 + 2) * 32 + c], vs[(jg * 4 + 3) * 32 + c]);
                *(u32x2*)(VT + c * 72 + jg * 4) = v2;
            }
            if (wid == 7) {
                const float f = fl[lane], iv = il[lane];
                const float bs = wave_scan_add(f);
                const float cbv = iv - bs;
                const float cm = wave_scan_max(cbv);
                const float mi = fmaxf(m_prev + bs, bs + cm);
                const float b63 = __shfl(bs, 63, 64), mnew = __shfl(mi, 63, 64);
                ra[lane] = bs - mi; cb[lane] = cbv; inter[lane] = __expf(m_prev + bs - mi); kscale[lane] = __expf(b63 - mnew + cbv); em[lane] = __expf(-mi);
                if (lane == 0) misc[0] = __expf(m_prev + b63 - mnew);
                m_prev = mnew;
            }
            __syncthreads();
            {
                const int rt = wid >> 1;
#pragma unroll
                for (int c2 = 0; c2 < 2; ++c2) { const int ct = (wid & 1) * 2 + c2;
                    f32x4 acc = {0.f, 0.f, 0.f, 0.f};
                    acc = MFMA16(ldfrag(Qbf, 72, rt * 16, 0, lane), ldfrag(Kbf, 72, ct * 16, 0, lane), acc);
                    acc = MFMA16(ldfrag(Qbf, 72, rt * 16, 32, lane), ldfrag(Kbf, 72, ct * 16, 32, lane), acc);
                    const int jc = ct * 16 + l15; const float cbj = cb[jc];
#pragma unroll
                    for (int jj = 0; jj < 4; ++jj) { const int i = rt * 16 + quad * 4 + jj;
                        const float wv = (jc <= i) ? __expf(ra[i] + cbj) * acc[jj] : 0.f;
                        Wbf[i * 72 + jc] = f2bf1(wv); } }
                const int d = tid & 63, jg = tid >> 6;
                float kv[8];
#pragma unroll
                for (int jj = 0; jj < 8; ++jj) kv[jj] = ks[(jg * 8 + jj) * 64 + d] * kscale[jg * 8 + jj];
                u32x4 w; w.x = pk_bf16(kv[0], kv[1]); w.y = pk_bf16(kv[2], kv[3]); w.z = pk_bf16(kv[4], kv[5]); w.w = pk_bf16(kv[6], kv[7]);
                *(u32x4*)(KwT + d * 72 + jg * 8) = w;
            }
            __syncthreads();
            { const float carry = misc[0];
#pragma unroll
              for (int r = 0; r < 2; ++r) { const int id = wid + 8 * r;
                if (id < 12) { const int rt = id / 3, ct = id - rt * 3;
                    f32x4 acc = {0.f, 0.f, 0.f, 0.f};
                    acc = MFMA16(ldfrag(Qbf, 72, rt * 16, 0, lane), ldfrag(CT, 72, ct * 16, 0, lane), acc);
                    acc = MFMA16(ldfrag(Qbf, 72, rt * 16, 32, lane), ldfrag(CT, 72, ct * 16, 32, lane), acc);
#pragma unroll
                    for (int jj = 0; jj < 4; ++jj) acc[jj] *= inter[rt * 16 + quad * 4 + jj];
                    acc = MFMA16(ldfrag(Wbf, 72, rt * 16, 0, lane), ldfrag(VT, 72, ct * 16, 0, lane), acc);
                    acc = MFMA16(ldfrag(Wbf, 72, rt * 16, 32, lane), ldfrag(VT, 72, ct * 16, 32, lane), acc);
#pragma unroll
                    for (int jj = 0; jj < 4; ++jj) Hout[(rt * 16 + quad * 4 + jj) * 48 + ct * 16 + l15] = acc[jj];
                    f32x4 st = r ? st1 : st0;
                    st = st * carry;
                    st = MFMA16(ldfrag(KwT, 72, rt * 16, 0, lane), ldfrag(VT, 72, ct * 16, 0, lane), st);
                    st = MFMA16(ldfrag(KwT, 72, rt * 16, 32, lane), ldfrag(VT, 72, ct * 16, 32, lane), st);
                    if (r) st1 = st; else st0 = st; } } }
            __syncthreads();
#pragma unroll
            for (int r = 0; r < 2; ++r) { const int id = wid + 8 * r;
                if (id < 12) { const int dt = id / 3, ct = id - dt * 3; const f32x4 st = r ? st1 : st0;
                    u32x2 w; w.x = pk_bf16(st[0], st[1]); w.y = pk_bf16(st[2], st[3]);
                    *(u32x2*)(CT + (ct * 16 + l15) * 72 + dt * 16 + quad * 4) = w; } }
            { const int t = tid >> 3, c4 = (tid & 7) * 4;
              const f32x4 num = *(const f32x4*)(Hout + t * 48 + c4); const float den = Hout[t * 48 + 32];
              const float dd = 1.0f / fmaxf(fabsf(den), em[t]);
              u32x2 w; w.x = pk_bf16(num[0] * dd, num[1] * dd); w.y = pk_bf16(num[2] * dd, num[3] * dd);
              *(u32x2*)(O + (row0 + t) * DM + hd * 128 + q4 * 32 + c4) = w; }
        }
    }
#undef ML_PREFETCH
}
__device__ __forceinline__ void phase_ml_post(const KA a) {
    const bf16_t* h = (const bf16_t*)(a.ws() + WS_H);
    const bf16_t* O = (const bf16_t*)(a.ws() + WS_X);
    bf16_t* Y = (bf16_t*)(a.ws() + WS_X + 64 * MiB);
    const int lane = ltid() & 63, wid = ltid() >> 6;
    float gw[16];
#pragma unroll
    for (int e = 0; e < 16; ++e) gw[e] = a.in(29)[lane * 16 + e];
    const int stride = (int)gridDim.x * 8;
    int row = lbid() * 8 + wid;
    u32x4 n0[6];
#define MLP_LOAD(R) do { n0[0] = ntl((const u32x4*)(O + (size_t)(R) * DM + lane * 16)); n0[1] = ntl((const u32x4*)(O + (size_t)(R) * DM + lane * 16 + 8)); \
        n0[2] = ntl((const u32x4*)(h + (size_t)(R) * NH + 3072 + lane * 16)); n0[3] = ntl((const u32x4*)(h + (size_t)(R) * NH + 3072 + lane * 16 + 8)); \
        n0[4] = ntl((const u32x4*)(h + (size_t)(R) * NH + 2048 + lane * 16)); n0[5] = ntl((const u32x4*)(h + (size_t)(R) * NH + 2048 + lane * 16 + 8)); } while (0)
    if (row < MTOK) MLP_LOAD(row);
    for (; row < MTOK; row += stride) {
        float o[16], z[16], g[16];
        unpack8(n0[0], *(float(*)[8])&o[0]); unpack8(n0[1], *(float(*)[8])&o[8]); unpack8(n0[2], *(float(*)[8])&z[0]); unpack8(n0[3], *(float(*)[8])&z[8]);
        unpack8(n0[4], *(float(*)[8])&g[0]); unpack8(n0[5], *(float(*)[8])&g[8]);
        const int nr = row + stride;
        if (nr < MTOK) MLP_LOAD(nr);
        float s = 0.f;
#pragma unroll
        for (int e = 0; e < 16; ++e) { o[e] *= sigmoidf_(g[e]); s += o[e]; }
        s = row8_sum(s);
        const float mu = s * (1.0f / 128.0f);
        float ss = 0.f;
#pragma unroll
        for (int e = 0; e < 16; ++e) { const float d = o[e] - mu; ss += d * d; }
        ss = row8_sum(ss);
        const float sc = rsqrtf(ss * (1.0f / 128.0f) + 1e-6f);
        float y[16];
#pragma unroll
        for (int e = 0; e < 16; ++e) y[e] = (o[e] - mu) * sc * gw[e] * siluf_(z[e]);
        u32x4 w0, w1; w0.x = pk_bf16(y[0], y[1]); w0.y = pk_bf16(y[2], y[3]); w0.z = pk_bf16(y[4], y[5]); w0.w = pk_bf16(y[6], y[7]);
        w1.x = pk_bf16(y[8], y[9]); w1.y = pk_bf16(y[10], y[11]); w1.z = pk_bf16(y[12], y[13]); w1.w = pk_bf16(y[14], y[15]);
        *(u32x4*)(Y + (size_t)row * DM + lane * 16) = w0; *(u32x4*)(Y + (size_t)row * DM + lane * 16 + 8) = w1;
    }
#undef MLP_LOAD
}

__device__ __forceinline__ void phase_ln(const KA a, int L) {
    const bf16_t* Yb = (const bf16_t*)(a.ws() + WS_H);
    const float* xr = (L == 0) ? a.in(0) : (const float*)a.out();
    bf16_t* xb = (bf16_t*)(a.ws() + WS_X);
    bf16_t* pb = (bf16_t*)(a.ws() + WS_P);
    const float* p = a.in(1) + (size_t)L * MTOK * DPLE;
    const float* lg = a.in(2) + L * DM; const float* lb = a.in(3) + L * DM;
    const int lane = ltid() & 63, wid = ltid() >> 6;
    f32x4 g[4], bb[4];
#pragma unroll
    for (int i = 0; i < 4; ++i) { g[i] = *(const f32x4*)(lg + i * 256 + lane * 4); bb[i] = *(const f32x4*)(lb + i * 256 + lane * 4); }
    const int stride = (int)gridDim.x * 8;
    int row = lbid() * 8 + wid;
    f32x4 nv[4], npv; u32x2 ny[4];
    if (row < MTOK) {
#pragma unroll
        for (int i = 0; i < 4; ++i) { nv[i] = *(const f32x4*)(xr + (size_t)row * DM + i * 256 + lane * 4); ny[i] = *(const u32x2*)(Yb + (size_t)row * DM + i * 256 + lane * 4); }
        npv = *(const f32x4*)(p + (size_t)row * DPLE + lane * 4); }
    for (; row < MTOK; row += stride) {
        f32x4 v[4]; const f32x4 pv = npv; float s = 0.f;
#pragma unroll
        for (int i = 0; i < 4; ++i) { v[i] = nv[i] * ALPHA + (f32x4){bflo(ny[i].x), bfhi(ny[i].x), bflo(ny[i].y), bfhi(ny[i].y)}; s += v[i][0] + v[i][1] + v[i][2] + v[i][3]; }
        const int nr = row + stride;
        if (nr < MTOK) {
#pragma unroll
            for (int i = 0; i < 4; ++i) { nv[i] = *(const f32x4*)(xr + (size_t)nr * DM + i * 256 + lane * 4); ny[i] = *(const u32x2*)(Yb + (size_t)nr * DM + i * 256 + lane * 4); }
            npv = *(const f32x4*)(p + (size_t)nr * DPLE + lane * 4); }
        const float mu = wave_sum(s) * (1.0f / 1024.0f);
        float ss = 0.f;
#pragma unroll
        for (int i = 0; i < 4; ++i) { v[i] = v[i] - mu; ss += v[i][0] * v[i][0] + v[i][1] * v[i][1] + v[i][2] * v[i][2] + v[i][3] * v[i][3]; }
        const float sc = rsqrtf(wave_sum(ss) * (1.0f / 1024.0f) + 1e-5f);
#pragma unroll
        for (int i = 0; i < 4; ++i) { const f32x4 y = v[i] * sc * g[i] + bb[i];
            u32x2 w; w.x = pk_bf16(y[0], y[1]); w.y = pk_bf16(y[2], y[3]); *(u32x2*)(xb + (size_t)row * DM + i * 256 + lane * 4) = w; }
        { u32x2 w; w.x = pk_bf16(pv[0], pv[1]); w.y = pk_bf16(pv[2], pv[3]); *(u32x2*)(pb + (size_t)row * DPLE + lane * 4) = w; }
    }
}
__device__ __forceinline__ void phase_combine(const KA a, int L) {
    const bf16_t* Yb = (const bf16_t*)(a.ws() + WS_H);
    const float* xr = (L == 0) ? a.in(0) : (const float*)a.out();
    const bf16_t* PP = (const bf16_t*)(a.ws() + WS_H + 128 * MiB);
    const bf16_t* G = (const bf16_t*)(a.ws() + WS_H + 192 * MiB);
    bf16_t* xb = (bf16_t*)(a.ws() + WS_X);
    const float* nw = a.in(5) + L * DM; const float* lg = a.in(2) + L * DM; const float* lb = a.in(3) + L * DM;
    const int lane = ltid() & 63, wid = ltid() >> 6;
    const int next_kind = (L + 1 < NLAYER) ? ((L + 1) % 3) : -1;
    const int stride = (int)gridDim.x * 8;
    int row = lbid() * 8 + wid;
    f32x4 ntv[4]; u32x2 npr[4], ngr[4], nyr[4];
    if (row < MTOK) {
#pragma unroll
        for (int i = 0; i < 4; ++i) { const size_t o = (size_t)row * DM + i * 256 + lane * 4; ntv[i] = ntl((const f32x4*)(xr + o)); nyr[i] = ntl((const u32x2*)(Yb + o)); npr[i] = ntl((const u32x2*)(PP + o)); ngr[i] = ntl((const u32x2*)(G + o)); } }
    for (; row < MTOK; row += stride) {
        f32x4 tv[4], pp[4]; u32x2 gr[4]; float s = 0.f, ss = 0.f;
#pragma unroll
        for (int i = 0; i < 4; ++i) { tv[i] = ntv[i] * ALPHA + (f32x4){bflo(nyr[i].x), bfhi(nyr[i].x), bflo(nyr[i].y), bfhi(nyr[i].y)}; gr[i] = ngr[i]; s += tv[i][0] + tv[i][1] + tv[i][2] + tv[i][3];
            pp[i] = (f32x4){bflo(npr[i].x), bfhi(npr[i].x), bflo(npr[i].y), bfhi(npr[i].y)};
            ss += pp[i][0] * pp[i][0] + pp[i][1] * pp[i][1] + pp[i][2] * pp[i][2] + pp[i][3] * pp[i][3]; }
        const int nr = row + stride;
        if (nr < MTOK) {
#pragma unroll
            for (int i = 0; i < 4; ++i) { const size_t o = (size_t)nr * DM + i * 256 + lane * 4; ntv[i] = ntl((const f32x4*)(xr + o)); nyr[i] = ntl((const u32x2*)(Yb + o)); npr[i] = ntl((const u32x2*)(PP + o)); ngr[i] = ntl((const u32x2*)(G + o)); } }
        const float mu = wave_sum(s) * (1.0f / 1024.0f);
        const float psc = rsqrtf(wave_sum(ss) * (1.0f / 1024.0f) + 1e-6f);
        float vs_ = 0.f;
#pragma unroll
        for (int i = 0; i < 4; ++i) { tv[i] = tv[i] - mu; vs_ += tv[i][0] * tv[i][0] + tv[i][1] * tv[i][1] + tv[i][2] * tv[i][2] + tv[i][3] * tv[i][3]; }
        const float lsc = rsqrtf(wave_sum(vs_) * (1.0f / 1024.0f) + 1e-5f);
#pragma unroll
        for (int i = 0; i < 4; ++i) {
            const int c = i * 256 + lane * 4; const size_t o = (size_t)row * DM + c;
            const f32x4 x1 = tv[i] * lsc * *(const f32x4*)(lg + c) + *(const f32x4*)(lb + c);
            const f32x4 gg = {bflo(gr[i].x), bfhi(gr[i].x), bflo(gr[i].y), bfhi(gr[i].y)};
            const f32x4 y = x1 + gg * pp[i] * psc * *(const f32x4*)(nw + c);
            nts((f32x4*)(a.out() + o), y);
            u32x2 w; w.x = pk_bf16(y[0], y[1]); w.y = pk_bf16(y[2], y[3]);
            if (next_kind == 1) {
                *(u32x2*)(xb + (size_t)row * 2048 + c) = w;
                if ((row & (SEQ - 1)) != SEQ - 1) *(u32x2*)(xb + (size_t)(row + 1) * 2048 + 1024 + c) = w;
                if ((row & (SEQ - 1)) == 0) { u32x2 zz; zz.x = 0u; zz.y = 0u; *(u32x2*)(xb + (size_t)row * 2048 + 1024 + c) = zz; }
            } else if (next_kind >= 0) {
                *(u32x2*)(xb + o) = w;
            }
        }
    }
}

#define XB_TMO      128
#define XB_XCNT(j)  (256  + 64 * (j))
#define XB_XSUB(j)  (1280 + 64 * (j))
#define XB_XGEN(j)  (2304 + 64 * (j))
#define XB_TOP      3328
#define XB_TOPGEN   3392
#define XCD_BAR_WORDS 3456
#define XB_SPIN_CAP (1u << 18)
__device__ __forceinline__ unsigned xb_ld(unsigned* p)              { return __hip_atomic_load(p, __ATOMIC_RELAXED, __HIP_MEMORY_SCOPE_AGENT); }
__device__ __forceinline__ unsigned xb_add(unsigned* p, unsigned v) { return __hip_atomic_fetch_add(p, v, __ATOMIC_RELAXED, __HIP_MEMORY_SCOPE_AGENT); }
__device__ __forceinline__ unsigned xb_xcc_id() { return (unsigned)__builtin_amdgcn_s_getreg((3 << 11) | 20) & 0xFu; }
#define XB_SPIN(cond, bar) do { unsigned _sp = 0; while (cond) { __builtin_amdgcn_s_sleep(1); \
    if ((++_sp & 255u) == 0u) { if (xb_ld(&(bar)[XB_TMO])) break; if (_sp > XB_SPIN_CAP) { atomicAdd(&(bar)[XB_TMO], 1u); break; } } } } while (0)
struct XcdBarrier { unsigned* bar; unsigned x; volatile LAS unsigned* st; };
__device__ __forceinline__ void xcd_barrier_complete(unsigned* bar, unsigned x, unsigned& nloc, unsigned& nx) {
    const unsigned G = gridDim.x * gridDim.y * gridDim.z;
    unsigned sum, cnt, mine, sp = 0u;
    for (;;) {
        sum = 0u; cnt = 0u; mine = 0u;
#pragma unroll
        for (unsigned j = 0; j < 16; ++j) { const unsigned c = xb_ld(&bar[XB_XCNT(j)]); sum += c; cnt += (c > 0u) ? 1u : 0u; mine = (j == x) ? c : mine; }
        if (sum == G) break;
        __builtin_amdgcn_s_sleep(1);
        if ((++sp & 255u) == 0u) { if (xb_ld(&bar[XB_TMO])) break; if (sp > XB_SPIN_CAP) { atomicAdd(&bar[XB_TMO], 1u); break; } }
    }
    nloc = mine > 0u ? mine : 1u; nx = cnt > 0u ? cnt : 1u;
}
__device__ __forceinline__ void xcd_barrier(const XcdBarrier& b) {
    asm volatile("s_waitcnt vmcnt(0)" ::: "memory");
    __syncthreads();
    if (threadIdx.x == 0) {
        unsigned* bar = b.bar;
        __builtin_amdgcn_s_waitcnt(0);
        unsigned nloc = b.st[0], nx = b.st[1];
        if (nloc == 0u) { xcd_barrier_complete(bar, b.x, nloc, nx); b.st[0] = nloc; b.st[1] = nx; }
        const unsigned old = xb_add(&bar[XB_XSUB(b.x)], 1u);
        const unsigned gen = old / nloc;
        if (old + 1u == (gen + 1u) * nloc) {
            __builtin_amdgcn_fence(__ATOMIC_RELEASE, "agent");
            asm volatile("s_waitcnt vmcnt(0)" ::: "memory");
            const unsigned og = xb_add(&bar[XB_TOP], 1u);
            const unsigned tg = og / nx;
            if (og + 1u == (tg + 1u) * nx) xb_add(&bar[XB_TOPGEN], 1u);
            else XB_SPIN(xb_ld(&bar[XB_TOPGEN]) == tg, bar);
            __builtin_amdgcn_fence(__ATOMIC_ACQUIRE, "agent");
            xb_add(&bar[XB_XGEN(b.x)], 1u);
            asm volatile("s_waitcnt vmcnt(0)" ::: "memory");
        } else {
            XB_SPIN(xb_ld(&bar[XB_XGEN(b.x)]) == gen, bar);
            __builtin_amdgcn_fence(__ATOMIC_ACQUIRE, "agent");
            asm volatile("s_waitcnt vmcnt(0)" ::: "memory");
        }
    }
    __syncthreads();
}

constexpr int NSTEP = 9;
constexpr int N_PHASES = 1 + NSTEP * NLAYER;
__global__ void __launch_bounds__(512, 2) mega(Args args) {
    extern __shared__ __attribute__((aligned(16))) unsigned char shm[];
    cg::grid_group grid = cg::this_grid();
    LAS unsigned char* lds3 = (LAS unsigned char*)shm;
    float* ldsf = (float*)shm;
    const int ph_lo = args.ph_lo, ph_hi = args.ph_hi;
    volatile LAS unsigned* xst = (volatile LAS unsigned*)(lds3 + 131072);
    if (threadIdx.x == 0) { xst[0] = 0u; xst[1] = 0u; }
    __syncthreads();
    if (ph_hi - ph_lo > 1 && threadIdx.x == 0) (void)xb_add(&((unsigned*)(args.ws + WS_BAR))[XB_XCNT(xb_xcc_id())], 1u);
    for (int ph = ph_lo; ph < ph_hi; ++ph) {
        kargp_t kp = (kargp_t)__builtin_amdgcn_kernarg_segment_ptr();
        asm volatile("" : "+s"(kp));
        KA a; a.p = kp;
        bool need_sync = true;
        if (ph == 0) {
            if (HAS(0)) phase_prep(a, shm);
        } else {
            const int L = (ph - 1) / NSTEP, st = (ph - 1) % NSTEP, kind = L % 3, j = L / 3;
            if ((st == 0 || st == 7) && HAS(1)) {
                pg8::Gemm g; pg8::EpiBf16 E; g.M = MTOK; g.A = (const bf16_t*)(a.ws() + WS_X);
                if (st == 0) { g.N = NH; g.K = (kind == 1) ? 2048 : 1024;
                    g.Bt = (const bf16_t*)(a.ws() + (kind == 0 ? (j == 0 ? WS_W_DN0 : WS_W_DN1) : (kind == 1 ? WS_W_RW : WS_W_ML)));
                    E.O = (bf16_t*)(a.ws() + WS_H); E.ldc = NH; E.act = 0; }
                else { g.N = DM; g.K = DM; g.Bt = (const bf16_t*)(a.ws() + WS_W_GATE + (size_t)L * 2 * MiB);
                    E.O = (bf16_t*)(a.ws() + WS_H + 192 * MiB); E.ldc = DM; E.act = 1; }
                pg8::StaticOrder S; S.init(g.M, g.N, (int)gridDim.x, lbid());
                pg8::gemm_phase(lds3, g, S, E);
            } else if (st == 6 && HAS(1)) {
                pg8::Gemm g; pg8::EpiBf16 E; g.M = MTOK; g.A = (const bf16_t*)(a.ws() + WS_P); g.N = DM; g.K = DPLE; g.Bt = (const bf16_t*)(a.ws() + WS_W_PROJ + (size_t)L * (MiB / 2));
                E.O = (bf16_t*)(a.ws() + WS_H + 128 * MiB); E.ldc = DM; E.act = 0; need_sync = false;
                pg8::StaticOrder S; S.init(g.M, g.N, (int)gridDim.x, lbid());
                pg8::gemm_phase(lds3, g, S, E);
            } else if (st == 4 && HAS(6)) {
                pg8::Gemm g; pg8::EpiBf16 E; g.M = MTOK; g.N = DM; g.K = DM;
                g.A = (const bf16_t*)(a.ws() + WS_X + (kind == 0 ? 0 : 64 * MiB)); g.Bt = (const bf16_t*)(a.ws() + WS_W_OUT + (size_t)L * 2 * MiB);
                E.O = (bf16_t*)(a.ws() + WS_H); E.ldc = DM; E.act = 0;
                pg8::StaticOrder S; S.init(g.M, g.N, (int)gridDim.x, lbid());
                pg8::gemm_phase(lds3, g, S, E);
            } else if (st == 1) {
                if (kind == 0) { if (HAS(2) && HAS(10)) phase_dn_prep2(a, j, shm); } else need_sync = false;
            } else if (st == 2) {
                if (kind == 0) { if (HAS(2) && HAS(11)) phase_dn_chunk2(a, j, shm); } else if (kind == 1) { if (HAS(3)) phase_rw_scan3(a, shm); } else { if (HAS(4)) phase_ml_chunk(a, shm); }
            } else if (st == 3) {
                if (HAS(5)) { if (kind == 0) phase_dn_post(a, j); else if (kind == 1) phase_rw_post(a); else phase_ml_post(a); }
            } else if (st == 5) {
                if (HAS(7)) phase_ln(a, L);
            } else if (st == 8) {
                if (HAS(9)) phase_combine(a, L);
            }
        }
        if (need_sync && ph + 1 < ph_hi) {
            if (ph == 0) grid.sync();
            else { XcdBarrier xb; xb.bar = (unsigned*)(a.ws() + WS_BAR); xb.x = xb_xcc_id(); xb.st = xst; xcd_barrier(xb); }
        }
    }
}

extern "C" void kernel_launch(void* const* d_in, const int* in_sizes, int n_in, void* d_out, int out_size, void* d_ws, size_t ws_size, hipStream_t stream) {
    static int grid = 0;
    if (grid == 0) {
        if (n_in != 31 || out_size != MTOK * DM || ws_size < WS_END) { fprintf(stderr, "kernel_launch: unexpected shapes (n_in %d out %d ws %zu need %zu)\n", n_in, out_size, ws_size, (size_t)WS_END); grid = -1; return; }
        int dev = 0, cus = 0, per_cu = 0;
        (void)hipGetDevice(&dev); (void)hipDeviceGetAttribute(&cus, hipDeviceAttributeMultiprocessorCount, dev);
        if (hipFuncSetAttribute((const void*)mega, hipFuncAttributeMaxDynamicSharedMemorySize, LDS_BYTES) != hipSuccess) { fprintf(stderr, "kernel_launch: hipFuncSetAttribute failed\n"); grid = -1; return; }
        if (hipOccupancyMaxActiveBlocksPerMultiprocessor(&per_cu, (const void*)mega, NTHR, LDS_BYTES) != hipSuccess || per_cu < 1) { fprintf(stderr, "kernel_launch: occupancy query says %d blocks/CU\n", per_cu); per_cu = 1; }
        (void)hipGetLastError();
        grid = cus;
        if (grid <= 0) grid = 256;
    }
    if (grid < 0) return;
    (void)hipMemsetAsync((char*)d_ws + WS_BAR, 0, XCD_BAR_WORDS * sizeof(unsigned), stream);
    Args a{};
    for (int i = 0; i < 31; ++i) a.in[i] = (const float*)d_in[i];
    a.out = (float*)d_out; a.ws = (unsigned char*)d_ws;
#if MULTI_LAUNCH
    for (int ph = 0; ph < N_PHASES; ++ph) { a.ph_lo = ph; a.ph_hi = ph + 1; hipLaunchKernelGGL(mega, dim3(grid), dim3(NTHR), LDS_BYTES, stream, a); }
#else
    a.ph_lo = 0; a.ph_hi = N_PHASES;
    void* kargs[] = {&a};
    hipError_t e = hipLaunchCooperativeKernel((const void*)mega, dim3(grid), dim3(NTHR), kargs, LDS_BYTES, stream);
    if (e != hipSuccess) fprintf(stderr, "cooperative launch failed: %s (grid %d)\n", hipGetErrorString(e), grid);
#endif
}
```

```cpp
#include <hip/hip_runtime.h>
#include <hip/hip_cooperative_groups.h>
#include <cstdio>
#include <cstddef>
namespace cg = cooperative_groups;

#ifndef PHMASK
#define PHMASK 0xFFFF
#endif
#ifndef SOLVE_N
#define SOLVE_N 64
#endif
#define HAS(b) ((PHMASK >> (b)) & 1)
#ifndef MULTI_LAUNCH
#define MULTI_LAUNCH 0
#endif

#define LAS __attribute__((address_space(3)))
typedef unsigned short bf16_t;
typedef short bf16x8 __attribute__((ext_vector_type(8)));
typedef float f32x4 __attribute__((ext_vector_type(4)));
typedef unsigned u32x4 __attribute__((ext_vector_type(4)));
typedef unsigned u32x2 __attribute__((ext_vector_type(2)));

constexpr int MTOK = 32768, DM = 1024, SEQ = 4096, NB = 8, NLAYER = 4, DPLE = 256;
constexpr int NH = 4352;
constexpr float ALPHA = 1.681792830507429f;
constexpr int NTHR = 512;
constexpr int LDS_BYTES = 131072 + 16;

constexpr size_t MiB = 1048576;
constexpr size_t WS_X = 0;
constexpr size_t WS_H = 128 * MiB;
constexpr size_t WS_W = 400 * MiB;
constexpr size_t W_IN_BYTES = (size_t)NH * 1024 * 2;
constexpr size_t WS_W_DN0 = WS_W;
constexpr size_t WS_W_DN1 = WS_W_DN0 + W_IN_BYTES;
constexpr size_t WS_W_RW = WS_W_DN1 + W_IN_BYTES;
constexpr size_t WS_W_ML = WS_W_RW + 2 * W_IN_BYTES;
constexpr size_t WS_W_OUT = WS_W_ML + W_IN_BYTES;
constexpr size_t WS_W_GATE = WS_W_OUT + 4 * 2 * MiB;
constexpr size_t WS_W_PROJ = WS_W_GATE + 4 * 2 * MiB;
constexpr size_t WS_P = WS_W_PROJ + 2 * MiB;
constexpr size_t WS_BONUS = WS_P + 16 * MiB;
constexpr size_t WS_BAR = WS_BONUS + 2 * MiB;
constexpr size_t WS_END = WS_BAR + 65536;

struct Args { const float* in[31]; float* out; unsigned char* ws; int ph_lo, ph_hi; };
#define AS4 __attribute__((address_space(4)))
typedef const AS4 unsigned char* kargp_t;
struct KA { kargp_t p;
    __device__ __forceinline__ const float* in(int i) const { return *(const float* const AS4*)(p + 8 * i); }
    __device__ __forceinline__ float* out() const { return *(float* const AS4*)(p + 248); }
    __device__ __forceinline__ unsigned char* ws() const { return *(unsigned char* const AS4*)(p + 256); }
};
static_assert(offsetof(Args, out) == 248 && offsetof(Args, ws) == 256, "kernarg layout");

__device__ __forceinline__ int ltid() { int t = (int)threadIdx.x; asm volatile("" : "+v"(t)); return t; }
__device__ __forceinline__ int lbid() { int t = (int)blockIdx.x; asm volatile("" : "+s"(t)); return t; }
__device__ __forceinline__ float bf2f(bf16_t b) { return __uint_as_float(((unsigned)b) << 16); }
__device__ __forceinline__ float bflo(unsigned u) { return __uint_as_float(u << 16); }
__device__ __forceinline__ float bfhi(unsigned u) { return __uint_as_float(u & 0xffff0000u); }
typedef float f32x2_ __attribute__((ext_vector_type(2)));
typedef __bf16 bf16x2_ __attribute__((ext_vector_type(2)));
__device__ __forceinline__ unsigned pk_bf16(float lo, float hi) { const f32x2_ v = {lo, hi}; return __builtin_bit_cast(unsigned, __builtin_convertvector(v, bf16x2_)); }
__device__ __forceinline__ float sigmoidf_(float x) { return __builtin_amdgcn_rcpf(1.0f + __expf(-x)); }
__device__ __forceinline__ float siluf_(float x) { return x * __builtin_amdgcn_rcpf(1.0f + __expf(-x)); }
__device__ __forceinline__ float softplusf_(float x) { return x > 20.f ? x : log1pf(__expf(x)); }
template <int CTRL> __device__ __forceinline__ float dppf(float x) { return __builtin_bit_cast(float, __builtin_amdgcn_mov_dpp(__builtin_bit_cast(int, x), CTRL, 0xf, 0xf, true)); }
__device__ __forceinline__ float row16_sum(float v) { v += dppf<0xB1>(v); v += dppf<0x4E>(v); v += dppf<0x124>(v); v += dppf<0x128>(v); return v; }
__device__ __forceinline__ float row8_sum(float v) { v += dppf<0xB1>(v); v += dppf<0x4E>(v); v += dppf<0x141>(v); return v; }
__device__ __forceinline__ float quad_sum(float v) { v += dppf<0xB1>(v); v += dppf<0x4E>(v); return v; }
__device__ __forceinline__ float wave_sum(float v) { v = row16_sum(v); v += __shfl_xor(v, 16, 64); v += __shfl_xor(v, 32, 64); return v; }
template <class T> __device__ __forceinline__ T ntl(const T* p) { return __builtin_nontemporal_load(p); }
template <class T> __device__ __forceinline__ void nts(T* p, T v) { __builtin_nontemporal_store(v, p); }
template <int CTRL, int RM> __device__ __forceinline__ float dpp_old(float oldv, float x) { return __builtin_bit_cast(float, __builtin_amdgcn_update_dpp(__builtin_bit_cast(int, oldv), __builtin_bit_cast(int, x), CTRL, RM, 0xf, false)); }
__device__ __forceinline__ float wave_scan_add(float v) {
    v += dpp_old<0x111, 0xf>(0.f, v); v += dpp_old<0x112, 0xf>(0.f, v); v += dpp_old<0x114, 0xf>(0.f, v); v += dpp_old<0x118, 0xf>(0.f, v);
    v += dpp_old<0x142, 0xa>(0.f, v); v += dpp_old<0x143, 0xc>(0.f, v); return v; }
__device__ __forceinline__ float wave_scan_max(float v) {
    const float ninf = -__builtin_inff();
    v = fmaxf(v, dpp_old<0x111, 0xf>(ninf, v)); v = fmaxf(v, dpp_old<0x112, 0xf>(ninf, v)); v = fmaxf(v, dpp_old<0x114, 0xf>(ninf, v)); v = fmaxf(v, dpp_old<0x118, 0xf>(ninf, v));
    v = fmaxf(v, dpp_old<0x142, 0xa>(ninf, v)); v = fmaxf(v, dpp_old<0x143, 0xc>(ninf, v)); return v; }
__device__ __forceinline__ void unpack8(const u32x4 r, float (&f)[8]) {
    f[0] = bflo(r.x); f[1] = bfhi(r.x); f[2] = bflo(r.y); f[3] = bfhi(r.y); f[4] = bflo(r.z); f[5] = bfhi(r.z); f[6] = bflo(r.w); f[7] = bfhi(r.w);
}

__device__ __forceinline__ bf16x8 ldfrag(const bf16_t* base, int ld, int r0, int k0, int lane) { return *(const bf16x8*)(base + (r0 + (lane & 15)) * ld + k0 + (lane >> 4) * 8); }
#define MFMA16(a, b, c) __builtin_amdgcn_mfma_f32_16x16x32_bf16(a, b, c, 0, 0, 0)
__device__ __forceinline__ bf16_t f2bf1(float x) { return (bf16_t)(pk_bf16(x, x) & 0xffffu); }

namespace pg8 {
constexpr int BM = 256, BK = 64, HALF = 128, HTB = HALF * BK * 2, STAGE_BYTES = 8 * HTB, NXCD = 8, WGM = 8;
__host__ __device__ __forceinline__ int lds_byte(int r, int c) { const int st = (r >> 4) * 2 + (c >> 5), rr = r & 15, cc = c & 31, ob = rr * 64 + cc * 2; return st * 1024 + (ob ^ (((ob >> 9) & 1) << 5)); }
__host__ __device__ __forceinline__ void stage_rc(int b, int& R, int& C) { const int st = b / 1024, sb = b % 1024, swz = sb ^ (((sb >> 9) & 1) << 5); R = (st >> 1) * 16 + swz / 64; C = (st & 1) * 32 + (swz % 64) / 2; }
__host__ __device__ __forceinline__ int perm32(int rho) { const int n = rho >> 4, i = rho & 15; return 8 * (i >> 2) + 4 * n + (i & 3); }
struct Unit { int pm, pn; };
struct Gemm { const bf16_t* A; const bf16_t* Bt; int M, N, K; };
struct StaticOrder {
    int nM, nN, nwg, G, c;
    __device__ void init(int M, int N, int G_, int c_) { nM = M / BM; nN = N / BM; nwg = nM * nN; G = G_; c = c_; }
    __device__ bool next(int i, Unit& u) const {
        const long L = (long)i * G + c; if (L >= nwg) return false;
        int wgid = (int)L; { const int q = nwg / NXCD, r = nwg % NXCD, xcd = wgid % NXCD, off = wgid / NXCD; wgid = (xcd < r ? xcd * (q + 1) : r * (q + 1) + (xcd - r) * q) + off; }
        const int nig = WGM * nN, gid = wgid / nig, fm = gid * WGM, gsz = (nM - fm) < WGM ? (nM - fm) : WGM;
        u.pm = fm + ((wgid % nig) % gsz); u.pn = (wgid % nig) / gsz; return true;
    }
};
struct EpiBf16 {
    static constexpr bool PERM = true;
    bf16_t* O; int ldc; int act;
    __device__ __forceinline__ void operator()(const f32x4 (&acc)[2][2][4][2], const Unit& u, int wr, int wc, int fr, int fq) const {
        const int row0 = u.pm * BM + wr * 64 + fr; const int col0 = u.pn * BM + wc * 32 + 8 * fq;
#pragma unroll
        for (int ai = 0; ai < 2; ++ai)
#pragma unroll
            for (int m = 0; m < 4; ++m) { bf16_t* rowp = O + (size_t)(row0 + ai * HALF + m * 16) * ldc + col0;
#pragma unroll
                for (int bj = 0; bj < 2; ++bj) { f32x4 v0 = acc[ai][bj][m][0], v1 = acc[ai][bj][m][1];
                    if (act) {
#pragma unroll
                        for (int j = 0; j < 4; ++j) { v0[j] = sigmoidf_(v0[j]); v1[j] = sigmoidf_(v1[j]); } }
                    u32x4 w; w.x = pk_bf16(v0[0], v0[1]); w.y = pk_bf16(v0[2], v0[3]); w.z = pk_bf16(v1[0], v1[1]); w.w = pk_bf16(v1[2], v1[3]);
                    __builtin_nontemporal_store(w, (u32x4*)(rowp + bj * HALF)); } }
    }
};
struct EpiF32 {
    static constexpr bool PERM = false;
    float* C; int ldc; const float* R; float rscale;
    __device__ __forceinline__ void operator()(const f32x4 (&acc)[2][2][4][2], const Unit& u, int wr, int wc, int fr, int fq) const {
        const int row0 = u.pm * BM + wr * 64 + fr, col0 = u.pn * BM + wc * 32 + 4 * fq;
#pragma unroll
        for (int ai = 0; ai < 2; ++ai)
#pragma unroll
            for (int m = 0; m < 4; ++m) { const size_t ro = (size_t)(row0 + ai * HALF + m * 16) * ldc + col0;
#pragma unroll
                for (int bj = 0; bj < 2; ++bj)
#pragma unroll
                    for (int n = 0; n < 2; ++n) { f32x4 v = acc[ai][bj][m][n];
                        if (R) { const f32x4 r = *(const f32x4*)(R + ro + bj * HALF + n * 16); v = v + r * rscale; }
                        *(f32x4*)(C + ro + bj * HALF + n * 16) = v; } }
    }
};

template <class Epi>
__device__ __forceinline__ void gemm_phase(LAS unsigned char* lds, const Gemm g, const StaticOrder& S, const Epi& E) {
    const int tid = ltid(), wid = __builtin_amdgcn_readfirstlane(tid >> 6), lane = tid & 63, wr = wid >> 2, wc = wid & 3, fr = lane & 15, fq = lane >> 4;
    const int K = g.K, nt = K / BK;
    unsigned voffA[2], voffB[2];
#pragma unroll
    for (int i = 0; i < 2; ++i) { int R, C; stage_rc(tid * 16 + i * 8192, R, C); const int Rb = Epi::PERM ? ((R & ~31) + perm32(R & 31)) : R;
        voffA[i] = (unsigned)(R * K + C) * 2u; voffB[i] = (unsigned)(Rb * K + C) * 2u; }
    const size_t kstep = (size_t)(BK * 2);
    const size_t hstep = (size_t)HALF * K * 2;
    const size_t tstep = 2 * hstep;
    const unsigned ldsw = (unsigned)wid * 1024u;
    const int aoff = lds_byte(wr * 64 + fr, fq * 8), boff = lds_byte(wc * 32 + fr, fq * 8);
#define PG8_SA(b, h) (((b) * 2 + (h)) * HTB)
#define PG8_SB(b, h) ((4 + (b) * 2 + (h)) * HTB)
#define PG8_STAGE(bufoff, gbase, voff) do { _Pragma("unroll") for (int _i = 0; _i < 2; ++_i) \
        __builtin_amdgcn_global_load_lds((const unsigned*)((const char*)(gbase) + (voff)[_i]), (LAS unsigned*)(lds + (bufoff) + ldsw + _i * 8192), 16, 0, 0); } while (0)
#define PG8_LDA(dst, b, h) do { _Pragma("unroll") for (int m = 0; m < 4; ++m) _Pragma("unroll") for (int k = 0; k < 2; ++k) dst[m][k] = *(const LAS bf16x8*)(lds + PG8_SA(b, h) + aoff + m * 2048 + k * 1024); } while (0)
#define PG8_LDB(dst, b, h) do { _Pragma("unroll") for (int n = 0; n < 2; ++n) _Pragma("unroll") for (int k = 0; k < 2; ++k) dst[n][k] = *(const LAS bf16x8*)(lds + PG8_SB(b, h) + boff + n * 2048 + k * 1024); } while (0)
#define PG8_MMA(ai, bj, At, Bt) do { __builtin_amdgcn_s_setprio(1); _Pragma("unroll") for (int m = 0; m < 4; ++m) _Pragma("unroll") for (int n = 0; n < 2; ++n) _Pragma("unroll") for (int k = 0; k < 2; ++k) \
        acc[ai][bj][m][n] = __builtin_amdgcn_mfma_f32_16x16x32_bf16(Bt[n][k], At[m][k], acc[ai][bj][m][n], 0, 0, 0); __builtin_amdgcn_s_setprio(0); } while (0)
#define PG8_WAIT_V(n) asm volatile("s_waitcnt vmcnt(" #n ")" ::: "memory")
#define PG8_WAIT_L(n) asm volatile("s_waitcnt lgkmcnt(" #n ")" ::: "memory")
#define PG8_BAR __builtin_amdgcn_s_barrier()
#define PG8_SCHED __builtin_amdgcn_sched_barrier(0)
    Unit cur, nxt; int ui = 0;
    if (!S.next(0, cur)) return;
    f32x4 acc[2][2][4][2];
#pragma unroll
    for (int a = 0; a < 2; ++a)
#pragma unroll
        for (int b = 0; b < 2; ++b)
#pragma unroll
            for (int m = 0; m < 4; ++m)
#pragma unroll
                for (int n = 0; n < 2; ++n) acc[a][b][m][n] = (f32x4){0.f, 0.f, 0.f, 0.f};
    bf16x8 At[4][2], B0[2][2], B1[2][2];
    const char* cA = (const char*)g.A + (size_t)cur.pm * tstep; const char* cB = (const char*)g.Bt + (size_t)cur.pn * tstep;
    PG8_STAGE(PG8_SB(0, 0), cB, voffB); PG8_STAGE(PG8_SA(0, 0), cA, voffA); PG8_STAGE(PG8_SB(0, 1), cB + hstep, voffB); PG8_STAGE(PG8_SA(0, 1), cA + hstep, voffA);
    if (wr == 1) PG8_BAR;
    PG8_WAIT_V(4); PG8_BAR;
    PG8_STAGE(PG8_SB(1, 0), cB + kstep, voffB); PG8_STAGE(PG8_SA(1, 0), cA + kstep, voffA); PG8_STAGE(PG8_SB(1, 1), cB + hstep + kstep, voffB);
    PG8_WAIT_V(6); PG8_BAR;
    for (;;) {
        const bool has_next = S.next(ui + 1, nxt);
        const char* nA = has_next ? (const char*)g.A + (size_t)nxt.pm * tstep : cA; const char* nB = has_next ? (const char*)g.Bt + (size_t)nxt.pn * tstep : cB;
        for (int t = 0; t < nt; t += 2) {
            const bool last = (t == nt - 2);
            const char* a1 = cA + (size_t)(t + 1) * kstep;
            const char* a2 = last ? nA : cA + (size_t)(t + 2) * kstep; const char* b2 = last ? nB : cB + (size_t)(t + 2) * kstep;
            const char* a3 = a2 + kstep; const char* b3 = b2 + kstep;
            PG8_LDB(B0, 0, 0); PG8_SCHED; PG8_LDA(At, 0, 0); PG8_STAGE(PG8_SA(1, 1), a1 + hstep, voffA);
            PG8_WAIT_L(8); PG8_BAR; PG8_WAIT_L(0); PG8_MMA(0, 0, At, B0); PG8_BAR; PG8_SCHED;
            PG8_LDB(B1, 0, 1); PG8_STAGE(PG8_SB(0, 0), b2, voffB);
            PG8_BAR; PG8_WAIT_L(0); PG8_MMA(0, 1, At, B1); PG8_BAR;
            PG8_LDA(At, 0, 1); PG8_STAGE(PG8_SA(0, 0), a2, voffA);
            PG8_BAR; PG8_WAIT_L(0); PG8_MMA(1, 0, At, B0); PG8_BAR; PG8_SCHED;
            PG8_STAGE(PG8_SB(0, 1), b2 + hstep, voffB);
            PG8_WAIT_V(6); PG8_BAR; PG8_MMA(1, 1, At, B1); PG8_BAR;
            PG8_LDB(B0, 1, 0); PG8_SCHED; PG8_LDA(At, 1, 0); PG8_STAGE(PG8_SA(0, 1), a2 + hstep, voffA);
            PG8_WAIT_L(8); PG8_BAR; PG8_WAIT_L(0); PG8_MMA(0, 0, At, B0); PG8_BAR; PG8_SCHED;
            PG8_LDB(B1, 1, 1); PG8_STAGE(PG8_SB(1, 0), b3, voffB);
            PG8_BAR; PG8_WAIT_L(0); PG8_MMA(0, 1, At, B1); PG8_BAR;
            PG8_LDA(At, 1, 1); PG8_STAGE(PG8_SA(1, 0), a3, voffA);
            PG8_BAR; PG8_WAIT_L(0); PG8_MMA(1, 0, At, B0); PG8_BAR; PG8_SCHED;
            PG8_STAGE(PG8_SB(1, 1), b3 + hstep, voffB);
            PG8_WAIT_V(6); PG8_BAR; PG8_MMA(1, 1, At, B1); PG8_BAR;
        }
        E(acc, cur, wr, wc, fr, fq);
        if (!has_next) break;
#pragma unroll
        for (int a = 0; a < 2; ++a)
#pragma unroll
            for (int b = 0; b < 2; ++b)
#pragma unroll
                for (int m = 0; m < 4; ++m)
#pragma unroll
                    for (int n = 0; n < 2; ++n) acc[a][b][m][n] = (f32x4){0.f, 0.f, 0.f, 0.f};
        cur = nxt; cA = nA; cB = nB; ++ui;
    }
    PG8_WAIT_V(0);
    if (wr == 0) PG8_BAR;
    PG8_BAR;
#undef PG8_SA
#undef PG8_SB
#undef PG8_STAGE
#undef PG8_LDA
#undef PG8_LDB
#undef PG8_MMA
#undef PG8_WAIT_V
#undef PG8_WAIT_L
#undef PG8_BAR
#undef PG8_SCHED
}
}

struct Seg { int in_idx, src_off, ldsrc, scol0, len, K, dst_off, ldk, koff, n0, mumode, mu_off; };
#define OFFW(x) ((int)((x) - WS_W))
__constant__ Seg g_segs[] = {
    {7, 0, 4112, 0, 4112, 1024, OFFW(WS_W_DN0), 1024, 0, 0, 0, 0}, {7, 0, 0, 0, 240, 1024, OFFW(WS_W_DN0), 1024, 0, 4112, 3, 0},
    {7, 1024 * 4112, 4112, 0, 4112, 1024, OFFW(WS_W_DN1), 1024, 0, 0, 0, 0}, {7, 0, 0, 0, 240, 1024, OFFW(WS_W_DN1), 1024, 0, 4112, 3, 0},
    {25, 0, 4112, 0, 4112, 1024, OFFW(WS_W_ML), 1024, 0, 0, 0, 0}, {25, 0, 0, 0, 240, 1024, OFFW(WS_W_ML), 1024, 0, 4112, 3, 0},
    {13, 0, 4224, 0, 1024, 1024, OFFW(WS_W_RW), 2048, 0, 0, 1, 0 * 1024}, {13, 0, 4224, 0, 1024, 1024, OFFW(WS_W_RW), 2048, 1024, 0, 2, 0 * 1024},
    {13, 0, 4224, 1088, 1024, 1024, OFFW(WS_W_RW), 2048, 0, 1024, 1, 2 * 1024}, {13, 0, 4224, 1088, 1024, 1024, OFFW(WS_W_RW), 2048, 1024, 1024, 2, 2 * 1024},
    {13, 0, 4224, 2112, 1024, 1024, OFFW(WS_W_RW), 2048, 0, 2048, 1, 3 * 1024}, {13, 0, 4224, 2112, 1024, 1024, OFFW(WS_W_RW), 2048, 1024, 2048, 2, 3 * 1024},
    {13, 0, 4224, 3200, 1024, 1024, OFFW(WS_W_RW), 2048, 0, 3072, 1, 5 * 1024}, {13, 0, 4224, 3200, 1024, 1024, OFFW(WS_W_RW), 2048, 1024, 3072, 2, 5 * 1024},
    {13, 0, 4224, 1024, 64, 1024, OFFW(WS_W_RW), 2048, 0, 4096, 1, 1 * 1024}, {13, 0, 4224, 1024, 64, 1024, OFFW(WS_W_RW), 2048, 1024, 4096, 2, 1 * 1024},
    {13, 0, 4224, 3136, 64, 1024, OFFW(WS_W_RW), 2048, 0, 4160, 1, 4 * 1024}, {13, 0, 4224, 3136, 64, 1024, OFFW(WS_W_RW), 2048, 1024, 4160, 2, 4 * 1024},
    {13, 0, 0, 0, 128, 2048, OFFW(WS_W_RW), 2048, 0, 4224, 3, 0},
    {12, 0, 1024, 0, 1024, 1024, OFFW(WS_W_OUT + 0 * 2 * MiB), 1024, 0, 0, 0, 0}, {24, 0, 1024, 0, 1024, 1024, OFFW(WS_W_OUT + 1 * 2 * MiB), 1024, 0, 0, 0, 0},
    {30, 0, 1024, 0, 1024, 1024, OFFW(WS_W_OUT + 2 * 2 * MiB), 1024, 0, 0, 0, 0}, {12, 1024 * 1024, 1024, 0, 1024, 1024, OFFW(WS_W_OUT + 3 * 2 * MiB), 1024, 0, 0, 0, 0},
    {6, 0 * 1024 * 1024, 1024, 0, 1024, 1024, OFFW(WS_W_GATE + 0 * 2 * MiB), 1024, 0, 0, 0, 0}, {6, 1 * 1024 * 1024, 1024, 0, 1024, 1024, OFFW(WS_W_GATE + 1 * 2 * MiB), 1024, 0, 0, 0, 0},
    {6, 2 * 1024 * 1024, 1024, 0, 1024, 1024, OFFW(WS_W_GATE + 2 * 2 * MiB), 1024, 0, 0, 0, 0}, {6, 3 * 1024 * 1024, 1024, 0, 1024, 1024, OFFW(WS_W_GATE + 3 * 2 * MiB), 1024, 0, 0, 0, 0},
    {4, 0 * 256 * 1024, 1024, 0, 1024, 256, OFFW(WS_W_PROJ + 0 * (MiB / 2)), 256, 0, 0, 0, 0}, {4, 1 * 256 * 1024, 1024, 0, 1024, 256, OFFW(WS_W_PROJ + 1 * (MiB / 2)), 256, 0, 0, 0, 0},
    {4, 2 * 256 * 1024, 1024, 0, 1024, 256, OFFW(WS_W_PROJ + 2 * (MiB / 2)), 256, 0, 0, 0, 0}, {4, 3 * 256 * 1024, 1024, 0, 1024, 256, OFFW(WS_W_PROJ + 3 * (MiB / 2)), 256, 0, 0, 0, 0},
};
constexpr int N_SEGS = 6 + 13 + 4 + 4 + 4;

__device__ __forceinline__ void phase_prep(const KA a, unsigned char* lds_) {
    const size_t gtid = (size_t)lbid() * NTHR + ltid(), gsz = (size_t)gridDim.x * NTHR;
    { const float* x = a.in(0); bf16_t* xb = (bf16_t*)(a.ws() + WS_X);
      const size_t n8 = (size_t)MTOK * DM / 8;
      for (size_t i = gtid; i < n8; i += 4 * gsz) {
          f32x4 v0[4], v1[4];
#pragma unroll
          for (int q = 0; q < 4; ++q) { const size_t ii = i + q * gsz; if (ii < n8) { v0[q] = ntl((const f32x4*)(x + ii * 8)); v1[q] = ntl((const f32x4*)(x + ii * 8 + 4)); } }
#pragma unroll
          for (int q = 0; q < 4; ++q) { const size_t ii = i + q * gsz; if (ii < n8) {
              u32x4 w; w.x = pk_bf16(v0[q][0], v0[q][1]); w.y = pk_bf16(v0[q][2], v0[q][3]); w.z = pk_bf16(v1[q][0], v1[q][1]); w.w = pk_bf16(v1[q][2], v1[q][3]); *(u32x4*)(xb + ii * 8) = w; } } } }
    bf16_t* tl = (bf16_t*)lds_;
    const int tid = ltid(), G = (int)gridDim.x;
    const int lk = tid >> 3, ln8 = (tid & 7) * 8;
#define PREP_NT(SG) ((((SG).len + 63) >> 6) * ((SG).K >> 6))
    int cs = 0, ct = lbid(), cnt = PREP_NT(g_segs[0]);
    while (cs < N_SEGS && ct >= cnt) { ct -= cnt; ++cs; if (cs < N_SEGS) cnt = PREP_NT(g_segs[cs]); }
    f32x4 r0 = {0.f, 0.f, 0.f, 0.f}, r1 = r0; float rsc = 1.f;
#define PREP_LOAD(S_, T_) do { const Seg q = g_segs[S_]; const int ntn = (q.len + 63) >> 6, tn = (T_) % ntn, tk = (T_) / ntn; const int k = tk * 64 + lk, n = tn * 64 + ln8; \
        r0 = (f32x4){0.f, 0.f, 0.f, 0.f}; r1 = r0; rsc = 1.f; \
        if (q.mumode != 3 && n < q.len) { const float* sp = a.in(q.in_idx) + q.src_off + (size_t)k * q.ldsrc + q.scol0 + n; r0 = *(const f32x4*)sp; r1 = *(const f32x4*)(sp + 4); \
            if (q.mumode == 1) rsc = 1.0f - a.in(14)[q.mu_off + k]; else if (q.mumode == 2) rsc = a.in(14)[q.mu_off + k]; } } while (0)
    if (cs < N_SEGS) PREP_LOAD(cs, ct);
    int buf = 0;
    while (cs < N_SEGS) {
        int ns = cs, nt = ct + G, nnt = cnt;
        while (ns < N_SEGS && nt >= nnt) { nt -= nnt; ++ns; if (ns < N_SEGS) nnt = PREP_NT(g_segs[ns]); }
        bf16_t* tb = tl + buf * (64 * 72);
        { const f32x4 v0 = r0 * rsc, v1 = r1 * rsc;
          tb[(ln8 + 0) * 72 + lk] = f2bf1(v0[0]); tb[(ln8 + 1) * 72 + lk] = f2bf1(v0[1]); tb[(ln8 + 2) * 72 + lk] = f2bf1(v0[2]); tb[(ln8 + 3) * 72 + lk] = f2bf1(v0[3]);
          tb[(ln8 + 4) * 72 + lk] = f2bf1(v1[0]); tb[(ln8 + 5) * 72 + lk] = f2bf1(v1[1]); tb[(ln8 + 6) * 72 + lk] = f2bf1(v1[2]); tb[(ln8 + 7) * 72 + lk] = f2bf1(v1[3]); }
        const Seg cq = g_segs[cs]; const int cntn = (cq.len + 63) >> 6, ctn = ct % cntn, ctk = ct / cntn;
        if (ns < N_SEGS) PREP_LOAD(ns, nt);
        __syncthreads();
        { const int n = ctn * 64 + (tid >> 3), kp = (tid & 7) * 8;
          if (n < cq.len) *(u32x4*)((bf16_t*)(a.ws() + WS_W + (size_t)cq.dst_off) + (size_t)(cq.n0 + n) * cq.ldk + cq.koff + ctk * 64 + kp) = *(const u32x4*)(tb + (tid >> 3) * 72 + kp); }
        buf ^= 1; cs = ns; ct = nt; cnt = nnt;
    }
#undef PREP_LOAD
#undef PREP_NT
}

template <int NC, int TC, int FN  >
__device__ __forceinline__ void cols_load(const bf16_t* __restrict__ h, size_t row0, int col0, float* dst, int dstride, int vt) {
    constexpr int NV = NC / 8, NITEM = NV * TC;
    for (int it = vt; it < NITEM; it += NTHR) {
        const int vc = it % NV, t = it / NV, c = vc * 8;
        const u32x4 r = *(const u32x4*)(h + (row0 + t) * NH + col0 + c);
        float f[8]; unpack8(r, f);
        float* d = dst + (size_t)t * dstride + c;
#pragma unroll
        for (int e = 0; e < 8; ++e) d[e] = FN == 1 ? tanhf(f[e]) : f[e];
    }
}
__device__ __forceinline__ int vtid(int shift) { return (int)((ltid() + NTHR - shift) & (NTHR - 1)); }

__device__ __forceinline__ void phase_dn_post(const KA a, int j) {
    const bf16_t* h = (const bf16_t*)(a.ws() + WS_H);
    const bf16_t* O = (const bf16_t*)(a.ws() + WS_X + 64 * MiB);
    bf16_t* Y = (bf16_t*)(a.ws() + WS_X);
#define DNO(R) (O + ((size_t)((((R) >> 12) * 8 + (lane >> 3)) * 64 + (((R) & 4095) >> 6)) * 8192 + ((R) & 63) * 128 + (lane & 7) * 16))
    const int lane = ltid() & 63, wid = ltid() >> 6;
    const float* nw = a.in(11) + j * 128 + (lane & 7) * 16;
    float w[16];
#pragma unroll
    for (int e = 0; e < 16; ++e) w[e] = nw[e];
    const int stride = (int)gridDim.x * 8;
    int row = lbid() * 8 + wid;
    u32x4 no0, no1, nz0, nz1;
    if (row < MTOK) { no0 = ntl((const u32x4*)DNO(row)); no1 = ntl((const u32x4*)(DNO(row) + 8));
        nz0 = ntl((const u32x4*)(h + (size_t)row * NH + 3072 + lane * 16)); nz1 = ntl((const u32x4*)(h + (size_t)row * NH + 3072 + lane * 16 + 8)); }
    for (; row < MTOK; row += stride) {
        float o[16], z[16];
        unpack8(no0, *(float(*)[8])&o[0]); unpack8(no1, *(float(*)[8])&o[8]); unpack8(nz0, *(float(*)[8])&z[0]); unpack8(nz1, *(float(*)[8])&z[8]);
        const int nr = row + stride;
        if (nr < MTOK) { no0 = ntl((const u32x4*)DNO(nr)); no1 = ntl((const u32x4*)(DNO(nr) + 8));
            nz0 = ntl((const u32x4*)(h + (size_t)nr * NH + 3072 + lane * 16)); nz1 = ntl((const u32x4*)(h + (size_t)nr * NH + 3072 + lane * 16 + 8)); }
        float ss = 0.f;
#pragma unroll
        for (int e = 0; e < 16; ++e) ss += o[e] * o[e];
        ss = row8_sum(ss);
        const float sc = rsqrtf(ss * (1.0f / 128.0f) + 1e-6f);
        float y[16];
#pragma unroll
        for (int e = 0; e < 16; ++e) y[e] = o[e] * sc * w[e] * siluf_(z[e]);
        u32x4 w0, w1; w0.x = pk_bf16(y[0], y[1]); w0.y = pk_bf16(y[2], y[3]); w0.z = pk_bf16(y[4], y[5]); w0.w = pk_bf16(y[6], y[7]);
        w1.x = pk_bf16(y[8], y[9]); w1.y = pk_bf16(y[10], y[11]); w1.z = pk_bf16(y[12], y[13]); w1.w = pk_bf16(y[14], y[15]);
        *(u32x4*)(Y + (size_t)row * DM + lane * 16) = w0; *(u32x4*)(Y + (size_t)row * DM + lane * 16 + 8) = w1;
    }
#undef DNO
}

__device__ __forceinline__ float tanh_fast(float x) { const float e = __expf(2.0f * x); return 1.0f - 2.0f * __builtin_amdgcn_rcpf(e + 1.0f); }
__device__ __forceinline__ int xcd_unit(int u) { return ((u & 7) << 5) | ((u >> 3) & 31); }
__device__ __forceinline__ void phase_rw_scan3(const KA a, unsigned char* shm_) {
    const bf16_t* h = (const bf16_t*)(a.ws() + WS_H);
    bf16_t* O = (bf16_t*)(a.ws() + WS_X);
    float* bonus = (float*)(a.ws() + WS_BONUS);
    float* osb = (float*)(shm_ + 90112);
    bf16_t* WL = (bf16_t*)(shm_ + 98304); bf16_t* AL = (bf16_t*)(shm_ + 102912); bf16_t* WUPT = (bf16_t*)(shm_ + 107520); bf16_t* AUPT = (bf16_t*)(shm_ + 116736);
    const int tid0 = ltid();
    for (int unit = lbid(); unit < NB * 16 * 2; unit += gridDim.x) {
        const int un_ = (gridDim.x == 256) ? xcd_unit(unit) : unit; const int b = un_ >> 5, hd = (un_ >> 1) & 15, half = un_ & 1;
        const int tid = tid0, wid = tid >> 6, lane = tid & 63, quad = lane >> 4, l15 = lane & 15;
        const bool producer = wid >= 4;
        const int ptid = tid & 255, pw = ptid >> 6;
        __syncthreads();
        for (int i = tid; i < 4096; i += NTHR) { const int jj = i >> 6, c = i & 63;
            WUPT[c * 72 + jj] = f2bf1(a.in(16)[jj * 1024 + hd * 64 + c]); AUPT[c * 72 + jj] = f2bf1(a.in(18)[jj * 1024 + hd * 64 + c]); }
        const int cm = pw * 16 + l15;
        const float w0c = a.in(15)[hd * 64 + cm], a0c = a.in(17)[hd * 64 + cm], kkc = a.in(19)[hd * 64 + cm], kac = a.in(20)[hd * 64 + cm];
        const int rpart = ptid & 7;
        const f32x4 rkA = *(const f32x4*)(a.in(21) + hd * 64 + rpart * 8), rkB = *(const f32x4*)(a.in(21) + hd * 64 + rpart * 8 + 4);
        const int pt = ptid >> 3, pvc = ptid & 7, vt_ = (ptid & 127) >> 2, vvc = ptid & 3;
        const size_t rowb = (size_t)b * SEQ;
        u32x4 p0 = {0u, 0u, 0u, 0u}, p1 = p0, p2 = p0, p3 = p0, p4 = p0;
#define RW3_PREFETCH(CH) do { const size_t rn = rowb + (size_t)(CH) * 32; \
            p0 = *(const u32x4*)(h + (rn + pt) * NH + hd * 64 + pvc * 8); p1 = *(const u32x4*)(h + (rn + pt) * NH + 1024 + hd * 64 + pvc * 8); \
            p2 = *(const u32x4*)(h + (rn + pt) * NH + 4096 + pvc * 8); p3 = *(const u32x4*)(h + (rn + pt) * NH + 4160 + pvc * 8); \
            if (ptid < 128) p4 = *(const u32x4*)(h + (rn + vt_) * NH + 2048 + hd * 64 + half * 32 + vvc * 8); } while (0)
        if (producer) RW3_PREFETCH(0);
        const int crow = (wid & 3) * 8 + (lane >> 3), kq = lane & 7;
        f32x2_ S0 = {0.f, 0.f}, S1 = S0, S2 = S0, S3 = S0;
        for (int c = -1; c < SEQ / 32; ++c) {
            const int cb = c & 1, nb = (c + 1) & 1;
            float* rsC = (float*)(shm_ + cb * 45056); float* dsC = rsC + 2048; float* kpC = rsC + 4096; float* kkC = rsC + 6144; float* kaC = rsC + 8192; float* vsC = rsC + 10240;
            float* rsN = (float*)(shm_ + nb * 45056); float* dsN = rsN + 2048; float* kpN = rsN + 4096; float* kkN = rsN + 6144; float* kaN = rsN + 8192; float* vsN = rsN + 10240;
            float* osC = osb + cb * 1024; float* osP = osb + nb * 1024;
            const bool cact = (c >= 0), pact = (c + 1 < SEQ / 32);
            __syncthreads();
#pragma unroll 1
            for (int seg = 0; seg < 4; ++seg) {
                if (!producer) {
                    if (seg == 0 && c >= 1) {
                        const int t = tid >> 3, c4 = (tid & 7) * 4; const f32x4 v = *(const f32x4*)(osP + t * 32 + c4);
                        u32x2 w; w.x = pk_bf16(v[0], v[1]); w.y = pk_bf16(v[2], v[3]);
                        *(u32x2*)(O + (rowb + (size_t)(c - 1) * 32 + t) * DM + hd * 64 + half * 32 + c4) = w; }
                    if (cact) {
                        float yv[8];
                        f32x4 nkA, nkB, naA, naB, ndA, ndB, npA, npB, nrA, nrB; float nvv;
#define RW3_LD(T) do { const int o_ = (T) * 64 + kq * 8; nkA = *(const f32x4*)(kkC + o_); nkB = *(const f32x4*)(kkC + o_ + 4); naA = *(const f32x4*)(kaC + o_); naB = *(const f32x4*)(kaC + o_ + 4); \
                            ndA = *(const f32x4*)(dsC + o_); ndB = *(const f32x4*)(dsC + o_ + 4); npA = *(const f32x4*)(kpC + o_); npB = *(const f32x4*)(kpC + o_ + 4); \
                            nrA = *(const f32x4*)(rsC + o_); nrB = *(const f32x4*)(rsC + o_ + 4); nvv = vsC[(T) * 32 + crow]; } while (0)
                        RW3_LD(seg * 8);
#pragma unroll
                        for (int tt = 0; tt < 8; ++tt) { const int t = seg * 8 + tt;
                            const f32x4 kkA = nkA, kkB = nkB, kaA = naA, kaB = naB, dA = ndA, dB = ndB, kpA = npA, kpB = npB, rA = nrA, rB = nrB; const float vv = nvv;
                            if (tt < 7) RW3_LD(t + 1);
                            f32x2_ p = S0 * (f32x2_){kkA[0], kkA[1]}; p = S1 * (f32x2_){kkA[2], kkA[3]} + p; p = S2 * (f32x2_){kkB[0], kkB[1]} + p; p = S3 * (f32x2_){kkB[2], kkB[3]} + p;
                            float sa = p[0] + p[1];
                            sa = row8_sum(sa);
                            const f32x2_ sa2 = {sa, sa}, vv2 = {vv, vv};
                            S0 = S0 * (f32x2_){dA[0], dA[1]} + sa2 * (f32x2_){kaA[0], kaA[1]} + vv2 * (f32x2_){kpA[0], kpA[1]};
                            S1 = S1 * (f32x2_){dA[2], dA[3]} + sa2 * (f32x2_){kaA[2], kaA[3]} + vv2 * (f32x2_){kpA[2], kpA[3]};
                            S2 = S2 * (f32x2_){dB[0], dB[1]} + sa2 * (f32x2_){kaB[0], kaB[1]} + vv2 * (f32x2_){kpB[0], kpB[1]};
                            S3 = S3 * (f32x2_){dB[2], dB[3]} + sa2 * (f32x2_){kaB[2], kaB[3]} + vv2 * (f32x2_){kpB[2], kpB[3]};
                            f32x2_ q2 = S0 * (f32x2_){rA[0], rA[1]}; q2 = S1 * (f32x2_){rA[2], rA[3]} + q2; q2 = S2 * (f32x2_){rB[0], rB[1]} + q2; q2 = S3 * (f32x2_){rB[2], rB[3]} + q2;
                            float y = q2[0] + q2[1];
                            y = row8_sum(y);
                            yv[tt] = y;
                        }
#undef RW3_LD
                        if (kq == 0) {
#pragma unroll
                            for (int tt = 0; tt < 8; ++tt) osC[(seg * 8 + tt) * 32 + crow] = yv[tt]; }
                    }
                } else if (pact) {
                    if (seg == 0) {
                        float f[8];
                        unpack8(p0, f); { float* d = rsN + pt * 64 + pvc * 8; *(f32x4*)d = (f32x4){f[0], f[1], f[2], f[3]}; *(f32x4*)(d + 4) = (f32x4){f[4], f[5], f[6], f[7]}; }
                        unpack8(p1, f); { float* d = kpN + pt * 64 + pvc * 8; *(f32x4*)d = (f32x4){f[0], f[1], f[2], f[3]}; *(f32x4*)(d + 4) = (f32x4){f[4], f[5], f[6], f[7]}; }
                        unpack8(p2, f); { u32x4 w; w.x = pk_bf16(tanh_fast(f[0]), tanh_fast(f[1])); w.y = pk_bf16(tanh_fast(f[2]), tanh_fast(f[3]));
                            w.z = pk_bf16(tanh_fast(f[4]), tanh_fast(f[5])); w.w = pk_bf16(tanh_fast(f[6]), tanh_fast(f[7])); *(u32x4*)(WL + pt * 72 + pvc * 8) = w; }
                        *(u32x4*)(AL + pt * 72 + pvc * 8) = p3;
                        if (ptid < 128) { unpack8(p4, f); float* dv = vsN + vt_ * 32 + vvc * 8; *(f32x4*)dv = (f32x4){f[0], f[1], f[2], f[3]}; *(f32x4*)(dv + 4) = (f32x4){f[4], f[5], f[6], f[7]}; }
                        if (c + 2 < SEQ / 32) RW3_PREFETCH(c + 2);
                    } else if (seg == 1) {
#pragma unroll
                        for (int rt = 0; rt < 2; ++rt) {
                            f32x4 aw = {0.f, 0.f, 0.f, 0.f}, aa = {0.f, 0.f, 0.f, 0.f};
                            aw = MFMA16(ldfrag(WL, 72, rt * 16, 0, lane), ldfrag(WUPT, 72, pw * 16, 0, lane), aw); aw = MFMA16(ldfrag(WL, 72, rt * 16, 32, lane), ldfrag(WUPT, 72, pw * 16, 32, lane), aw);
                            aa = MFMA16(ldfrag(AL, 72, rt * 16, 0, lane), ldfrag(AUPT, 72, pw * 16, 0, lane), aa); aa = MFMA16(ldfrag(AL, 72, rt * 16, 32, lane), ldfrag(AUPT, 72, pw * 16, 32, lane), aa);
#pragma unroll
                            for (int jj = 0; jj < 4; ++jj) { const int t = rt * 16 + quad * 4 + jj;
                                const float sw = w0c + aw[jj], sa_ = a0c + aa[jj];
                                const float av = sigmoidf_(sa_);
                                const float kraw = kpN[t * 64 + cm];
                                dsN[t * 64 + cm] = __expf(-0.6065306597f * sigmoidf_(sw));
                                kkN[t * 64 + cm] = kraw * kkc;
                                kpN[t * 64 + cm] = kraw * (1.0f + (av - 1.0f) * kac);
                                kaN[t * 64 + cm] = av; } }
                    } else if (seg == 2) {
                        const int t = ptid >> 3;
                        float* pk_ = kkN + t * 64 + rpart * 8; float* pa_ = kaN + t * 64 + rpart * 8;
                        const f32x4 k0 = *(const f32x4*)pk_, k1 = *(const f32x4*)(pk_ + 4), a0 = *(const f32x4*)pa_, a1 = *(const f32x4*)(pa_ + 4);
                        const f32x4 r0 = *(const f32x4*)(rsN + t * 64 + rpart * 8), r1 = *(const f32x4*)(rsN + t * 64 + rpart * 8 + 4);
                        const f32x4 q0 = *(const f32x4*)(kpN + t * 64 + rpart * 8), q1 = *(const f32x4*)(kpN + t * 64 + rpart * 8 + 4);
                        const float ss = row8_sum(k0[0] * k0[0] + k0[1] * k0[1] + k0[2] * k0[2] + k0[3] * k0[3] + k1[0] * k1[0] + k1[1] * k1[1] + k1[2] * k1[2] + k1[3] * k1[3]);
                        const float inv = rsqrtf(ss + 1e-6f);
                        const f32x4 n0 = k0 * inv, n1 = k1 * inv;
                        *(f32x4*)pk_ = -n0; *(f32x4*)(pk_ + 4) = -n1; *(f32x4*)pa_ = n0 * a0; *(f32x4*)(pa_ + 4) = n1 * a1;
                        const float bo = row8_sum(r0[0] * q0[0] * rkA[0] + r0[1] * q0[1] * rkA[1] + r0[2] * q0[2] * rkA[2] + r0[3] * q0[3] * rkA[3]
                                                  + r1[0] * q1[0] * rkB[0] + r1[1] * q1[1] * rkB[1] + r1[2] * q1[2] * rkB[2] + r1[3] * q1[3] * rkB[3]);
                        if (half == 0 && rpart == 0) bonus[(rowb + (size_t)(c + 1) * 32 + t) * 16 + hd] = bo;
                    }
                }
                if (seg < 3) __syncthreads();
            }
        }
        __syncthreads();
        if (!producer) {
            const int cl = SEQ / 32 - 1; const float* osL = osb + (cl & 1) * 1024;
            const int t = tid >> 3, c4 = (tid & 7) * 4; const f32x4 v = *(const f32x4*)(osL + t * 32 + c4);
            u32x2 w; w.x = pk_bf16(v[0], v[1]); w.y = pk_bf16(v[2], v[3]);
            *(u32x2*)(O + (rowb + (size_t)cl * 32 + t) * DM + hd * 64 + half * 32 + c4) = w; }
#undef RW3_PREFETCH
    }
}
__device__ __forceinline__ void phase_rw_post(const KA a) {
    const bf16_t* h = (const bf16_t*)(a.ws() + WS_H);
    const bf16_t* O = (const bf16_t*)(a.ws() + WS_X);
    const float* bonus = (const float*)(a.ws() + WS_BONUS);
    bf16_t* Y = (bf16_t*)(a.ws() + WS_X + 64 * MiB);
    const int lane = ltid() & 63, wid = ltid() >> 6;
    float gw[16], gb[16];
#pragma unroll
    for (int e = 0; e < 16; ++e) { gw[e] = a.in(22)[lane * 16 + e]; gb[e] = a.in(23)[lane * 16 + e]; }
    const int stride = (int)gridDim.x * 8;
    int row = lbid() * 8 + wid;
    u32x4 n0[6]; float nbo = 0.f;
#define RWP_LOAD(R) do { n0[0] = ntl((const u32x4*)(O + (size_t)(R) * DM + lane * 16)); n0[1] = ntl((const u32x4*)(O + (size_t)(R) * DM + lane * 16 + 8)); \
        n0[2] = ntl((const u32x4*)(h + (size_t)(R) * NH + 3072 + lane * 16)); n0[3] = ntl((const u32x4*)(h + (size_t)(R) * NH + 3072 + lane * 16 + 8)); \
        n0[4] = ntl((const u32x4*)(h + (size_t)(R) * NH + 2048 + lane * 16)); n0[5] = ntl((const u32x4*)(h + (size_t)(R) * NH + 2048 + lane * 16 + 8)); \
        nbo = bonus[(size_t)(R) * 16 + (lane >> 2)]; } while (0)
    if (row < MTOK) RWP_LOAD(row);
    for (; row < MTOK; row += stride) {
        float o[16], z[16], v[16];
        unpack8(n0[0], *(float(*)[8])&o[0]); unpack8(n0[1], *(float(*)[8])&o[8]); unpack8(n0[2], *(float(*)[8])&z[0]); unpack8(n0[3], *(float(*)[8])&z[8]);
        unpack8(n0[4], *(float(*)[8])&v[0]); unpack8(n0[5], *(float(*)[8])&v[8]);
        const float bo = nbo;
        const int nr = row + stride;
        if (nr < MTOK) RWP_LOAD(nr);
        float s = 0.f;
#pragma unroll
        for (int e = 0; e < 16; ++e) s += o[e];
        s = quad_sum(s);
        const float mu = s * (1.0f / 64.0f);
        float ss = 0.f;
#pragma unroll
        for (int e = 0; e < 16; ++e) { const float d = o[e] - mu; ss += d * d; }
        ss = quad_sum(ss);
        const float sc = rsqrtf(ss * (1.0f / 64.0f) + 64e-5f);
        float y[16];
#pragma unroll
        for (int e = 0; e < 16; ++e) y[e] = ((o[e] - mu) * sc * gw[e] + gb[e] + bo * v[e]) * siluf_(z[e]);
        u32x4 w0, w1; w0.x = pk_bf16(y[0], y[1]); w0.y = pk_bf16(y[2], y[3]); w0.z = pk_bf16(y[4], y[5]); w0.w = pk_bf16(y[6], y[7]);
        w1.x = pk_bf16(y[8], y[9]); w1.y = pk_bf16(y[10], y[11]); w1.z = pk_bf16(y[12], y[13]); w1.w = pk_bf16(y[14], y[15]);
        *(u32x4*)(Y + (size_t)row * DM + lane * 16) = w0; *(u32x4*)(Y + (size_t)row * DM + lane * 16 + 8) = w1;
    }
#undef RWP_LOAD
}

__device__ __forceinline__ bf16_t* dn_seg(bf16_t* h, size_t row0, int hd, int sgi) { const int ar = sgi / 61, r = sgi - ar * 61; return h + (row0 + r) * NH + ar * 1024 + hd * 128; }
__device__ __forceinline__ void phase_dn_prep2(const KA a, int j, unsigned char* shm_) {
    bf16_t* h = (bf16_t*)(a.ws() + WS_H);
    float* E63 = (float*)(a.ws() + WS_BONUS);
    const float* convw = a.in(8) + (size_t)j * 4 * 3072;
    bf16_t* Kraw = (bf16_t*)shm_; bf16_t* KT = (bf16_t*)(shm_ + 17408); bf16_t* VT = (bf16_t*)(shm_ + 35840);
    float* Ap = (float*)(shm_ + 54272); bf16_t* T1 = (bf16_t*)(shm_ + 70656); bf16_t* T2 = (bf16_t*)(shm_ + 79872);
    float* gt = (float*)(shm_ + 89088); float* bet = gt; float* Gs = gt + 64; float* eG = gt + 128; float* rk = gt + 192;
    bf16_t* Vraw = (bf16_t*)(shm_ + 90112); bf16_t* Qraw = (bf16_t*)(shm_ + 107520);
    float* rq = (float*)(shm_ + 124928); float* kds = rq + 64; float* rqp = rq + 128;
    const int tid0 = ltid();
#define DNP_IDX(T) const int tid = (T), wid = tid >> 6, lane = tid & 63, quad = lane >> 4, l15 = lane & 15, cidx = tid & 255, cvc = cidx & 31, ctg = cidx >> 5, cisv = tid >> 8, qc2 = tid & 63, qtg = tid >> 6; (void)quad; (void)l15
    u32x2 praw[11]; unsigned qraw[11]; float pbp = 0.f, pap = 0.f;
#define DNP_PREFETCH(U) do { const int ch_ = (U) & 63, hd_ = ((U) >> 6) & 7, b_ = (U) >> 9; const int t0p = ch_ * 64; const size_t rowp = (size_t)b_ * SEQ + t0p; \
        const int hc = 1024 + cisv * 1024 + hd_ * 128 + cvc * 4; const int hq = hd_ * 128 + qc2 * 2; \
        _Pragma("unroll") for (int i = 0; i < 11; ++i) { const int tl = ctg * 8 - 3 + i; \
            if (t0p + tl >= 0) praw[i] = *(const u32x2*)(h + (size_t)((long)rowp + tl) * NH + hc); else praw[i] = (u32x2){0u, 0u}; } \
        _Pragma("unroll") for (int i = 0; i < 11; ++i) { const int tl = qtg * 8 - 3 + i; \
            if (t0p + tl >= 0) qraw[i] = *(const unsigned*)(h + (size_t)((long)rowp + tl) * NH + hq); else qraw[i] = 0u; } \
        if (wid == 5) { pbp = bf2f(h[(rowp + lane) * NH + 4096 + hd_]); pap = bf2f(h[(rowp + lane) * NH + 4104 + hd_]); } } while (0)
    { DNP_IDX(tid0); const int u0 = lbid(); if (u0 < NB * 8 * 64) DNP_PREFETCH(u0); }
    for (int unit = lbid(); unit < NB * 8 * 64; unit += gridDim.x) {
        int tl_ = tid0; asm volatile("" : "+v"(tl_));
        DNP_IDX(tl_);
        const int ch = unit & 63, hd = (unit >> 6) & 7, b = unit >> 9;
        const int t0 = ch * 64; const size_t row0 = (size_t)b * SEQ + t0;
        bf16_t* Wg = (bf16_t*)(a.ws() + WS_X + (size_t)unit * 16384); bf16_t* Ug = (bf16_t*)(a.ws() + WS_X + 64 * MiB + (size_t)unit * 16384);
        f32x4 pwv[4]; f32x2_ qwv[4];
#pragma unroll
        for (int jw = 0; jw < 4; ++jw) { pwv[jw] = *(const f32x4*)(convw + jw * 3072 + 1024 + cisv * 1024 + hd * 128 + cvc * 4); qwv[jw] = *(const f32x2_*)(convw + jw * 3072 + hd * 128 + qc2 * 2); }
        __syncthreads();
        {
            bf16_t* rm = cisv ? Vraw : Kraw;
            f32x4 x0, x1, x2, x3;
#define DN_X(i) ((f32x4){bflo(praw[i].x), bfhi(praw[i].x), bflo(praw[i].y), bfhi(praw[i].y)})
            x1 = DN_X(0); x2 = DN_X(1); x3 = DN_X(2);
#pragma unroll
            for (int i = 3; i < 11; ++i) {
                x0 = x1; x1 = x2; x2 = x3; x3 = DN_X(i);
                const f32x4 y = pwv[0] * x0 + pwv[1] * x1 + pwv[2] * x2 + pwv[3] * x3;
                u32x2 o; o.x = pk_bf16(siluf_(y[0]), siluf_(y[1])); o.y = pk_bf16(siluf_(y[2]), siluf_(y[3]));
                *(u32x2*)(rm + (ctg * 8 + i - 3) * 136 + cvc * 4) = o;
            }
#undef DN_X
            __builtin_amdgcn_sched_barrier(0);
            f32x2_ q0, q1, q2, q3;
#define DN_Q(i) ((f32x2_){bflo(qraw[i]), bfhi(qraw[i])})
            q1 = DN_Q(0); q2 = DN_Q(1); q3 = DN_Q(2);
#pragma unroll
            for (int i = 3; i < 11; ++i) {
                q0 = q1; q1 = q2; q2 = q3; q3 = DN_Q(i);
                const f32x2_ y = qwv[0] * q0 + qwv[1] * q1 + qwv[2] * q2 + qwv[3] * q3;
                *(unsigned*)(Qraw + (qtg * 8 + i - 3) * 136 + qc2 * 2) = pk_bf16(siluf_(y[0]), siluf_(y[1]));
            }
#undef DN_Q
        }
        if (wid == 5) { const int t = lane;
            float g = -__expf(a.in(9)[j * 8 + hd]) * softplusf_(pap + a.in(10)[j * 8 + hd]);
#pragma unroll
            for (int off = 1; off < 64; off <<= 1) { const float y = __shfl_up(g, off, 64); if (lane >= off) g += y; }
            bet[t] = sigmoidf_(pbp); Gs[t] = g; eG[t] = __expf(g);
            if (lane == 63) E63[unit] = __expf(g); }
        __syncthreads();
        {
            const int row = tid >> 2, part = tid & 3, which = row >> 6, t = row & 63;
            const bf16_t* src = (which ? Kraw : Qraw) + t * 136 + part * 32;
            float ss = 0.f;
#pragma unroll
            for (int q8 = 0; q8 < 4; ++q8) { float f[8]; unpack8(*(const u32x4*)(src + q8 * 8), f);
#pragma unroll
                for (int e = 0; e < 8; ++e) ss += f[e] * f[e]; }
            ss = quad_sum(ss);
            if (part == 0) { const float r = rsqrtf(ss + 1e-6f);
                if (which) { rk[t] = r; kds[t] = r * __expf(Gs[63] - Gs[t]); } else { rqp[t] = r * 0.08838834764831845f; rq[t] = r * 0.08838834764831845f * eG[t]; } } }
        __syncthreads();
        { const int d = tid & 127, jg = tid >> 7;
#pragma unroll
          for (int r = 0; r < 2; ++r) { const bf16_t* src = r ? Vraw : Kraw; bf16_t* dst = r ? VT : KT;
            bf16_t raw[16];
#pragma unroll
            for (int jj = 0; jj < 16; ++jj) raw[jj] = src[(jg * 16 + jj) * 136 + d];
            u32x4 w0, w1; w0.x = raw[0] | ((unsigned)raw[1] << 16); w0.y = raw[2] | ((unsigned)raw[3] << 16); w0.z = raw[4] | ((unsigned)raw[5] << 16); w0.w = raw[6] | ((unsigned)raw[7] << 16);
            w1.x = raw[8] | ((unsigned)raw[9] << 16); w1.y = raw[10] | ((unsigned)raw[11] << 16); w1.z = raw[12] | ((unsigned)raw[13] << 16); w1.w = raw[14] | ((unsigned)raw[15] << 16);
            *(u32x4*)(dst + d * 72 + jg * 16) = w0; *(u32x4*)(dst + d * 72 + jg * 16 + 8) = w1;
            if (r == 0) { float kv[16];
#pragma unroll
                for (int jj = 0; jj < 16; ++jj) kv[jj] = bf2f(raw[jj]) * kds[jg * 16 + jj];
                u32x4 g0, g1; g0.x = pk_bf16(kv[0], kv[1]); g0.y = pk_bf16(kv[2], kv[3]); g0.z = pk_bf16(kv[4], kv[5]); g0.w = pk_bf16(kv[6], kv[7]);
                g1.x = pk_bf16(kv[8], kv[9]); g1.y = pk_bf16(kv[10], kv[11]); g1.z = pk_bf16(kv[12], kv[13]); g1.w = pk_bf16(kv[14], kv[15]);
                bf16_t* kp_ = dn_seg(h, row0, hd, 64 + (d >> 1)) + (d & 1) * 64 + jg * 16;
                *(u32x4*)kp_ = g0; *(u32x4*)(kp_ + 8) = g1; }
            __builtin_amdgcn_sched_barrier(0); } }
        {
            const int t = tid >> 3, c16 = (tid & 7) * 16; const float sc = rq[t];
            float f[8]; u32x4 o0, o1;
            unpack8(*(const u32x4*)(Qraw + t * 136 + c16), f);
            o0.x = pk_bf16(f[0] * sc, f[1] * sc); o0.y = pk_bf16(f[2] * sc, f[3] * sc); o0.z = pk_bf16(f[4] * sc, f[5] * sc); o0.w = pk_bf16(f[6] * sc, f[7] * sc);
            unpack8(*(const u32x4*)(Qraw + t * 136 + c16 + 8), f);
            o1.x = pk_bf16(f[0] * sc, f[1] * sc); o1.y = pk_bf16(f[2] * sc, f[3] * sc); o1.z = pk_bf16(f[4] * sc, f[5] * sc); o1.w = pk_bf16(f[6] * sc, f[7] * sc);
            bf16_t* qp_ = dn_seg(h, row0, hd, t) + c16;
            *(u32x4*)qp_ = o0; *(u32x4*)(qp_ + 8) = o1; }
        __builtin_amdgcn_sched_barrier(0);
        { const int rt = wid >> 1;
#pragma unroll
          for (int c2 = 0; c2 < 2; ++c2) { const int ct = (wid & 1) * 2 + c2;
            f32x4 acc = {0.f, 0.f, 0.f, 0.f}, accp = {0.f, 0.f, 0.f, 0.f};
#pragma unroll
            for (int k0 = 0; k0 < 128; k0 += 32) { const bf16x8 bk = ldfrag(Kraw, 136, ct * 16, k0, lane);
                acc = MFMA16(ldfrag(Kraw, 136, rt * 16, k0, lane), bk, acc); accp = MFMA16(ldfrag(Qraw, 136, rt * 16, k0, lane), bk, accp); }
            const int jc = ct * 16 + l15; const float rkj = rk[jc], Gj = Gs[jc];
#pragma unroll
            for (int jj = 0; jj < 4; ++jj) { const int i = rt * 16 + quad * 4 + jj;
                const float dec = __expf(Gs[i] - Gj);
                const float av = (jc < i) ? bet[i] * rk[i] * rkj * dec * acc[jj] : 0.f;
                Ap[i * 64 + (jc & 7) * 8 + (jc >> 3)] = av;
                const float pv = (jc <= i) ? rqp[i] * rkj * dec * accp[jj] : 0.f;
                dn_seg(h, row0, hd, 128 + (i >> 1))[(i & 1) * 64 + jc] = f2bf1(pv); } } }
        __syncthreads();
        { const int un = unit + (int)gridDim.x; if (un < NB * 8 * 64) DNP_PREFETCH(un); }
        {
            const int c = wid * 8 + (lane >> 3), js = lane & 7;
            float Tl[8];
#pragma unroll
            for (int m = 0; m < 8; ++m) Tl[m] = 0.f;
            if (js == 0) Tl[0] = (c == 0) ? 1.f : 0.f;
#pragma unroll
            for (int i = 1; i < 64; ++i) {
                const f32x4 c0 = *(const f32x4*)(Ap + i * 64 + js * 8);
                f32x4 c1 = {0.f, 0.f, 0.f, 0.f};
                if (i > 32) c1 = *(const f32x4*)(Ap + i * 64 + js * 8 + 4);
                float part = 0.f;
#pragma unroll
                for (int m = 0; m < (i + 7) / 8; ++m) part += (m < 4 ? c0[m & 3] : c1[m & 3]) * Tl[m];
                const float sres = row8_sum(part);
                const float val = ((i == c) ? 1.f : 0.f) - sres;
                if (js == (i & 7)) Tl[i >> 3] = val;
            }
            const float s1 = bet[c], s2 = bet[c] * eG[c] * rk[c];
#pragma unroll
            for (int m = 0; m < 8; ++m) { const int i = js + 8 * m; T1[i * 72 + c] = f2bf1(Tl[m] * s1); T2[i * 72 + c] = f2bf1(Tl[m] * s2); }
        }
        __syncthreads();
        {
            const bf16x8 bv0 = ldfrag(VT, 72, wid * 16, 0, lane), bv1 = ldfrag(VT, 72, wid * 16, 32, lane);
            const bf16x8 bk0 = ldfrag(KT, 72, wid * 16, 0, lane), bk1 = ldfrag(KT, 72, wid * 16, 32, lane);
#pragma unroll
            for (int rt = 0; rt < 4; ++rt) {
                f32x4 au = {0.f, 0.f, 0.f, 0.f}, aw = {0.f, 0.f, 0.f, 0.f};
                au = MFMA16(ldfrag(T1, 72, rt * 16, 0, lane), bv0, au); au = MFMA16(ldfrag(T1, 72, rt * 16, 32, lane), bv1, au);
                aw = MFMA16(ldfrag(T2, 72, rt * 16, 0, lane), bk0, aw); aw = MFMA16(ldfrag(T2, 72, rt * 16, 32, lane), bk1, aw);
#pragma unroll
                for (int jj = 0; jj < 4; ++jj) { const int i = rt * 16 + quad * 4 + jj;
                    Ug[i * 128 + wid * 16 + l15] = f2bf1(au[jj]); Wg[i * 128 + wid * 16 + l15] = f2bf1(aw[jj]); } }
        }
    }
#undef DNP_PREFETCH
#undef DNP_IDX
}
__device__ __forceinline__ void phase_dn_chunk2(const KA a, int j, unsigned char* shm_) {
    bf16_t* h = (bf16_t*)(a.ws() + WS_H);
    const float* E63 = (const float*)(a.ws() + WS_BONUS);
    bf16_t* Qsl = (bf16_t*)shm_; bf16_t* KdT = (bf16_t*)(shm_ + 34816); bf16_t* Wbf = (bf16_t*)(shm_ + 53248);
    bf16_t* ST = (bf16_t*)(shm_ + 70656); bf16_t* Pbf = (bf16_t*)(shm_ + 79360); bf16_t* VnT = (bf16_t*)(shm_ + 88576);
    const int tid = ltid(), wid = tid >> 6, lane = tid & 63, quad = lane >> 4, l15 = lane & 15;
    for (int unit = lbid(); unit < NB * 8 * 4; unit += gridDim.x) {
        const int un_ = (gridDim.x == 256) ? xcd_unit(unit) : unit; const int b = un_ >> 5, hd = (un_ >> 2) & 7, q4 = un_ & 3;
        f32x4 st0 = {0.f, 0.f, 0.f, 0.f}, st1 = {0.f, 0.f, 0.f, 0.f};
        __syncthreads();
        for (int i = tid; i < 32 * 136 / 2; i += NTHR) ((unsigned*)ST)[i] = 0u;
        const int rt = wid >> 1, et = wid & 1;
        const size_t rowb = (size_t)b * SEQ;
        const bf16_t* Wg0 = (const bf16_t*)(a.ws() + WS_X + (size_t)((b * 8 + hd) * 64) * 16384);
        bf16_t* Ug0 = (bf16_t*)(a.ws() + WS_X + 64 * MiB + (size_t)((b * 8 + hd) * 64) * 16384);
        u32x4 pq[2], pk_[2], pp, pw[2]; bf16_t pu[4]; float pe = 0.f;
#define DN2_PREFETCH(CH) do { const size_t r0p = rowb + (size_t)(CH) * 64; const bf16_t* Wgp = Wg0 + (size_t)(CH) * 8192; const bf16_t* Ugp = Ug0 + (size_t)(CH) * 8192; \
            _Pragma("unroll") for (int r = 0; r < 2; ++r) { const int p = tid + NTHR * r; \
                pq[r] = *(const u32x4*)(dn_seg(h, r0p, hd, p >> 4) + (p & 15) * 8); \
                const int d = p >> 3; pk_[r] = *(const u32x4*)(dn_seg(h, r0p, hd, 64 + (d >> 1)) + (d & 1) * 64 + (p & 7) * 8); \
                pw[r] = *(const u32x4*)(Wgp + (p >> 4) * 128 + (p & 15) * 8); } \
            { const int i = tid >> 3; pp = *(const u32x4*)(dn_seg(h, r0p, hd, 128 + (i >> 1)) + (i & 1) * 64 + (tid & 7) * 8); } \
            _Pragma("unroll") for (int jj = 0; jj < 4; ++jj) pu[jj] = Ugp[(rt * 16 + quad * 4 + jj) * 128 + q4 * 32 + et * 16 + l15]; \
            pe = E63[(b * 8 + hd) * 64 + (CH)]; } while (0)
        DN2_PREFETCH(0);
        for (int ch = 0; ch < SEQ / 64; ++ch) {
            __syncthreads();
#pragma unroll
            for (int r = 0; r < 2; ++r) { const int p = tid + NTHR * r;
                *(u32x4*)(Qsl + (p >> 4) * 136 + (p & 15) * 8) = pq[r];
                *(u32x4*)(KdT + (p >> 3) * 72 + (p & 7) * 8) = pk_[r];
                *(u32x4*)(Wbf + (p >> 4) * 136 + (p & 15) * 8) = pw[r]; }
            *(u32x4*)(Pbf + (tid >> 3) * 72 + (tid & 7) * 8) = pp;
            float ureg[4];
#pragma unroll
            for (int jj = 0; jj < 4; ++jj) ureg[jj] = bf2f(pu[jj]);
            const float eg63 = pe;
            if (ch + 1 < SEQ / 64) DN2_PREFETCH(ch + 1);
            __syncthreads();
            f32x4 accv = {0.f, 0.f, 0.f, 0.f}, acco = {0.f, 0.f, 0.f, 0.f};
#pragma unroll
            for (int k0 = 0; k0 < 128; k0 += 32) { const bf16x8 bs = ldfrag(ST, 136, et * 16, k0, lane);
                accv = MFMA16(ldfrag(Wbf, 136, rt * 16, k0, lane), bs, accv);
                acco = MFMA16(ldfrag(Qsl, 136, rt * 16, k0, lane), bs, acco); }
            { u32x2 w; w.x = pk_bf16(ureg[0] - accv[0], ureg[1] - accv[1]); w.y = pk_bf16(ureg[2] - accv[2], ureg[3] - accv[3]);
              *(u32x2*)(VnT + (et * 16 + l15) * 72 + rt * 16 + quad * 4) = w; }
            __syncthreads();
            acco = MFMA16(ldfrag(Pbf, 72, rt * 16, 0, lane), ldfrag(VnT, 72, et * 16, 0, lane), acco);
            acco = MFMA16(ldfrag(Pbf, 72, rt * 16, 32, lane), ldfrag(VnT, 72, et * 16, 32, lane), acco);
#pragma unroll
            for (int jj = 0; jj < 4; ++jj) { const int i = rt * 16 + quad * 4 + jj;
                Ug0[(size_t)ch * 8192 + i * 128 + q4 * 32 + et * 16 + l15] = f2bf1(acco[jj]); }
            { const bf16x8 ak0 = ldfrag(KdT, 72, wid * 16, 0, lane), ak1 = ldfrag(KdT, 72, wid * 16, 32, lane);
              st0 = st0 * eg63; st1 = st1 * eg63;
              st0 = MFMA16(ak0, ldfrag(VnT, 72, 0, 0, lane), st0); st0 = MFMA16(ak1, ldfrag(VnT, 72, 0, 32, lane), st0);
              st1 = MFMA16(ak0, ldfrag(VnT, 72, 16, 0, lane), st1); st1 = MFMA16(ak1, ldfrag(VnT, 72, 16, 32, lane), st1);
              u32x2 w; w.x = pk_bf16(st0[0], st0[1]); w.y = pk_bf16(st0[2], st0[3]);
              *(u32x2*)(ST + (l15) * 136 + wid * 16 + quad * 4) = w;
              w.x = pk_bf16(st1[0], st1[1]); w.y = pk_bf16(st1[2], st1[3]);
              *(u32x2*)(ST + (16 + l15) * 136 + wid * 16 + quad * 4) = w; }
        }
#undef DN2_PREFETCH
    }
}
__device__ __forceinline__ void phase_ml_chunk(const KA a, unsigned char* shm_) {
    const bf16_t* h = (const bf16_t*)(a.ws() + WS_H);
    bf16_t* O = (bf16_t*)(a.ws() + WS_X);
    const float* convw = a.in(26);
    float* qs = (float*)shm_; float* ks = qs + 4096; float* vs = qs + 8192; float* Hout = qs + 10240;
    bf16_t* Qbf = (bf16_t*)(shm_ + 53248); bf16_t* Kbf = Qbf + 64 * 72; bf16_t* KwT = Kbf + 64 * 72; bf16_t* Wbf = KwT + 64 * 72; bf16_t* VT = Wbf + 64 * 72; bf16_t* CT = VT + 48 * 72;
    float* gt = (float*)(shm_ + 103936);
    float* il = gt; float* fl = gt + 64; float* ra = gt + 128; float* cb = gt + 192; float* inter = gt + 256; float* kscale = gt + 320; float* em = gt + 384; float* misc = gt + 448;
    const int tid = ltid(), wid = tid >> 6, lane = tid & 63, quad = lane >> 4, l15 = lane & 15;
    for (int unit = lbid(); unit < NB * 8 * 4; unit += gridDim.x) {
        const int un_ = (gridDim.x == 256) ? xcd_unit(unit) : unit; const int b = un_ >> 5, hd = (un_ >> 2) & 7, q4 = un_ & 3;
        const float ib = a.in(27)[hd], fb = a.in(28)[hd];
        f32x4 st0 = {0.f, 0.f, 0.f, 0.f}, st1 = {0.f, 0.f, 0.f, 0.f};
        float m_prev = -1e30f;
        __syncthreads();
        for (int i = tid; i < 48 * 72 / 2; i += NTHR) ((unsigned*)CT)[i] = 0u;
        for (int i = tid; i < 16 * 72; i += NTHR) VT[32 * 72 + i] = (i < 72) ? (bf16_t)0x3F80 : (bf16_t)0;
        const int cidx = tid & 127, cvc = cidx & 15, ctg = cidx >> 4, cisk = (tid >> 7) & 1;
        const int chc = cisk * 512 + hd * 64 + cvc * 4;
        const int vt_ = (tid & 255) >> 2, vvc = tid & 3, vcol = 1024 + hd * 128 + q4 * 32 + vvc * 8;
        const size_t rowb = (size_t)b * SEQ;
        f32x4 cwv[4];
#pragma unroll
        for (int jw = 0; jw < 4; ++jw) cwv[jw] = *(const f32x4*)(convw + jw * 1024 + chc);
        u32x2 praw[11]; u32x4 pv = {0u, 0u, 0u, 0u}; float pip = 0.f, pfp = 0.f;
#define ML_PREFETCH(CH) do { const int t0p = (CH) * 64; \
            if (tid < 256) { _Pragma("unroll") for (int i = 0; i < 11; ++i) { const int tl = ctg * 8 - 3 + i; \
                if (t0p + tl >= 0) praw[i] = *(const u32x2*)(h + (size_t)((long)(rowb + t0p) + tl) * NH + chc); else praw[i] = (u32x2){0u, 0u}; } } \
            else pv = *(const u32x4*)(h + (rowb + t0p + vt_) * NH + vcol); \
            if (wid == 6) { pip = bf2f(h[(rowb + t0p + lane) * NH + 4096 + hd]); pfp = bf2f(h[(rowb + t0p + lane) * NH + 4104 + hd]); } } while (0)
        ML_PREFETCH(0);
        for (int ch = 0; ch < SEQ / 64; ++ch) {
            const int t0 = ch * 64; const size_t row0 = (size_t)b * SEQ + t0;
            __syncthreads();
            if (tid < 256) {
                float* dst = (cisk ? ks : qs) + cvc * 4; const float sc = cisk ? 0.125f : 1.0f;
                f32x4 x0, x1, x2, x3;
#define ML_X(i) ((f32x4){bflo(praw[i].x), bfhi(praw[i].x), bflo(praw[i].y), bfhi(praw[i].y)})
                x1 = ML_X(0); x2 = ML_X(1); x3 = ML_X(2);
#pragma unroll
                for (int i = 3; i < 11; ++i) {
                    x0 = x1; x1 = x2; x2 = x3; x3 = ML_X(i);
                    const f32x4 y = cwv[0] * x0 + cwv[1] * x1 + cwv[2] * x2 + cwv[3] * x3;
                    *(f32x4*)(dst + (ctg * 8 + i - 3) * 64) = (f32x4){siluf_(y[0]) * sc, siluf_(y[1]) * sc, siluf_(y[2]) * sc, siluf_(y[3]) * sc};
                }
#undef ML_X
            } else { float f[8]; unpack8(pv, f); float* dv = vs + vt_ * 32 + vvc * 8;
                *(f32x4*)dv = (f32x4){f[0], f[1], f[2], f[3]}; *(f32x4*)(dv + 4) = (f32x4){f[4], f[5], f[6], f[7]}; }
            if (wid == 6) { il[lane] = pip + ib; fl[lane] = -softplusf_(-(pfp + fb)); }
            if (ch + 1 < SEQ / 64) ML_PREFETCH(ch + 1);
            __syncthreads();
            {
                const int t = tid >> 3, c8 = (tid & 7) * 8;
                const f32x4 q0 = *(const f32x4*)(qs + t * 64 + c8), q1 = *(const f32x4*)(qs + t * 64 + c8 + 4);
                const f32x4 k0 = *(const f32x4*)(ks + t * 64 + c8), k1 = *(const f32x4*)(ks + t * 64 + c8 + 4);
                u32x4 w; w.x = pk_bf16(q0[0], q0[1]); w.y = pk_bf16(q0[2], q0[3]); w.z = pk_bf16(q1[0], q1[1]); w.w = pk_bf16(q1[2], q1[3]); *(u32x4*)(Qbf + t * 72 + c8) = w;
                w.x = pk_bf16(k0[0], k0[1]); w.y = pk_bf16(k0[2], k0[3]); w.z = pk_bf16(k1[0], k1[1]); w.w = pk_bf16(k1[2], k1[3]); *(u32x4*)(Kbf + t * 72 + c8) = w;
                const int c = tid & 31, jg = tid >> 5;
                u32x2 v2; v2.x = pk_bf16(vs[(jg * 4 + 0) * 32 + c], vs[(jg * 4 + 1) * 32 + c]); v2.y = pk_bf16(vs[(jg * 4 + 2) * 32 + c], vs[(jg * 4 + 3) * 32 + c]);
                *(u32x2*)(VT + c * 72 + jg * 4) = v2;
            }
            if (wid == 7) {
                const float f = fl[lane], iv = il[lane];
                const float bs = wave_scan_add(f);
                const float cbv = iv - bs;
                const float cm = wave_scan_max(cbv);
                const float mi = fmaxf(m_prev + bs, bs + cm);
                const float b63 = __shfl(bs, 63, 64), mnew = __shfl(mi, 63, 64);
                ra[lane] = bs - mi; cb[lane] = cbv; inter[lane] = __expf(m_prev + bs - mi); kscale[lane] = __expf(b63 - mnew + cbv); em[lane] = __expf(-mi);
                if (lane == 0) misc[0] = __expf(m_prev + b63 - mnew);
                m_prev = mnew;
            }
            __syncthreads();
            {
                const int rt = wid >> 1;
#pragma unroll
                for (int c2 = 0; c2 < 2; ++c2) { const int ct = (wid & 1) * 2 + c2;
                    f32x4 acc = {0.f, 0.f, 0.f, 0.f};
                    acc = MFMA16(ldfrag(Qbf, 72, rt * 16, 0, lane), ldfrag(Kbf, 72, ct * 16, 0, lane), acc);
                    acc = MFMA16(ldfrag(Qbf, 72, rt * 16, 32, lane), ldfrag(Kbf, 72, ct * 16, 32, lane), acc);
                    const int jc = ct * 16 + l15; const float cbj = cb[jc];
#pragma unroll
                    for (int jj = 0; jj < 4; ++jj) { const int i = rt * 16 + quad * 4 + jj;
                        const float wv = (jc <= i) ? __expf(ra[i] + cbj) * acc[jj] : 0.f;
                        Wbf[i * 72 + jc] = f2bf1(wv); } }
                const int d = tid & 63, jg = tid >> 6;
                float kv[8];
#pragma unroll
                for (int jj = 0; jj < 8; ++jj) kv[jj] = ks[(jg * 8 + jj) * 64 + d] * kscale[jg * 8 + jj];
                u32x4 w; w.x = pk_bf16(kv[0], kv[1]); w.y = pk_bf16(kv[2], kv[3]); w.z = pk_bf16(kv[4], kv[5]); w.w = pk_bf16(kv[6], kv[7]);
                *(u32x4*)(KwT + d * 72 + jg * 8) = w;
            }
            __syncthreads();
            { const float carry = misc[0];
#pragma unroll
              for (int r = 0; r < 2; ++r) { const int id = wid + 8 * r;
                if (id < 12) { const int rt = id / 3, ct = id - rt * 3;
                    f32x4 acc = {0.f, 0.f, 0.f, 0.f};
                    acc = MFMA16(ldfrag(Qbf, 72, rt * 16, 0, lane), ldfrag(CT, 72, ct * 16, 0, lane), acc);
                    acc = MFMA16(ldfrag(Qbf, 72, rt * 16, 32, lane), ldfrag(CT, 72, ct * 16, 32, lane), acc);
#pragma unroll
                    for (int jj = 0; jj < 4; ++jj) acc[jj] *= inter[rt * 16 + quad * 4 + jj];
                    acc = MFMA16(ldfrag(Wbf, 72, rt * 16, 0, lane), ldfrag(VT, 72, ct * 16, 0, lane), acc);
                    acc = MFMA16(ldfrag(Wbf, 72, rt * 16, 32, lane), ldfrag(VT, 72, ct * 16, 32, lane), acc);
#pragma unroll
                    for (int jj = 0; jj < 4; ++jj) Hout[(rt * 16 + quad * 4 + jj) * 48 + ct * 16 + l15] = acc[jj];
                    f32x4 st = r ? st1 : st0;
                    st = st * carry;
                    st = MFMA16(ldfrag(KwT, 72, rt * 16, 0, lane), ldfrag(VT, 72, ct * 16, 0, lane), st);
                    st = MFMA16(ldfrag(KwT, 72, rt * 16, 32, lane), ldfrag(VT, 72, ct * 16, 32, lane), st);
                    if (r) st1 = st; else st0 = st; } } }
            __syncthreads();
#pragma unroll
            for (int r = 0; r < 2; ++r) { const int id = wid + 8 * r;
                if (id < 12) { const int dt = id / 3, ct = id - dt * 3; const f32x4 st = r ? st1 : st0;
                    u32x2 w; w.x = pk_bf16(st[0], st[1]); w.y = pk_bf16(st[2], st[3]);
                    *(u32x2*)(CT + (ct * 16 + l15) * 72 + dt * 16 + quad * 4) = w; } }
            { const int t = tid >> 3, c4 = (tid & 7) * 4;
              const f32x4 num = *(const f32x4*)(Hout + t * 48 + c4); const float den = Hout[t * 48 + 32];
              const float dd = 1.0f / fmaxf(fabsf(den), em[t]);
              u32x2 w; w.x = pk_bf16(num[0] * dd, num[1] * dd); w.y = pk_bf16(num[2] * dd, num[3] * dd);
              *(u32x2*)(O + (row0 + t) * DM + hd * 128 + q4 * 32 + c4) = w; }
        }
    }
#undef ML_PREFETCH
}
__device__ __forceinline__ void phase_ml_post(const KA a) {
    const bf16_t* h = (const bf16_t*)(a.ws() + WS_H);
    const bf16_t* O = (const bf16_t*)(a.ws() + WS_X);
    bf16_t* Y = (bf16_t*)(a.ws() + WS_X + 64 * MiB);
    const int lane = ltid() & 63, wid = ltid() >> 6;
    float gw[16];
#pragma unroll
    for (int e = 0; e < 16; ++e) gw[e] = a.in(29)[lane * 16 + e];
    const int stride = (int)gridDim.x * 8;
    int row = lbid() * 8 + wid;
    u32x4 n0[6];
#define MLP_LOAD(R) do { n0[0] = ntl((const u32x4*)(O + (size_t)(R) * DM + lane * 16)); n0[1] = ntl((const u32x4*)(O + (size_t)(R) * DM + lane * 16 + 8)); \
        n0[2] = ntl((const u32x4*)(h + (size_t)(R) * NH + 3072 + lane * 16)); n0[3] = ntl((const u32x4*)(h + (size_t)(R) * NH + 3072 + lane * 16 + 8)); \
        n0[4] = ntl((const u32x4*)(h + (size_t)(R) * NH + 2048 + lane * 16)); n0[5] = ntl((const u32x4*)(h + (size_t)(R) * NH + 2048 + lane * 16 + 8)); } while (0)
    if (row < MTOK) MLP_LOAD(row);
    for (; row < MTOK; row += stride) {
        float o[16], z[16], g[16];
        unpack8(n0[0], *(float(*)[8])&o[0]); unpack8(n0[1], *(float(*)[8])&o[8]); unpack8(n0[2], *(float(*)[8])&z[0]); unpack8(n0[3], *(float(*)[8])&z[8]);
        unpack8(n0[4], *(float(*)[8])&g[0]); unpack8(n0[5], *(float(*)[8])&g[8]);
        const int nr = row + stride;
        if (nr < MTOK) MLP_LOAD(nr);
        float s = 0.f;
#pragma unroll
        for (int e = 0; e < 16; ++e) { o[e] *= sigmoidf_(g[e]); s += o[e]; }
        s = row8_sum(s);
        const float mu = s * (1.0f / 128.0f);
        float ss = 0.f;
#pragma unroll
        for (int e = 0; e < 16; ++e) { const float d = o[e] - mu; ss += d * d; }
        ss = row8_sum(ss);
        const float sc = rsqrtf(ss * (1.0f / 128.0f) + 1e-6f);
        float y[16];
#pragma unroll
        for (int e = 0; e < 16; ++e) y[e] = (o[e] - mu) * sc * gw[e] * siluf_(z[e]);
        u32x4 w0, w1; w0.x = pk_bf16(y[0], y[1]); w0.y = pk_bf16(y[2], y[3]); w0.z = pk_bf16(y[4], y[5]); w0.w = pk_bf16(y[6], y[7]);
        w1.x = pk_bf16(y[8], y[9]); w1.y = pk_bf16(y[10], y[11]); w1.z = pk_bf16(y[12], y[13]); w1.w = pk_bf16(y[14], y[15]);
        *(u32x4*)(Y + (size_t)row * DM + lane * 16) = w0; *(u32x4*)(Y + (size_t)row * DM + lane * 16 + 8) = w1;
    }
#undef MLP_LOAD
}

__device__ __forceinline__ void phase_ln(const KA a, int L) {
    const bf16_t* Yb = (const bf16_t*)(a.ws() + WS_H);
    const float* xr = (L == 0) ? a.in(0) : (const float*)a.out();
    bf16_t* xb = (bf16_t*)(a.ws() + WS_X);
    bf16_t* pb = (bf16_t*)(a.ws() + WS_P);
    const float* p = a.in(1) + (size_t)L * MTOK * DPLE;
    const float* lg = a.in(2) + L * DM; const float* lb = a.in(3) + L * DM;
    const int lane = ltid() & 63, wid = ltid() >> 6;
    f32x4 g[4], bb[4];
#pragma unroll
    for (int i = 0; i < 4; ++i) { g[i] = *(const f32x4*)(lg + i * 256 + lane * 4); bb[i] = *(const f32x4*)(lb + i * 256 + lane * 4); }
    const int stride = (int)gridDim.x * 8;
    int row = lbid() * 8 + wid;
    f32x4 nv[4], npv; u32x2 ny[4];
    if (row < MTOK) {
#pragma unroll
        for (int i = 0; i < 4; ++i) { nv[i] = *(const f32x4*)(xr + (size_t)row * DM + i * 256 + lane * 4); ny[i] = *(const u32x2*)(Yb + (size_t)row * DM + i * 256 + lane * 4); }
        npv = ntl((const f32x4*)(p + (size_t)row * DPLE + lane * 4)); }
    for (; row < MTOK; row += stride) {
        f32x4 v[4]; const f32x4 pv = npv; float s = 0.f;
#pragma unroll
        for (int i = 0; i < 4; ++i) { v[i] = nv[i] * ALPHA + (f32x4){bflo(ny[i].x), bfhi(ny[i].x), bflo(ny[i].y), bfhi(ny[i].y)}; s += v[i][0] + v[i][1] + v[i][2] + v[i][3]; }
        const int nr = row + stride;
        if (nr < MTOK) {
#pragma unroll
            for (int i = 0; i < 4; ++i) { nv[i] = *(const f32x4*)(xr + (size_t)nr * DM + i * 256 + lane * 4); ny[i] = *(const u32x2*)(Yb + (size_t)nr * DM + i * 256 + lane * 4); }
            npv = ntl((const f32x4*)(p + (size_t)nr * DPLE + lane * 4)); }
        const float mu = wave_sum(s) * (1.0f / 1024.0f);
        float ss = 0.f;
#pragma unroll
        for (int i = 0; i < 4; ++i) { v[i] = v[i] - mu; ss += v[i][0] * v[i][0] + v[i][1] * v[i][1] + v[i][2] * v[i][2] + v[i][3] * v[i][3]; }
        const float sc = rsqrtf(wave_sum(ss) * (1.0f / 1024.0f) + 1e-5f);
#pragma unroll
        for (int i = 0; i < 4; ++i) { const f32x4 y = v[i] * sc * g[i] + bb[i];
            u32x2 w; w.x = pk_bf16(y[0], y[1]); w.y = pk_bf16(y[2], y[3]); *(u32x2*)(xb + (size_t)row * DM + i * 256 + lane * 4) = w; }
        { u32x2 w; w.x = pk_bf16(pv[0], pv[1]); w.y = pk_bf16(pv[2], pv[3]); *(u32x2*)(pb + (size_t)row * DPLE + lane * 4) = w; }
    }
}
__device__ __forceinline__ void phase_combine(const KA a, int L) {
    const bf16_t* Yb = (const bf16_t*)(a.ws() + WS_H);
    const float* xr = (L == 0) ? a.in(0) : (const float*)a.out();
    const bf16_t* PP = (const bf16_t*)(a.ws() + WS_H + 128 * MiB);
    const bf16_t* G = (const bf16_t*)(a.ws() + WS_H + 192 * MiB);
    bf16_t* xb = (bf16_t*)(a.ws() + WS_X);
    const float* nw = a.in(5) + L * DM; const float* lg = a.in(2) + L * DM; const float* lb = a.in(3) + L * DM;
    const int lane = ltid() & 63, wid = ltid() >> 6;
    const int next_kind = (L + 1 < NLAYER) ? ((L + 1) % 3) : -1;
    const int stride = (int)gridDim.x * 8;
    int row = lbid() * 8 + wid;
    f32x4 ntv[4]; u32x2 npr[4], ngr[4], nyr[4];
    if (row < MTOK) {
#pragma unroll
        for (int i = 0; i < 4; ++i) { const size_t o = (size_t)row * DM + i * 256 + lane * 4; ntv[i] = ntl((const f32x4*)(xr + o)); nyr[i] = ntl((const u32x2*)(Yb + o)); npr[i] = ntl((const u32x2*)(PP + o)); ngr[i] = ntl((const u32x2*)(G + o)); } }
    for (; row < MTOK; row += stride) {
        f32x4 tv[4], pp[4]; u32x2 gr[4]; float s = 0.f, ss = 0.f;
#pragma unroll
        for (int i = 0; i < 4; ++i) { tv[i] = ntv[i] * ALPHA + (f32x4){bflo(nyr[i].x), bfhi(nyr[i].x), bflo(nyr[i].y), bfhi(nyr[i].y)}; gr[i] = ngr[i]; s += tv[i][0] + tv[i][1] + tv[i][2] + tv[i][3];
            pp[i] = (f32x4){bflo(npr[i].x), bfhi(npr[i].x), bflo(npr[i].y), bfhi(npr[i].y)};
            ss += pp[i][0] * pp[i][0] + pp[i][1] * pp[i][1] + pp[i][2] * pp[i][2] + pp[i][3] * pp[i][3]; }
        const int nr = row + stride;
        if (nr < MTOK) {
#pragma unroll
            for (int i = 0; i < 4; ++i) { const size_t o = (size_t)nr * DM + i * 256 + lane * 4; ntv[i] = ntl((const f32x4*)(xr + o)); nyr[i] = ntl((const u32x2*)(Yb + o)); npr[i] = ntl((const u32x2*)(PP + o)); ngr[i] = ntl((const u32x2*)(G + o)); } }
        const float mu = wave_sum(s) * (1.0f / 1024.0f);
        const float psc = rsqrtf(wave_sum(ss) * (1.0f / 1024.0f) + 1e-6f);
        float vs_ = 0.f;
#pragma unroll
        for (int i = 0; i < 4; ++i) { tv[i] = tv[i] - mu; vs_ += tv[i][0] * tv[i][0] + tv[i][1] * tv[i][1] + tv[i][2] * tv[i][2] + tv[i][3] * tv[i][3]; }
        const float lsc = rsqrtf(wave_sum(vs_) * (1.0f / 1024.0f) + 1e-5f);
#pragma unroll
        for (int i = 0; i < 4; ++i) {
            const int c = i * 256 + lane * 4; const size_t o = (size_t)row * DM + c;
            const f32x4 x1 = tv[i] * lsc * *(const f32x4*)(lg + c) + *(const f32x4*)(lb + c);
            const f32x4 gg = {bflo(gr[i].x), bfhi(gr[i].x), bflo(gr[i].y), bfhi(gr[i].y)};
            const f32x4 y = x1 + gg * pp[i] * psc * *(const f32x4*)(nw + c);
            nts((f32x4*)(a.out() + o), y);
            u32x2 w; w.x = pk_bf16(y[0], y[1]); w.y = pk_bf16(y[2], y[3]);
            if (next_kind == 1) {
                *(u32x2*)(xb + (size_t)row * 2048 + c) = w;
                if ((row & (SEQ - 1)) != SEQ - 1) *(u32x2*)(xb + (size_t)(row + 1) * 2048 + 1024 + c) = w;
                if ((row & (SEQ - 1)) == 0) { u32x2 zz; zz.x = 0u; zz.y = 0u; *(u32x2*)(xb + (size_t)row * 2048 + 1024 + c) = zz; }
            } else if (next_kind >= 0) {
                *(u32x2*)(xb + o) = w;
            }
        }
    }
}

#define XB_TMO      128
#define XB_XCNT(j)  (256  + 64 * (j))
#define XB_XSUB(j)  (1280 + 64 * (j))
#define XB_XGEN(j)  (2304 + 64 * (j))
#define XB_TOP      3328
#define XB_TOPGEN   3392
#define XCD_BAR_WORDS 3456
#define XB_SPIN_CAP (1u << 18)
__device__ __forceinline__ unsigned xb_ld(unsigned* p)              { return __hip_atomic_load(p, __ATOMIC_RELAXED, __HIP_MEMORY_SCOPE_AGENT); }
__device__ __forceinline__ unsigned xb_add(unsigned* p, unsigned v) { return __hip_atomic_fetch_add(p, v, __ATOMIC_RELAXED, __HIP_MEMORY_SCOPE_AGENT); }
__device__ __forceinline__ unsigned xb_xcc_id() { return (unsigned)__builtin_amdgcn_s_getreg((3 << 11) | 20) & 0xFu; }
#define XB_SPIN(cond, bar) do { unsigned _sp = 0; while (cond) { __builtin_amdgcn_s_sleep(1); \
    if ((++_sp & 255u) == 0u) { if (xb_ld(&(bar)[XB_TMO])) break; if (_sp > XB_SPIN_CAP) { atomicAdd(&(bar)[XB_TMO], 1u); break; } } } } while (0)
struct XcdBarrier { unsigned* bar; unsigned x; volatile LAS unsigned* st; };
__device__ __forceinline__ void xcd_barrier_complete(unsigned* bar, unsigned x, unsigned& nloc, unsigned& nx) {
    const unsigned G = gridDim.x * gridDim.y * gridDim.z;
    unsigned sum, cnt, mine, sp = 0u;
    for (;;) {
        sum = 0u; cnt = 0u; mine = 0u;
#pragma unroll
        for (unsigned j = 0; j < 16; ++j) { const unsigned c = xb_ld(&bar[XB_XCNT(j)]); sum += c; cnt += (c > 0u) ? 1u : 0u; mine = (j == x) ? c : mine; }
        if (sum == G) break;
        __builtin_amdgcn_s_sleep(1);
        if ((++sp & 255u) == 0u) { if (xb_ld(&bar[XB_TMO])) break; if (sp > XB_SPIN_CAP) { atomicAdd(&bar[XB_TMO], 1u); break; } }
    }
    nloc = mine > 0u ? mine : 1u; nx = cnt > 0u ? cnt : 1u;
}
__device__ __forceinline__ void xcd_barrier(const XcdBarrier& b) {
    asm volatile("s_waitcnt vmcnt(0)" ::: "memory");
    __syncthreads();
    if (threadIdx.x == 0) {
        unsigned* bar = b.bar;
        __builtin_amdgcn_s_waitcnt(0);
        unsigned nloc = b.st[0], nx = b.st[1];
        if (nloc == 0u) { xcd_barrier_complete(bar, b.x, nloc, nx); b.st[0] = nloc; b.st[1] = nx; }
        const unsigned old = xb_add(&bar[XB_XSUB(b.x)], 1u);
        const unsigned gen = old / nloc;
        if (old + 1u == (gen + 1u) * nloc) {
            __builtin_amdgcn_fence(__ATOMIC_RELEASE, "agent");
            asm volatile("s_waitcnt vmcnt(0)" ::: "memory");
            const unsigned og = xb_add(&bar[XB_TOP], 1u);
            const unsigned tg = og / nx;
            if (og + 1u == (tg + 1u) * nx) xb_add(&bar[XB_TOPGEN], 1u);
            else XB_SPIN(xb_ld(&bar[XB_TOPGEN]) == tg, bar);
            __builtin_amdgcn_fence(__ATOMIC_ACQUIRE, "agent");
            xb_add(&bar[XB_XGEN(b.x)], 1u);
            asm volatile("s_waitcnt vmcnt(0)" ::: "memory");
        } else {
            XB_SPIN(xb_ld(&bar[XB_XGEN(b.x)]) == gen, bar);
            __builtin_amdgcn_fence(__ATOMIC_ACQUIRE, "agent");
            asm volatile("s_waitcnt vmcnt(0)" ::: "memory");
        }
    }
    __syncthreads();
}

constexpr int NSTEP = 9;
constexpr int N_PHASES = 1 + NSTEP * NLAYER;
__global__ void __launch_bounds__(512, 2) mega(Args args) {
    extern __shared__ __attribute__((aligned(16))) unsigned char shm[];
    cg::grid_group grid = cg::this_grid();
    LAS unsigned char* lds3 = (LAS unsigned char*)shm;
    float* ldsf = (float*)shm;
    const int ph_lo = args.ph_lo, ph_hi = args.ph_hi;
    volatile LAS unsigned* xst = (volatile LAS unsigned*)(lds3 + 131072);
    if (threadIdx.x == 0) { xst[0] = 0u; xst[1] = 0u; }
    __syncthreads();
    if (ph_hi - ph_lo > 1 && threadIdx.x == 0) (void)xb_add(&((unsigned*)(args.ws + WS_BAR))[XB_XCNT(xb_xcc_id())], 1u);
    for (int ph = ph_lo; ph < ph_hi; ++ph) {
        kargp_t kp = (kargp_t)__builtin_amdgcn_kernarg_segment_ptr();
        asm volatile("" : "+s"(kp));
        KA a; a.p = kp;
        bool need_sync = true;
        if (ph == 0) {
            if (HAS(0)) phase_prep(a, shm);
        } else {
            const int L = (ph - 1) / NSTEP, st = (ph - 1) % NSTEP, kind = L % 3, j = L / 3;
            if ((st == 0 || st == 7) && HAS(1)) {
                pg8::Gemm g; pg8::EpiBf16 E; g.M = MTOK; g.A = (const bf16_t*)(a.ws() + WS_X);
                if (st == 0) { g.N = NH; g.K = (kind == 1) ? 2048 : 1024;
                    g.Bt = (const bf16_t*)(a.ws() + (kind == 0 ? (j == 0 ? WS_W_DN0 : WS_W_DN1) : (kind == 1 ? WS_W_RW : WS_W_ML)));
                    E.O = (bf16_t*)(a.ws() + WS_H); E.ldc = NH; E.act = 0; }
                else { g.N = DM; g.K = DM; g.Bt = (const bf16_t*)(a.ws() + WS_W_GATE + (size_t)L * 2 * MiB);
                    E.O = (bf16_t*)(a.ws() + WS_H + 192 * MiB); E.ldc = DM; E.act = 1; }
                pg8::StaticOrder S; S.init(g.M, g.N, (int)gridDim.x, lbid());
                pg8::gemm_phase(lds3, g, S, E);
            } else if (st == 6 && HAS(1)) {
                pg8::Gemm g; pg8::EpiBf16 E; g.M = MTOK; g.A = (const bf16_t*)(a.ws() + WS_P); g.N = DM; g.K = DPLE; g.Bt = (const bf16_t*)(a.ws() + WS_W_PROJ + (size_t)L * (MiB / 2));
                E.O = (bf16_t*)(a.ws() + WS_H + 128 * MiB); E.ldc = DM; E.act = 0; need_sync = false;
                pg8::StaticOrder S; S.init(g.M, g.N, (int)gridDim.x, lbid());
                pg8::gemm_phase(lds3, g, S, E);
            } else if (st == 4 && HAS(6)) {
                pg8::Gemm g; pg8::EpiBf16 E; g.M = MTOK; g.N = DM; g.K = DM;
                g.A = (const bf16_t*)(a.ws() + WS_X + (kind == 0 ? 0 : 64 * MiB)); g.Bt = (const bf16_t*)(a.ws() + WS_W_OUT + (size_t)L * 2 * MiB);
                E.O = (bf16_t*)(a.ws() + WS_H); E.ldc = DM; E.act = 0;
                pg8::StaticOrder S; S.init(g.M, g.N, (int)gridDim.x, lbid());
                pg8::gemm_phase(lds3, g, S, E);
            } else if (st == 1) {
                if (kind == 0) { if (HAS(2) && HAS(10)) phase_dn_prep2(a, j, shm); } else need_sync = false;
            } else if (st == 2) {
                if (kind == 0) { if (HAS(2) && HAS(11)) phase_dn_chunk2(a, j, shm); } else if (kind == 1) { if (HAS(3)) phase_rw_scan3(a, shm); } else { if (HAS(4)) phase_ml_chunk(a, shm); }
            } else if (st == 3) {
                if (HAS(5)) { if (kind == 0) phase_dn_post(a, j); else if (kind == 1) phase_rw_post(a); else phase_ml_post(a); }
            } else if (st == 5) {
                if (HAS(7)) phase_ln(a, L);
            } else if (st == 8) {
                if (HAS(9)) phase_combine(a, L);
            }
        }
        if (need_sync && ph + 1 < ph_hi) {
            if (ph == 0) grid.sync();
            else { XcdBarrier xb; xb.bar = (unsigned*)(a.ws() + WS_BAR); xb.x = xb_xcc_id(); xb.st = xst; xcd_barrier(xb); }
        }
    }
}

extern "C" void kernel_launch(void* const* d_in, const int* in_sizes, int n_in, void* d_out, int out_size, void* d_ws, size_t ws_size, hipStream_t stream) {
    static int grid = 0;
    if (grid == 0) {
        if (n_in != 31 || out_size != MTOK * DM || ws_size < WS_END) { fprintf(stderr, "kernel_launch: unexpected shapes (n_in %d out %d ws %zu need %zu)\n", n_in, out_size, ws_size, (size_t)WS_END); grid = -1; return; }
        int dev = 0, cus = 0, per_cu = 0;
        (void)hipGetDevice(&dev); (void)hipDeviceGetAttribute(&cus, hipDeviceAttributeMultiprocessorCount, dev);
        if (hipFuncSetAttribute((const void*)mega, hipFuncAttributeMaxDynamicSharedMemorySize, LDS_BYTES) != hipSuccess) { fprintf(stderr, "kernel_launch: hipFuncSetAttribute failed\n"); grid = -1; return; }
        if (hipOccupancyMaxActiveBlocksPerMultiprocessor(&per_cu, (const void*)mega, NTHR, LDS_BYTES) != hipSuccess || per_cu < 1) { fprintf(stderr, "kernel_launch: occupancy query says %d blocks/CU\n", per_cu); per_cu = 1; }
        (void)hipGetLastError();
        grid = cus;
        if (grid <= 0) grid = 256;
    }
    if (grid < 0) return;
    (void)hipMemsetAsync((char*)d_ws + WS_BAR, 0, XCD_BAR_WORDS * sizeof(unsigned), stream);
    Args a{};
    for (int i = 0; i < 31; ++i) a.in[i] = (const float*)d_in[i];
    a.out = (float*)d_out; a.ws = (unsigned char*)d_ws;
#if MULTI_LAUNCH
    for (int ph = 0; ph < N_PHASES; ++ph) { a.ph_lo = ph; a.ph_hi = ph + 1; hipLaunchKernelGGL(mega, dim3(grid), dim3(NTHR), LDS_BYTES, stream, a); }
#else
    a.ph_lo = 0; a.ph_hi = N_PHASES;
    void* kargs[] = {&a};
    hipError_t e = hipLaunchCooperativeKernel((const void*)mega, dim3(grid), dim3(NTHR), kargs, LDS_BYTES, stream);
    if (e != hipSuccess) fprintf(stderr, "cooperative launch failed: %s (grid %d)\n", hipGetErrorString(e), grid);
#endif
}
```
